# Optimizing an MI355X kernel written in HIP

```python
import jax
import jax.numpy as jnp
from jax import lax
import numpy as np

D_MODEL = 4096
BATCH = 1
SEQ = 8192
DEPTH = 1

HEAD_DIM = 128
MIX_WIDTH = D_MODEL
FOX_WIDTH = MIX_WIDTH // 2
HGRN_WIDTH = MIX_WIDTH - FOX_WIDTH
FOX_HEADS = FOX_WIDTH // HEAD_DIM
HGRN_HEADS = HGRN_WIDTH // HEAD_DIM
FOX_BLOCK = 128
HGRN_CHUNK = 64
IN_COLS = 3 * FOX_WIDTH + FOX_HEADS + 4 * HGRN_WIDTH
PEER_HEADS = 8
PEER_KEYS = 128
PEER_EXPERTS = PEER_KEYS * PEER_KEYS
PEER_TOPK = 16
PEER_QDIM = 256
PEER_HALF = PEER_QDIM // 2
PEER_TOKEN_BLOCK = 64
N_MOD = 6
EPS = 1e-6

kernel_name = "hymba_fox_hgrn2_peer_adaln"


def rms_norm(x, gain):
    xf = x.astype(jnp.float32)
    y = xf * lax.rsqrt(jnp.mean(xf * xf, axis=-1, keepdims=True) + EPS)
    return (y * gain.astype(jnp.float32)).astype(x.dtype)


def fox_attention(q, k, v, log_f):
    B, S, H, Dh = q.shape
    scale = Dh ** -0.5
    cum_f = jnp.cumsum(log_f, axis=1)
    qh = jnp.transpose(q, (0, 2, 1, 3))
    kh = jnp.transpose(k, (0, 2, 1, 3))
    vh = jnp.transpose(v, (0, 2, 1, 3))
    fh = jnp.transpose(cum_f, (0, 2, 1))
    nb = S // FOX_BLOCK
    q_blocks = jnp.transpose(qh.reshape(B, H, nb, FOX_BLOCK, Dh), (2, 0, 1, 3, 4))
    f_blocks = jnp.transpose(fh.reshape(B, H, nb, FOX_BLOCK), (2, 0, 1, 3))
    key_pos = jnp.arange(S)

    def one_block(args):
        qb, fb, bi = args
        s = jnp.einsum('bhqd,bhkd->bhqk', qb, kh, preferred_element_type=jnp.float32) * scale
        s = s + fb[..., None] - fh[:, :, None, :]
        q_pos = bi * FOX_BLOCK + jnp.arange(FOX_BLOCK)
        causal = key_pos[None, :] <= q_pos[:, None]
        s = jnp.where(causal, s, -jnp.inf)
        p = jax.nn.softmax(s, axis=-1)
        return jnp.einsum('bhqk,bhkd->bhqd', p.astype(vh.dtype), vh)

    out = lax.map(one_block, (q_blocks, f_blocks, jnp.arange(nb)))
    return jnp.transpose(out, (1, 0, 3, 2, 4)).reshape(B, S, H, Dh)


def hgrn2_recurrence(q, k, v, log_f):
    B, S, H, Dk = q.shape
    Dv = v.shape[-1]
    C = HGRN_CHUNK
    nc = S // C

    def to_chunks(t):
        return jnp.transpose(t.reshape(B, nc, C, H, t.shape[-1]), (1, 0, 3, 2, 4))

    qc, kc, vc, gc = to_chunks(q), to_chunks(k), to_chunks(v), to_chunks(log_f)
    causal = jnp.tril(jnp.ones((C, C), dtype=bool))[:, :, None]

    def step(state, inp):
        qb, kb, vb, gb = inp
        b = jnp.cumsum(gb, axis=2)
        diff = b[:, :, :, None, :] - b[:, :, None, :, :]
        decay = jnp.exp(jnp.where(causal, diff, -jnp.inf))
        scores = jnp.einsum('bhtk,bhsk,bhtsk->bhts', qb, kb, decay)
        o_intra = jnp.einsum('bhts,bhsv->bhtv', scores, vb)
        o_inter = jnp.einsum('bhtk,bhkv->bhtv', qb * jnp.exp(b), state)
        b_last = b[:, :, -1:, :]
        k_dec = kb * jnp.exp(b_last - b)
        new_state = state * jnp.exp(b_last)[:, :, 0, :, None] + jnp.einsum('bhsk,bhsv->bhkv', k_dec, vb)
        return new_state, o_intra + o_inter

    state0 = jnp.zeros((B, H, Dk, Dv), jnp.float32)
    _, out = lax.scan(step, state0, (qc, kc, vc, gc))
    return jnp.transpose(out, (1, 0, 3, 2, 4)).reshape(B, S, H, Dv)


def hybrid_mixer(h, w_in, fox_f_bias, fox_q_gain, fox_k_gain, lower_bound, hgrn_out_gain, w_out):
    B, S, _ = h.shape
    proj = h @ w_in
    o1 = FOX_WIDTH
    o2 = 2 * FOX_WIDTH
    o3 = 3 * FOX_WIDTH
    o4 = o3 + FOX_HEADS
    o5 = o4 + HGRN_WIDTH
    o6 = o5 + HGRN_WIDTH
    o7 = o6 + HGRN_WIDTH
    fq = proj[..., :o1].reshape(B, S, FOX_HEADS, HEAD_DIM)
    fk = proj[..., o1:o2].reshape(B, S, FOX_HEADS, HEAD_DIM)
    fv = proj[..., o2:o3].reshape(B, S, FOX_HEADS, HEAD_DIM)
    f_logit = proj[..., o3:o4]
    hq = proj[..., o4:o5].reshape(B, S, HGRN_HEADS, HEAD_DIM)
    hf = proj[..., o5:o6].reshape(B, S, HGRN_HEADS, HEAD_DIM)
    hi = proj[..., o6:o7].reshape(B, S, HGRN_HEADS, HEAD_DIM)
    hg = proj[..., o7:].reshape(B, S, HGRN_HEADS, HEAD_DIM)

    fq = rms_norm(fq, fox_q_gain)
    fk = rms_norm(fk, fox_k_gain)
    fox_log_f = jax.nn.log_sigmoid(f_logit.astype(jnp.float32) + fox_f_bias.astype(jnp.float32))
    fox_out = fox_attention(fq, fk, fv, fox_log_f)

    lb = lower_bound.reshape(HGRN_HEADS, HEAD_DIM)
    forget = lb + (1.0 - lb) * jax.nn.sigmoid(hf.astype(jnp.float32))
    h_log_f = jnp.log(forget)
    h_key = 1.0 - forget
    h_query = jax.nn.silu(hq.astype(jnp.float32)) * (HEAD_DIM ** -0.5)
    h_rec = hgrn2_recurrence(h_query, h_key, hi.astype(jnp.float32), h_log_f)
    hgrn_out = rms_norm(h_rec, hgrn_out_gain) * jax.nn.silu(hg.astype(jnp.float32))

    merged = jnp.concatenate([fox_out.reshape(B, S, FOX_WIDTH).astype(h.dtype),
                              hgrn_out.reshape(B, S, HGRN_WIDTH).astype(h.dtype)], axis=-1)
    return merged @ w_out


def peer_ffn(h, w_query, sub_keys, u_experts, v_experts):
    B, S, D = h.shape
    T = B * S
    ht = h.reshape(T, D)
    q = (ht @ w_query).reshape(T, PEER_HEADS, 2, PEER_HALF)
    scores = jnp.einsum('thpd,hpnd->thpn', q, sub_keys, preferred_element_type=jnp.float32)
    top_s, top_i = lax.top_k(scores, PEER_TOPK)
    cand_s = top_s[:, :, 0, :, None] + top_s[:, :, 1, None, :]
    cand_i = top_i[:, :, 0, :, None] * PEER_KEYS + top_i[:, :, 1, None, :]
    cand_s = cand_s.reshape(T, PEER_HEADS, PEER_TOPK * PEER_TOPK)
    cand_i = cand_i.reshape(T, PEER_HEADS, PEER_TOPK * PEER_TOPK)
    best_s, best_pos = lax.top_k(cand_s, PEER_TOPK)
    expert_idx = jnp.take_along_axis(cand_i, best_pos, axis=-1)
    gates = jax.nn.softmax(best_s.astype(jnp.float32), axis=-1)

    nb = T // PEER_TOKEN_BLOCK
    xb_all = ht.reshape(nb, PEER_TOKEN_BLOCK, D)
    idx_all = expert_idx.reshape(nb, PEER_TOKEN_BLOCK, PEER_HEADS, PEER_TOPK)
    g_all = gates.reshape(nb, PEER_TOKEN_BLOCK, PEER_HEADS, PEER_TOPK)

    def one_block(args):
        xb, idx, g = args
        u = u_experts[idx]
        act = jax.nn.gelu(jnp.einsum('td,thkd->thk', xb, u, preferred_element_type=jnp.float32), approximate=False)
        v = v_experts[idx]
        return jnp.einsum('thk,thkd->td', (g * act).astype(v.dtype), v)

    out = lax.map(one_block, (xb_all, idx_all, g_all))
    return out.reshape(B, S, D)


def setup_inputs(seed: int = 0) -> dict:
    key = jax.random.key(seed)
    ks = jax.random.split(key, 17)
    D = D_MODEL
    L = DEPTH
    f32 = jnp.float32

    def nrm(k, shape, scale):
        return jax.random.normal(k, shape, f32) * scale

    return {
        "x": nrm(ks[0], (BATCH, SEQ, D), 1.0),
        "c": nrm(ks[1], (BATCH, D), 1.0),
        "ada_w": nrm(ks[2], (L, D, N_MOD * D), 0.5 * D ** -0.5),
        "ada_b": nrm(ks[3], (L, N_MOD * D), 0.02),
        "norm1_gain": 1.0 + nrm(ks[4], (L, D), 0.02),
        "norm2_gain": 1.0 + nrm(ks[5], (L, D), 0.02),
        "w_in": nrm(ks[6], (L, D, IN_COLS), D ** -0.5),
        "fox_f_bias": 2.0 + nrm(ks[7], (L, FOX_HEADS), 0.5),
        "fox_q_gain": 1.0 + nrm(ks[8], (L, FOX_HEADS, HEAD_DIM), 0.02),
        "fox_k_gain": 1.0 + nrm(ks[9], (L, FOX_HEADS, HEAD_DIM), 0.02),
        "hgrn_lower_bounds": nrm(ks[10], (L + 1, HGRN_WIDTH), 0.1).at[-1].add(1.0),
        "hgrn_out_gain": 1.0 + nrm(ks[11], (L, HGRN_HEADS, HEAD_DIM), 0.02),
        "w_out": nrm(ks[12], (L, MIX_WIDTH, D), MIX_WIDTH ** -0.5),
        "peer_w_query": nrm(ks[13], (L, D, PEER_HEADS * PEER_QDIM), D ** -0.5),
        "peer_sub_keys": nrm(ks[14], (L, PEER_HEADS, 2, PEER_KEYS, PEER_HALF), PEER_HALF ** -0.5),
        "peer_u": nrm(ks[15], (L, PEER_EXPERTS, D), D ** -0.5),
        "peer_v": nrm(ks[16], (L, PEER_EXPERTS, D), PEER_HEADS ** -0.5),
    }


def reference(x, c, ada_w, ada_b, norm1_gain, norm2_gain, w_in, fox_f_bias, fox_q_gain, fox_k_gain,
              hgrn_lower_bounds, hgrn_out_gain, w_out, peer_w_query, peer_sub_keys, peer_u, peer_v):
    lower_bounds = jnp.cumsum(jax.nn.softmax(hgrn_lower_bounds.astype(jnp.float32), axis=0), axis=0)
    c_act = jax.nn.silu(c)
    for layer in range(DEPTH):
        mod = c_act @ ada_w[layer] + ada_b[layer]
        shift1, scale1, gate1, shift2, scale2, gate2 = jnp.split(mod[:, None, :], N_MOD, axis=-1)
        h = rms_norm(x, norm1_gain[layer]) * (1.0 + scale1) + shift1
        mix = hybrid_mixer(h, w_in[layer], fox_f_bias[layer], fox_q_gain[layer], fox_k_gain[layer],
                           lower_bounds[layer], hgrn_out_gain[layer], w_out[layer])
        x = x + gate1 * mix
        h = rms_norm(x, norm2_gain[layer]) * (1.0 + scale2) + shift2
        x = x + gate2 * peer_ffn(h, peer_w_query[layer], peer_sub_keys[layer], peer_u[layer], peer_v[layer])
    return x
```

```cpp
#include <hip/hip_runtime.h>
#include <hip/hip_bf16.h>
#include <cstdio>
#include <cstdint>

constexpr int T_ = 8192, DM = 4096, NIN = 14352, NPROJ = 14336, FOXW = 2048, HGW = 2048, NHEAD = 16, HDIM = 128;
constexpr int PEER_H = 8, PEER_K = 128, PEER_TOP = 16, PEER_QW = 2048, PEER_NE = 16384;
constexpr float EPS_ = 1e-6f;

constexpr size_t MiB = 1u << 20;
constexpr size_t WS_CTL = 0, CTL_ZERO_BYTES = 1 * MiB;
constexpr size_t CTL_MOD = 65536;
constexpr size_t WS_WINT = 2 * MiB;
constexpr size_t WS_WOUTT = WS_WINT + 112 * MiB;
constexpr size_t WS_WQT = WS_WOUTT + 32 * MiB;
constexpr size_t WS_WFT = WS_WQT + 16 * MiB;
constexpr size_t WS_UBF = WS_WFT + 1 * MiB;
constexpr size_t WS_VBF = WS_UBF + 128 * MiB;
constexpr size_t WS_H = WS_VBF + 128 * MiB;
constexpr size_t WS_FLOGF = WS_H + 64 * MiB;
constexpr size_t WS_FCUM = WS_FLOGF + 512 * 1024;
constexpr size_t WS_FQ = WS_FLOGF + 1 * MiB;
constexpr size_t WS_FK = WS_FQ + 32 * MiB;
constexpr size_t WS_FV = WS_FK + 32 * MiB;
constexpr size_t WS_HQ = WS_FV + 32 * MiB;
constexpr size_t WS_HK = WS_HQ + 32 * MiB;
constexpr size_t WS_HV = WS_HK + 32 * MiB;
constexpr size_t WS_HG = WS_HV + 32 * MiB;
constexpr size_t WS_HLF = WS_HG + 32 * MiB;
constexpr size_t WS_HO = WS_HLF + 64 * MiB;
constexpr size_t WS_MERGED = WS_HO + 64 * MiB;
constexpr size_t WS_QP = WS_MERGED + 64 * MiB;
constexpr size_t WS_SC = WS_QP + 64 * MiB;
constexpr size_t WS_PIDX = WS_SC + 64 * MiB;
constexpr size_t WS_PGATE = WS_PIDX + 4 * MiB;
constexpr size_t WS_PROJ = WS_PGATE + 4 * MiB;
constexpr size_t WS_END = WS_PROJ + 448 * MiB;

typedef unsigned short bf16_t;
typedef float f32x4 __attribute__((ext_vector_type(4)));
typedef float f32x2 __attribute__((ext_vector_type(2)));
typedef unsigned u32x4 __attribute__((ext_vector_type(4)));
typedef unsigned u32x2 __attribute__((ext_vector_type(2)));
#define LAS __attribute__((address_space(3)))

__device__ __forceinline__ unsigned f2bf(float f) { unsigned u = __builtin_bit_cast(unsigned, f); return (u + 0x7fffu + ((u >> 16) & 1u)) >> 16; }
__device__ __forceinline__ unsigned pk2(float lo, float hi) { return f2bf(lo) | (f2bf(hi) << 16); }
__device__ __forceinline__ float bf2f(unsigned b) { return __builtin_bit_cast(float, b << 16); }
__device__ __forceinline__ float wave_sum(float v) {
#pragma unroll
    for (int o = 1; o < 64; o <<= 1) v += __shfl_xor(v, o);
    return v;
}
__device__ __forceinline__ float silu_f(float x) { return x / (1.f + __expf(-x)); }
__device__ __forceinline__ float sigmoid_f(float x) { return 1.f / (1.f + __expf(-x)); }
namespace pg8 {
#define PG8_LAS __attribute__((address_space(3)))
typedef unsigned short bf16_t;
typedef short bf16x8 __attribute__((ext_vector_type(8)));
typedef float f32x4 __attribute__((ext_vector_type(4)));
typedef unsigned u32x4 __attribute__((ext_vector_type(4)));
constexpr int BM = 256, BK = 64, HALF = 128, HTB = HALF * BK * 2  , STAGE_BYTES = 8 * HTB, NXCD = 8, WGM = 8;

__host__ __device__ __forceinline__ int lds_byte(int r, int c) { const int st = (r >> 4) * 2 + (c >> 5), rr = r & 15, cc = c & 31, ob = rr * 64 + cc * 2; return st * 1024 + (ob ^ (((ob >> 9) & 1) << 5)); }
__host__ __device__ __forceinline__ void stage_rc(int b, int& R, int& C) { const int st = b / 1024, sb = b % 1024, swz = sb ^ (((sb >> 9) & 1) << 5); R = (st >> 1) * 16 + swz / 64; C = (st & 1) * 32 + (swz % 64) / 2; }
__host__ __device__ __forceinline__ int perm32(int rho) { const int n = rho >> 4, i = rho & 15; return 8 * (i >> 2) + 4 * n + (i & 3); }

struct Unit { int pm, pn; };
struct Gemm { const bf16_t* A; const bf16_t* Bt; int M, N, K; };

struct StaticOrder {
    int nM, nN, nwg, G, c;
    __host__ __device__ void init(int M, int N, int G_, int c_) { nM = M / BM; nN = N / BM; nwg = nM * nN; G = G_; c = c_; }
    __host__ __device__ bool next(int i, Unit& u) const {
        const long L = (long)i * G + c; if (L >= nwg) return false;
        int wgid = (int)L; { const int q = nwg / NXCD, r = nwg % NXCD, xcd = wgid % NXCD, off = wgid / NXCD; wgid = (xcd < r ? xcd * (q + 1) : r * (q + 1) + (xcd - r) * q) + off; }
        const int nig = WGM * nN, gid = wgid / nig, fm = gid * WGM, gsz = (nM - fm) < WGM ? (nM - fm) : WGM;
        u.pm = fm + ((wgid % nig) % gsz); u.pn = (wgid % nig) / gsz; return true;
    }
    __device__ __forceinline__ void a_ready(const Unit&) const {}
    __device__ __forceinline__ void done(const Unit&) const {}
};
__device__ __forceinline__ unsigned cvt_pk_bf16(float lo, float hi) { unsigned r; asm volatile("v_cvt_pk_bf16_f32 %0, %1, %2" : "=v"(r) : "v"(lo), "v"(hi)); return r; }
typedef float f32x2 __attribute__((ext_vector_type(2)));
__device__ __forceinline__ f32x2 gelu_pk(f32x2 v) {
    const f32x2 av = __builtin_elementwise_abs(v), d = av * 0.2316418882f + 1.0f;
    f32x2 t; t.x = __builtin_amdgcn_rcpf(d.x); t.y = __builtin_amdgcn_rcpf(d.y);
    f32x2 q = t * 0.5307027145f + (-0.7265760135f); q = q * t + 0.7107068705f; q = q * t + (-0.142248368f); q = q * t + 0.127414796f; q = q * t;
    const f32x2 s = (v * v) * (-0.72134752044f);
    f32x2 e; e.x = __builtin_amdgcn_exp2f(s.x); e.y = __builtin_amdgcn_exp2f(s.y);
    const f32x2 m = v * (q * e), r = v - m;
    f32x2 o; o.x = v.x < 0.f ? m.x : r.x; o.y = v.y < 0.f ? m.y : r.y; return o;
}

struct EpiF32 {
    static constexpr bool PERM = false, AFTER_DRAIN = false;
    float* C; int ldc; const float* bias;
    __device__ __forceinline__ void operator()(const f32x4 (&acc)[2][2][4][2], const Unit& u, int wr, int wc, int fr, int fq) const {
        const int row0 = u.pm * BM + wr * 64 + fr, col0 = u.pn * BM + wc * 32 + 4 * fq;
        f32x4 bv[2][2];
#pragma unroll
        for (int bj = 0; bj < 2; ++bj)
#pragma unroll
            for (int n = 0; n < 2; ++n) bv[bj][n] = bias ? *(const f32x4*)(bias + col0 + bj * HALF + n * 16) : (f32x4){0.f, 0.f, 0.f, 0.f};
#pragma unroll
        for (int ai = 0; ai < 2; ++ai)
#pragma unroll
            for (int m = 0; m < 4; ++m) { float* rowp = C + (size_t)(row0 + ai * HALF + m * 16) * ldc + col0;
#pragma unroll
                for (int bj = 0; bj < 2; ++bj)
#pragma unroll
                    for (int n = 0; n < 2; ++n) *(f32x4*)(rowp + bj * HALF + n * 16) = acc[ai][bj][m][n] + bv[bj][n]; }
    }
};
template <class Epi, class Sched, bool STAMP = false>
__device__ __forceinline__ void gemm_phase(PG8_LAS unsigned char* lds, const Gemm g, const Sched& S, const Epi& E, unsigned long long* stamps) {
    const int tid = threadIdx.x, wid = __builtin_amdgcn_readfirstlane(tid >> 6), lane = tid & 63, wr = wid >> 2, wc = wid & 3, fr = lane & 15, fq = lane >> 4;
    const int K = g.K, nt = K / BK;
    int ts_lo = 0, ts_hi = 0, nts = 0; const unsigned long long rt_entry = STAMP ? (unsigned long long)wall_clock64() : 0ull;
#define PG8_STAMP() do { if (STAMP && wid == 0 && nts < 64) { const unsigned long long _c = (unsigned long long)clock64(); \
        ts_lo = (lane == nts) ? (int)(unsigned)_c : ts_lo; ts_hi = (lane == nts) ? (int)(unsigned)(_c >> 32) : ts_hi; ++nts; } } while (0)
    PG8_STAMP();
    unsigned voffA[2], voffB[2];
#pragma unroll
    for (int i = 0; i < 2; ++i) { int R, C; stage_rc(tid * 16 + i * 8192, R, C); const int Rb = Epi::PERM ? ((R & ~31) + perm32(R & 31)) : R;
        voffA[i] = (unsigned)(R * K + C) * 2u; voffB[i] = (unsigned)(Rb * K + C) * 2u; }
    const size_t kstep = (size_t)(BK * 2);
    const size_t hstep = (size_t)HALF * K * 2;
    const size_t tstep = 2 * hstep;
    const unsigned ldsw = (unsigned)wid * 1024u;
    const int aoff = lds_byte(wr * 64 + fr, fq * 8), boff = lds_byte(wc * 32 + fr, fq * 8);
#define PG8_SA(b, h) (((b) * 2 + (h)) * HTB)
#define PG8_SB(b, h) ((4 + (b) * 2 + (h)) * HTB)
#define PG8_STAGE(bufoff, gbase, voff) do { _Pragma("unroll") for (int _i = 0; _i < 2; ++_i) \
        __builtin_amdgcn_global_load_lds((const unsigned*)((const char*)(gbase) + (voff)[_i]), (PG8_LAS unsigned*)(lds + (bufoff) + ldsw + _i * 8192), 16, 0, 0); } while (0)
#define PG8_LDA(dst, b, h) do { _Pragma("unroll") for (int m = 0; m < 4; ++m) _Pragma("unroll") for (int k = 0; k < 2; ++k) dst[m][k] = *(const PG8_LAS bf16x8*)(lds + PG8_SA(b, h) + aoff + m * 2048 + k * 1024); } while (0)
#define PG8_LDB(dst, b, h) do { _Pragma("unroll") for (int n = 0; n < 2; ++n) _Pragma("unroll") for (int k = 0; k < 2; ++k) dst[n][k] = *(const PG8_LAS bf16x8*)(lds + PG8_SB(b, h) + boff + n * 2048 + k * 1024); } while (0)
#define PG8_MMA(ai, bj, At, Bt) do { __builtin_amdgcn_s_setprio(1); _Pragma("unroll") for (int m = 0; m < 4; ++m) _Pragma("unroll") for (int n = 0; n < 2; ++n) _Pragma("unroll") for (int k = 0; k < 2; ++k) \
        acc[ai][bj][m][n] = __builtin_amdgcn_mfma_f32_16x16x32_bf16(Bt[n][k], At[m][k], acc[ai][bj][m][n], 0, 0, 0); __builtin_amdgcn_s_setprio(0); } while (0)
#define PG8_WAIT_V(n) asm volatile("s_waitcnt vmcnt(" #n ")" ::: "memory")
#define PG8_WAIT_L(n) asm volatile("s_waitcnt lgkmcnt(" #n ")" ::: "memory")
#define PG8_BAR __builtin_amdgcn_s_barrier()
#define PG8_SCHED __builtin_amdgcn_sched_barrier(0)
    Unit cur, nxt; int ui = 0;
    if (!S.next(0, cur)) return;
    f32x4 acc[2][2][4][2];
#pragma unroll
    for (int a = 0; a < 2; ++a)
#pragma unroll
        for (int b = 0; b < 2; ++b)
#pragma unroll
            for (int m = 0; m < 4; ++m)
#pragma unroll
                for (int n = 0; n < 2; ++n) acc[a][b][m][n] = (f32x4){0.f, 0.f, 0.f, 0.f};
    bf16x8 At[4][2], B0[2][2], B1[2][2];
    const char* cA = (const char*)g.A + (size_t)cur.pm * tstep; const char* cB = (const char*)g.Bt + (size_t)cur.pn * tstep;
    S.a_ready(cur);
    PG8_STAGE(PG8_SB(0, 0), cB, voffB); PG8_STAGE(PG8_SA(0, 0), cA, voffA); PG8_STAGE(PG8_SB(0, 1), cB + hstep, voffB); PG8_STAGE(PG8_SA(0, 1), cA + hstep, voffA);
    if (wr == 1) PG8_BAR;
    PG8_WAIT_V(4); PG8_BAR;
    PG8_STAGE(PG8_SB(1, 0), cB + kstep, voffB); PG8_STAGE(PG8_SA(1, 0), cA + kstep, voffA); PG8_STAGE(PG8_SB(1, 1), cB + hstep + kstep, voffB);
    PG8_WAIT_V(6); PG8_BAR;
    PG8_STAMP();
    for (;;) {
        const bool has_next = S.next(ui + 1, nxt);
        const char* nA = has_next ? (const char*)g.A + (size_t)nxt.pm * tstep : cA; const char* nB = has_next ? (const char*)g.Bt + (size_t)nxt.pn * tstep : cB;
        for (int t = 0; t < nt; t += 2) {
            const bool last = (t == nt - 2);
            const char* a1 = cA + (size_t)(t + 1) * kstep;
            const char* a2 = last ? nA : cA + (size_t)(t + 2) * kstep; const char* b2 = last ? nB : cB + (size_t)(t + 2) * kstep;
            const char* a3 = a2 + kstep; const char* b3 = b2 + kstep;
            if (last && has_next) S.a_ready(nxt);
            PG8_LDB(B0, 0, 0); PG8_SCHED; PG8_LDA(At, 0, 0); PG8_STAGE(PG8_SA(1, 1), a1 + hstep, voffA);
            PG8_WAIT_L(8); PG8_BAR; PG8_WAIT_L(0); PG8_MMA(0, 0, At, B0); PG8_BAR; PG8_SCHED;
            PG8_LDB(B1, 0, 1); PG8_STAGE(PG8_SB(0, 0), b2, voffB);
            PG8_BAR; PG8_WAIT_L(0); PG8_MMA(0, 1, At, B1); PG8_BAR;
            PG8_LDA(At, 0, 1); PG8_STAGE(PG8_SA(0, 0), a2, voffA);
            PG8_BAR; PG8_WAIT_L(0); PG8_MMA(1, 0, At, B0); PG8_BAR; PG8_SCHED;
            PG8_STAGE(PG8_SB(0, 1), b2 + hstep, voffB);
            PG8_WAIT_V(6); PG8_BAR; PG8_MMA(1, 1, At, B1); PG8_BAR;
            PG8_LDB(B0, 1, 0); PG8_SCHED; PG8_LDA(At, 1, 0); PG8_STAGE(PG8_SA(0, 1), a2 + hstep, voffA);
            PG8_WAIT_L(8); PG8_BAR; PG8_WAIT_L(0); PG8_MMA(0, 0, At, B0); PG8_BAR; PG8_SCHED;
            PG8_LDB(B1, 1, 1); PG8_STAGE(PG8_SB(1, 0), b3, voffB);
            PG8_BAR; PG8_WAIT_L(0); PG8_MMA(0, 1, At, B1); PG8_BAR;
            PG8_LDA(At, 1, 1); PG8_STAGE(PG8_SA(1, 0), a3, voffA);
            PG8_BAR; PG8_WAIT_L(0); PG8_MMA(1, 0, At, B0); PG8_BAR; PG8_SCHED;
            PG8_STAGE(PG8_SB(1, 1), b3 + hstep, voffB);
            PG8_WAIT_V(6); PG8_BAR; PG8_MMA(1, 1, At, B1); PG8_BAR;
        }
        PG8_STAMP();
        if constexpr (!Epi::AFTER_DRAIN) { E(acc, cur, wr, wc, fr, fq); S.done(cur); }
        PG8_STAMP();
        if (!has_next) break;
#pragma unroll
        for (int a = 0; a < 2; ++a)
#pragma unroll
            for (int b = 0; b < 2; ++b)
#pragma unroll
                for (int m = 0; m < 4; ++m)
#pragma unroll
                    for (int n = 0; n < 2; ++n) acc[a][b][m][n] = (f32x4){0.f, 0.f, 0.f, 0.f};
        cur = nxt; cA = nA; cB = nB; ++ui;
    }
    PG8_WAIT_V(0);
    if (wr == 0) PG8_BAR;
    PG8_BAR;
    if constexpr (Epi::AFTER_DRAIN) { E.fused(acc, cur, wr, wc, fr, fq, lds, wid, lane); S.done(cur); }
    PG8_STAMP();
    if (STAMP && wid == 0) { stamps[lane] = lane < nts ? (((unsigned long long)(unsigned)ts_hi << 32) | (unsigned)ts_lo) : 0ull;
        if (lane == 62) stamps[62] = rt_entry; if (lane == 63) stamps[63] = (unsigned long long)wall_clock64(); }
#undef PG8_STAMP
#undef PG8_SA
#undef PG8_SB
#undef PG8_STAGE
#undef PG8_LDA
#undef PG8_LDB
#undef PG8_MMA
#undef PG8_WAIT_V
#undef PG8_WAIT_L
#undef PG8_BAR
#undef PG8_SCHED
}
}
__device__ __forceinline__ void transpose_item(const float* W, int ld, int c0, bf16_t* WT, int K, int r0, int nblk, LAS float* scr, int item, int lane) {
    const int kb = item / nblk, nb = item % nblk, k0 = 64 * kb, n0 = 32 * nb;
#pragma unroll 8
    for (int i = 0; i < 32; ++i) { const int kk = 2 * i + (lane >> 5); scr[kk * 33 + (lane & 31)] = W[(size_t)(k0 + kk) * ld + c0 + n0 + (lane & 31)]; }
    asm volatile("s_waitcnt lgkmcnt(0)" ::: "memory");
    const int c = lane & 7;
#pragma unroll
    for (int j = 0; j < 4; ++j) { const int n = (lane >> 3) + 8 * j; const LAS float* s = scr + (8 * c) * 33 + n;
        u32x4 o; o.x = pk2(s[0 * 33], s[1 * 33]); o.y = pk2(s[2 * 33], s[3 * 33]); o.z = pk2(s[4 * 33], s[5 * 33]); o.w = pk2(s[6 * 33], s[7 * 33]);
        *(u32x4*)(WT + (size_t)(r0 + n0 + n) * K + k0 + 8 * c) = o; }
    asm volatile("s_waitcnt lgkmcnt(0)" ::: "memory");
}
__global__ void __launch_bounds__(512, 2) k_convert(const float* w_in, const float* w_out, const float* w_q, const float* u, const float* v,
                                                    bf16_t* WinT, bf16_t* WoutT, bf16_t* WqT, float* WFT, bf16_t* Ubf, bf16_t* Vbf) {
    extern __shared__ __attribute__((aligned(16))) unsigned char lds[];
    const int tid = threadIdx.x, lane = tid & 63, wave = tid >> 6;
    LAS float* scr = (LAS float*)((LAS unsigned char*)lds + wave * 16384);
    const int gw = blockIdx.x * 8 + wave, NGW = gridDim.x * 8;
    constexpr int I_A = 64 * 192, I_B = 64 * 256, I_O = 64 * 128, I_Q = 64 * 64, NIT = I_A + I_B + I_O + I_Q;
    for (int it = gw; it < NIT; it += NGW) {
        int r = it;
        if (r < I_A) { transpose_item(w_in, NIN, 0, WinT, DM, 0, 192, scr, r, lane); continue; } r -= I_A;
        if (r < I_B) { transpose_item(w_in, NIN, 6160, WinT, DM, 6144, 256, scr, r, lane); continue; } r -= I_B;
        if (r < I_O) { transpose_item(w_out, DM, 0, WoutT, DM, 0, 128, scr, r, lane); continue; } r -= I_O;
        transpose_item(w_q, PEER_QW, 0, WqT, DM, 0, 64, scr, r, lane);
    }
    const size_t gt = (size_t)blockIdx.x * 512 + tid, NGT = (size_t)gridDim.x * 512;
    for (size_t i = gt; i < (size_t)16 * DM; i += NGT) { const int h = (int)(i / DM), k = (int)(i % DM); WFT[i] = w_in[(size_t)k * NIN + 6144 + h]; }
    const size_t n8 = (size_t)PEER_NE * DM / 8;
    for (size_t i = gt; i < n8; i += NGT) {
        { const f32x4 a = *(const f32x4*)(u + i * 8), b = *(const f32x4*)(u + i * 8 + 4); u32x4 o = {pk2(a[0], a[1]), pk2(a[2], a[3]), pk2(b[0], b[1]), pk2(b[2], b[3])}; *(u32x4*)(Ubf + i * 8) = o; }
        { const f32x4 a = *(const f32x4*)(v + i * 8), b = *(const f32x4*)(v + i * 8 + 4); u32x4 o = {pk2(a[0], a[1]), pk2(a[2], a[3]), pk2(b[0], b[1]), pk2(b[2], b[3])}; *(u32x4*)(Vbf + i * 8) = o; }
    }
}
__global__ void __launch_bounds__(512, 2) k_adaln(const float* c, const float* ada_w, float* mod) {
    __shared__ float cact[DM];
    const int tid = threadIdx.x;
    for (int i = tid; i < DM; i += 512) cact[i] = silu_f(c[i]);
    __syncthreads();
    constexpr int NCH = 6 * DM / 2048, NIT = NCH * 64;
    for (int it = blockIdx.x; it < NIT; it += gridDim.x) {
        const int ch = it % NCH, ks = it / NCH, col = ch * 2048 + tid * 4;
        f32x4 acc = {0.f, 0.f, 0.f, 0.f};
#pragma unroll 16
        for (int k = 0; k < 64; ++k) { const int kk = ks * 64 + k; const f32x4 w = *(const f32x4*)(ada_w + (size_t)kk * (6 * DM) + col); acc += w * cact[kk]; }
        atomicAdd(mod + col + 0, acc[0]); atomicAdd(mod + col + 1, acc[1]); atomicAdd(mod + col + 2, acc[2]); atomicAdd(mod + col + 3, acc[3]);
    }
}
__global__ void __launch_bounds__(512, 2) k_norm1(const float* x, const float* mod, const float* ada_b, const float* g1, const float* WFT, const float* fbias, bf16_t* H, float* FLOGF) {
    extern __shared__ __attribute__((aligned(16))) unsigned char lds[];
    float* A1 = (float*)lds; float* B1 = A1 + DM;
    const int tid = threadIdx.x, lane = tid & 63, wave = tid >> 6;
    for (int i = tid; i < DM; i += 512) { A1[i] = g1[i] * (1.f + mod[DM + i] + ada_b[DM + i]); B1[i] = mod[i] + ada_b[i]; }
    __syncthreads();
    for (int t = blockIdx.x * 8 + wave; t < T_; t += gridDim.x * 8) {
        const f32x4* xr = (const f32x4*)(x + (size_t)t * DM) + lane;
        f32x4 v[16]; float ss = 0.f;
#pragma unroll
        for (int j = 0; j < 16; ++j) { v[j] = xr[64 * j]; ss += (v[j][0] * v[j][0] + v[j][1] * v[j][1]) + (v[j][2] * v[j][2] + v[j][3] * v[j][3]); }
        const float rstd = rsqrtf(wave_sum(ss) * (1.f / DM) + EPS_);
#pragma unroll
        for (int j = 0; j < 16; ++j) { const f32x4 a = *(const f32x4*)(A1 + 4 * lane + 256 * j), b = *(const f32x4*)(B1 + 4 * lane + 256 * j); v[j] = v[j] * rstd * a + b; }
        u32x2* o8 = (u32x2*)(H + (size_t)t * DM) + lane;
#pragma unroll
        for (int j = 0; j < 16; ++j) { u32x2 o = {pk2(v[j][0], v[j][1]), pk2(v[j][2], v[j][3])}; o8[64 * j] = o; }
        for (int h = 0; h < 16; ++h) {
            const f32x4* wr = (const f32x4*)(WFT + (size_t)h * DM) + lane; float d = 0.f;
#pragma unroll
            for (int j = 0; j < 16; ++j) { const f32x4 w = wr[64 * j]; d += (v[j][0] * w[0] + v[j][1] * w[1]) + (v[j][2] * w[2] + v[j][3] * w[3]); }
            d = wave_sum(d);
            if (lane == 0) { const float z = d + fbias[h]; FLOGF[(size_t)h * T_ + t] = fminf(z, 0.f) - log1pf(__expf(-fabsf(z))); }
        }
    }
}
__global__ void __launch_bounds__(512, 2) k_post1(const float* PROJ, const float* qg, const float* kg, const float* lbw,
                                                  bf16_t* FQ, bf16_t* FK, bf16_t* FV, bf16_t* HQ, bf16_t* HK, bf16_t* HV, bf16_t* HG, float* HLF) {
    const int tid = threadIdx.x, lane = tid & 63, wave = tid >> 6;
    for (int t = blockIdx.x * 8 + wave; t < T_; t += gridDim.x * 8) {
        const float* row = PROJ + (size_t)t * NPROJ;
        for (int s = 0; s < 112; ++s) {
            const int ty = s >> 4, h = s & 15, c = 2 * lane;
            const f32x2 p = *(const f32x2*)(row + s * 128 + c);
            const size_t o = ((size_t)h * T_ + t) * HDIM + c;
            if (ty < 2) {
                const float rs = rsqrtf(wave_sum(p[0] * p[0] + p[1] * p[1]) * (1.f / HDIM) + EPS_);
                const float* g = (ty == 0 ? qg : kg) + h * HDIM + c;
                *(unsigned*)((ty == 0 ? FQ : FK) + o) = pk2(p[0] * rs * g[0], p[1] * rs * g[1]);
            } else if (ty == 2) { *(unsigned*)(FV + o) = pk2(p[0], p[1]); }
            else if (ty == 3) { *(unsigned*)(HQ + o) = pk2(silu_f(p[0]) * 0.08838834764831845f, silu_f(p[1]) * 0.08838834764831845f); }
            else if (ty == 4) {
                const int j = h * HDIM + c;
                const float lb0 = 1.f / (1.f + __expf(lbw[HGW + j] - lbw[j])), lb1 = 1.f / (1.f + __expf(lbw[HGW + j + 1] - lbw[j + 1]));
                const float f0 = lb0 + (1.f - lb0) * sigmoid_f(p[0]), f1 = lb1 + (1.f - lb1) * sigmoid_f(p[1]);
                *(f32x2*)(HLF + o) = (f32x2){__logf(f0), __logf(f1)};
                *(unsigned*)(HK + o) = pk2(1.f - f0, 1.f - f1);
            } else if (ty == 5) { *(unsigned*)(HV + o) = pk2(p[0], p[1]); }
            else { *(unsigned*)(HG + o) = pk2(silu_f(p[0]), silu_f(p[1])); }
        }
    }
}
__global__ void __launch_bounds__(512, 2) k_scan(const float* FLOGF, float* FCUM) {
    __shared__ float part[512];
    const int tid = threadIdx.x;
    for (int h = blockIdx.x; h < NHEAD; h += gridDim.x) {
        const float* src = FLOGF + (size_t)h * T_ + tid * 16; float v[16]; float s = 0.f;
#pragma unroll
        for (int i = 0; i < 16; ++i) { s += src[i]; v[i] = s; }
        part[tid] = s; __syncthreads();
        if (tid == 0) { float run = 0.f; for (int i = 0; i < 512; ++i) { const float p = part[i]; part[i] = run; run += p; } }
        __syncthreads();
        const float off = part[tid]; float* dst = FCUM + (size_t)h * T_ + tid * 16;
#pragma unroll
        for (int i = 0; i < 16; ++i) dst[i] = v[i] + off;
        __syncthreads();
    }
}
namespace fox {
constexpr int B = 1, H = NHEAD, HKV = NHEAD, SQ = T_, SKV = T_, D = HDIM, QOFF = 0, WINDOW = SKV;
constexpr float THR = 8.f;
constexpr bool WSKIP = false;
constexpr float SCALE = 0.08838834764831845f;
constexpr float INV_SCALE = 11.313708498984761f;
constexpr int NW = 8, QBLK = 32, KVBLK = 64, QB = NW * QBLK;
constexpr int SHM_V = KVBLK * D * 2, SHM_K = KVBLK * D * 2;
constexpr int LDS_BYTES = 2 * SHM_V + 2 * SHM_K + NW * 64 * 4;
constexpr int CUM_OFF = LDS_BYTES;
constexpr int OST = 4096;
static_assert(D == 128 && SQ % QB == 0 && SKV % KVBLK == 0 && H % HKV == 0 && QOFF >= 0 && QOFF + SQ <= SKV && WINDOW >= 1, "geometry");

using bf16 = __hip_bfloat16;
typedef short bf16x8 __attribute__((ext_vector_type(8)));
typedef short s16x4 __attribute__((ext_vector_type(4)));
typedef float f32x16 __attribute__((ext_vector_type(16)));
typedef float f32x4 __attribute__((ext_vector_type(4)));
typedef unsigned u32x4 __attribute__((ext_vector_type(4)));
template <class A, class Bt> struct same_t { static constexpr bool v = false; };
template <class A> struct same_t<A, A> { static constexpr bool v = true; };

#define KSWZ(row, colB) ((row) * 256 + ((colB) ^ (((row) & 7) << 4)))
#define SBAR() __builtin_amdgcn_sched_barrier(0)
__device__ __forceinline__ int v_st(int k, int c) { const int kk = (k & ~0xC) | ((k & 4) << 1) | ((k & 8) >> 1); return ((kk >> 3) * 4 + (c >> 5)) * 512 + ((kk & 7) * 32 + (c & 31)) * 2; }
__device__ __forceinline__ int v_rd_base(int lane) { return ((lane & 3) << 3) | (((lane >> 2) & 3) << 6) | (((lane >> 4) & 1) << 5) | (((lane >> 5) & 1) << 8); }
constexpr int v_rd_off(int d0, int ks, int half) { return d0 * 512 + ks * 4096 + half * 2048; }
__device__ __forceinline__ int crow(int r, int hi) { return (r & 3) + 8 * (r >> 2) + 4 * hi; }
__device__ __forceinline__ unsigned cvtpk(float lo, float hi) {
    unsigned r; asm volatile("v_cvt_pk_bf16_f32 %0, %1, %2" : "=v"(r) : "v"(lo), "v"(hi)); return r;
}
__device__ __forceinline__ bf16x8 pack8(f32x4 a, f32x4 b) {
    u32x4 w = {cvtpk(a[0], a[1]), cvtpk(a[2], a[3]), cvtpk(b[0], b[1]), cvtpk(b[2], b[3])};
    return *reinterpret_cast<bf16x8*>(&w);
}
template <class T> __device__ __forceinline__ bf16x8 load8(const T* p) {
    if constexpr (same_t<T, float>::v) { return pack8(*(const f32x4*)p, *(const f32x4*)(p + 4)); }
    else { return *reinterpret_cast<const bf16x8*>(p); }
}
__device__ __forceinline__ void mask_tile(f32x16& p0, f32x16& p1, int dq, unsigned W) {
    const float NEG = -__builtin_inff();
#pragma unroll
    for (int r = 0; r < 16; ++r) {
        const int c = (r & 3) + 8 * (r >> 2);
        if ((unsigned)(dq - c) >= W) p0[r] = NEG;
        if ((unsigned)(dq - c - 32) >= W) p1[r] = NEG;
    }
}
__device__ __forceinline__ void partialSM(f32x16& p0, f32x16& p1, float& m_reg, float& mn, float& alpha) {
    float pmax = p0[0]; for (int r = 1; r < 16; ++r) pmax = fmaxf(pmax, p0[r]); for (int r = 0; r < 16; ++r) pmax = fmaxf(pmax, p1[r]);
    { auto rr = __builtin_amdgcn_permlane32_swap(__float_as_uint(pmax), __float_as_uint(pmax), false, false);
      pmax = fmaxf(__uint_as_float(rr[0]), __uint_as_float(rr[1])); }
    constexpr float C2 = 1.4426950408889634f * SCALE;
    if (__builtin_expect(__all((pmax - m_reg) * SCALE <= THR), 1)) { mn = m_reg; alpha = 1.f; }
    else { mn = fmaxf(m_reg, pmax); alpha = __builtin_amdgcn_exp2f((m_reg - mn) * C2); m_reg = mn; }
    const float mnL = -mn * C2;
    for (int r = 0; r < 16; ++r) p0[r] = fmaf(p0[r], C2, mnL); for (int r = 0; r < 16; ++r) p1[r] = fmaf(p1[r], C2, mnL);
    for (int r = 0; r < 16; ++r) p0[r] = __builtin_amdgcn_exp2f(p0[r]);
}
__device__ __forceinline__ void finishSM(f32x16& p0, f32x16& p1, float alpha, float& l_reg, bf16x8& pa0, bf16x8& pa1, bf16x8& pa2, bf16x8& pa3) {
    for (int r = 0; r < 16; ++r) p1[r] = __builtin_amdgcn_exp2f(p1[r]);
    float ps = 0; for (int r = 0; r < 16; ++r) ps += p0[r]; for (int r = 0; r < 16; ++r) ps += p1[r];
    { auto rr = __builtin_amdgcn_permlane32_swap(__float_as_uint(ps), __float_as_uint(ps), false, false);
      ps = __uint_as_float(rr[0]) + __uint_as_float(rr[1]); }
    l_reg = l_reg * alpha + ps;
#define PK4(P, B_, OUT) do { unsigned a0 = cvtpk(P[B_+0], P[B_+1]), a1 = cvtpk(P[B_+2], P[B_+3]);                          \
        unsigned b0 = cvtpk(P[B_+4], P[B_+5]), b1 = cvtpk(P[B_+6], P[B_+7]);                                             \
        auto r0 = __builtin_amdgcn_permlane32_swap(a0, b0, false, false); auto r1 = __builtin_amdgcn_permlane32_swap(a1, b1, false, false); \
        u32x4 w = {r0[0], r1[0], r0[1], r1[1]}; OUT = *reinterpret_cast<bf16x8*>(&w); } while (0)
    PK4(p0, 0, pa0); PK4(p0, 8, pa1); PK4(p1, 0, pa2); PK4(p1, 8, pa3);
#undef PK4
}
template <int KB, bool SK>
__device__ __forceinline__ void qkt(f32x16& p0, f32x16& p1, const char* K_lds, int r32, int hi, const bf16x8* qr, bool act, const float* cb, float ci) {
    if (SK && !act) { const float NEG = -__builtin_inff();
#pragma unroll
        for (int r = 0; r < 16; ++r) { p0[r] = NEG; p1[r] = NEG; } return; }
#pragma unroll
    for (int g = 0; g < 4; ++g) { const f32x4 c0 = *(const f32x4*)(cb + 8 * g), c1 = *(const f32x4*)(cb + 32 + 8 * g);
#pragma unroll
        for (int e = 0; e < 4; ++e) { p0[4 * g + e] = (ci - c0[e]) * INV_SCALE; p1[4 * g + e] = (ci - c1[e]) * INV_SCALE; } }
    const char* kb[4];
#pragma unroll
    for (int dd = 0; dd < 4; ++dd) kb[dd] = K_lds + KB * SHM_K + KSWZ(r32, (dd * 16 + hi * 8) * 2);
#pragma unroll
    for (int d0 = 0; d0 < 8; ++d0) { const char* a = kb[d0 & 3] + (d0 >> 2) * 128;
        bf16x8 b0 = *reinterpret_cast<const bf16x8*>(a);
        bf16x8 b1 = *reinterpret_cast<const bf16x8*>(a + 32 * 256);
        p0 = __builtin_amdgcn_mfma_f32_32x32x16_bf16(b0, qr[d0], p0, 0, 0, 0);
        p1 = __builtin_amdgcn_mfma_f32_32x32x16_bf16(b1, qr[d0], p1, 0, 0, 0); }
}
template <int VB, bool SK>
__device__ __forceinline__ void pv_tile(f32x16* o, int vb0, bf16x8 pa0, bf16x8 pa1, bf16x8 pa2, bf16x8 pa3, bool act) {
    if (SK && !act) return;
#define TRRD(dst, off) asm volatile("ds_read_b64_tr_b16 %0, %1 offset:%2" : "=&v"(dst) : "v"(vb0), "i"(off) : "memory")
#define PV_D0(d0) do { s16x4 l0, l1, l2, l3, h0, h1, h2, h3; constexpr int b_ = VB * SHM_V + v_rd_off(d0, 0, 0);     \
        TRRD(l0, b_); TRRD(h0, b_ + 2048); TRRD(l1, b_ + 4096); TRRD(h1, b_ + 6144); TRRD(l2, b_ + 8192); TRRD(h2, b_ + 10240); TRRD(l3, b_ + 12288); TRRD(h3, b_ + 14336); \
        asm volatile("s_waitcnt lgkmcnt(0)" ::: "memory"); SBAR();                 \
        o[d0] = __builtin_amdgcn_mfma_f32_32x32x16_bf16(pa0, (bf16x8){l0[0], l0[1], l0[2], l0[3], h0[0], h0[1], h0[2], h0[3]}, o[d0], 0, 0, 0);   \
        o[d0] = __builtin_amdgcn_mfma_f32_32x32x16_bf16(pa1, (bf16x8){l1[0], l1[1], l1[2], l1[3], h1[0], h1[1], h1[2], h1[3]}, o[d0], 0, 0, 0);   \
        o[d0] = __builtin_amdgcn_mfma_f32_32x32x16_bf16(pa2, (bf16x8){l2[0], l2[1], l2[2], l2[3], h2[0], h2[1], h2[2], h2[3]}, o[d0], 0, 0, 0);   \
        o[d0] = __builtin_amdgcn_mfma_f32_32x32x16_bf16(pa3, (bf16x8){l3[0], l3[1], l3[2], l3[3], h3[0], h3[1], h3[2], h3[3]}, o[d0], 0, 0, 0); } while (0)
    PV_D0(0); PV_D0(1); PV_D0(2); PV_D0(3);
#undef PV_D0
#undef TRRD
}

template <class TIn, class TOut> struct BlockRef { const TIn* Q; const TIn* K; const TIn* V; TOut* O; int P0; };
template <class TIn> struct Seam {
    bf16x8 qr[8];
    bf16x8 st_v0, st_v1, st_k0, st_k1; f32x4 sf0, sf1, sf2, sf3;
    f32x4 tq[16];
};
__device__ __forceinline__ int swa_jlo(int P0, int W) { const int lowk = P0 - W + 1; return lowk > 0 ? lowk / KVBLK : 0; }
#define ROW(p, k0, rr) ((p) + (size_t)((k0) + (rr)) * D + sc)
#define VMW() asm volatile("s_waitcnt vmcnt(0)" ::: "memory")
#define VMWN(n) asm volatile("s_waitcnt vmcnt(%0)" :: "i"(n) : "memory")
#define SLOAD_H(Kp, Vp, k0) do { S.st_v0 = load8<TIn>(ROW(Vp, k0, sr)); S.st_v1 = load8<TIn>(ROW(Vp, k0, 32 + sr));              \
                         S.st_k0 = load8<TIn>(ROW(Kp, k0, sr)); S.st_k1 = load8<TIn>(ROW(Kp, k0, 32 + sr)); } while (0)
#define SWRITE_HK(bf) do { *(bf16x8*)(K_lds + (bf) * SHM_K + kws) = S.st_k0; *(bf16x8*)(K_lds + (bf) * SHM_K + kws + 32 * 256) = S.st_k1; } while (0)
#define SWRITE_HV(bf) do { *(bf16x8*)(V_lds + (bf) * SHM_V + vst0) = S.st_v0; *(bf16x8*)(V_lds + (bf) * SHM_V + vst1) = S.st_v1; } while (0)
#define SWRITE_H(bf) do { SWRITE_HV(bf); SWRITE_HK(bf); } while (0)
#define SLOAD_F(p, k0) do { S.sf0 = *(const f32x4*)ROW(p, k0, sr); S.sf1 = *(const f32x4*)(ROW(p, k0, sr) + 4);                \
                            S.sf2 = *(const f32x4*)ROW(p, k0, 32 + sr); S.sf3 = *(const f32x4*)(ROW(p, k0, 32 + sr) + 4); } while (0)
#define SWRITE_KF(bf) do { *(bf16x8*)(K_lds + (bf) * SHM_K + kws) = pack8(S.sf0, S.sf1); *(bf16x8*)(K_lds + (bf) * SHM_K + kws + 32 * 256) = pack8(S.sf2, S.sf3); } while (0)
#define SWRITE_VF(bf) do { *(bf16x8*)(V_lds + (bf) * SHM_V + vst0) = pack8(S.sf0, S.sf1); *(bf16x8*)(V_lds + (bf) * SHM_V + vst1) = pack8(S.sf2, S.sf3); } while (0)
template <class TIn, class TOut>
__device__ __forceinline__ void causal_swa_prime(const BlockRef<TIn, TOut>& cur, int W, char* lds, Seam<TIn>& S) {
    constexpr bool F32 = same_t<TIn, float>::v;
    const int tid = threadIdx.x, wid = __builtin_amdgcn_readfirstlane(tid >> 6), lane = tid & 63, r32 = lane & 31, hi = lane >> 5;
    const int sr = tid >> 4, sc = (tid & 15) * 8, kws = KSWZ(sr, sc * 2); char* K_lds = lds + 2 * SHM_V;
    const int kb0 = swa_jlo(cur.P0, W) * KVBLK;
    for (int d0 = 0; d0 < 8; ++d0) S.qr[d0] = load8<TIn>(cur.Q + (size_t)(wid * QBLK + r32) * D + d0 * 16 + hi * 8);
    if constexpr (F32) { SLOAD_F((const float*)cur.K, kb0); VMW(); SWRITE_KF(0); SBAR(); SLOAD_F((const float*)cur.V, kb0); }
    else { SLOAD_H(cur.K, cur.V, kb0); VMW(); SWRITE_HK(0); }
    __syncthreads();
}
template <class TIn, class TOut>
__device__ __forceinline__ void causal_swa_block(const BlockRef<TIn, TOut>& cur, const BlockRef<TIn, TOut>& nxt, int skv, int W, char* lds, Seam<TIn>& S) {
    constexpr bool F32 = same_t<TIn, float>::v;
    const int tid = threadIdx.x, wid = __builtin_amdgcn_readfirstlane(tid >> 6), lane = tid & 63, r32 = lane & 31, hi = lane >> 5;
    const int j_lo = swa_jlo(cur.P0, W);
    int j_hi = (cur.P0 + QB - 1) / KVBLK + 1; if (j_hi > skv / KVBLK) j_hi = skv / KVBLK;
    const int NT = j_hi - j_lo;
    const int kbn = swa_jlo(nxt.P0, W) * KVBLK;
    const int qlo = cur.P0 + wid * QBLK, qm = qlo + r32 - 4 * hi;
    char* V_lds = lds; char* K_lds = lds + 2 * SHM_V;
    float* ws = (float*)(lds + 2 * SHM_V + 2 * SHM_K) + wid * 64; float* li_l = ws, * al_l = ws + 32;
    const float* cum = (const float*)(lds + CUM_OFF); const float ci = cum[cur.P0 + wid * QBLK + r32];
    float m_reg = -1e30f, l_reg = 0; f32x16 o[4] = {};
    const int sr = tid >> 4, sc = (tid & 15) * 8, vst0 = v_st(sr, sc), vst1 = v_st(32 + sr, sc), kws = KSWZ(sr, sc * 2);
    const int vb0 = (int)(uintptr_t)V_lds + v_rd_base(lane);
    const TIn* Kh = cur.K; const TIn* Vh = cur.V;
#define RESC(a) do { if (__any((a) < 1.f)) { if (hi == 0) al_l[r32] = (a); asm volatile("s_waitcnt lgkmcnt(0)" ::: "memory");              \
                     for (int d_ = 0; d_ < 4; ++d_) for (int r = 0; r < 16; ++r) o[d_][r] *= al_l[crow(r, hi)]; } } while (0)
#define KBASE(t) ((j_lo + (t)) * KVBLK)
#define CUMT(t) (cum + KBASE(t) + 4 * hi)
#define ACT(t) (KBASE(t) <= qlo + QBLK - 1 && KBASE(t) + KVBLK - 1 >= qlo - W + 1)
#define MASKT(P0_, P1_, t) do { const int kb_ = KBASE(t); if ((!SK || ACT(t)) && (kb_ + KVBLK - 1 > qlo || kb_ <= qlo + QBLK - 1 - W)) mask_tile(P0_, P1_, qm - kb_, (unsigned)W); } while (0)
    constexpr int NQL = F32 ? 16 : 8;
    constexpr bool SK = WSKIP && !F32;
#define SEAM_K0() do { VMWN(NQL); if constexpr (F32) { SWRITE_KF(0); SBAR(); SLOAD_F((const float*)nxt.V, kbn); } else { SWRITE_HK(0); } SBAR(); } while (0)
    f32x16 pA0, pA1, pB0, pB1; float mnA, mnB, alA, alB; bf16x8 pa0, pa1, pa2, pa3;
    if constexpr (F32) { VMW(); SWRITE_VF(0); SBAR(); } else { SWRITE_HV(0); SBAR(); }
    if (NT > 1) { if constexpr (F32) SLOAD_F((const float*)Kh, KBASE(1)); else SLOAD_H(Kh, Vh, KBASE(1)); }
    SBAR(); qkt<0, SK>(pA0, pA1, K_lds, r32, hi, S.qr, ACT(0), CUMT(0), ci);
    if constexpr (F32) { if (NT > 1) { VMW(); SWRITE_KF(1); SBAR(); SLOAD_F((const float*)Vh, KBASE(1)); } }
    MASKT(pA0, pA1, 0); partialSM(pA0, pA1, m_reg, mnA, alA);
    if (NT > 1) { VMW(); if constexpr (F32) { SWRITE_VF(1); SBAR(); if (NT > 2) SLOAD_F((const float*)Kh, KBASE(2)); } else SWRITE_H(1); }
    __syncthreads();
#define HALF_STEP(PX0, PX1, mnX, alX, PY0, PY1, alY, t, KB, VB, SB) do {                                                      \
        SBAR(); qkt<KB, SK>(PX0, PX1, K_lds, r32, hi, S.qr, ACT(t), CUMT(t), ci);                                             \
        finishSM(PY0, PY1, alY, l_reg, pa0, pa1, pa2, pa3); SBAR();                                                           \
        if ((t) + 1 < NT) { if constexpr (F32) { VMW(); SWRITE_KF(SB); SBAR(); SLOAD_F((const float*)Vh, KBASE((t) + 1)); }  \
                            else { SLOAD_H(Kh, Vh, KBASE((t) + 1)); } SBAR(); }                                               \
        pv_tile<VB, SK>(o, vb0, pa0, pa1, pa2, pa3, ACT((t) - 1)); MASKT(PX0, PX1, (t)); partialSM(PX0, PX1, m_reg, mnX, alX);                                        \
        __syncthreads();                                                                                                      \
        if ((t) + 1 < NT) { VMW(); if constexpr (F32) { SWRITE_VF(SB); SBAR(); if ((t) + 2 < NT) SLOAD_F((const float*)Kh, KBASE((t) + 2)); } \
                            else { SWRITE_H(SB); } }                                                                          \
        RESC(alX); __syncthreads(); } while (0)
    for (int t = 1; t + 1 < NT; t += 2) {
        HALF_STEP(pB0, pB1, mnB, alB, pA0, pA1, alA, t, 1, 0, 0);
        HALF_STEP(pA0, pA1, mnA, alA, pB0, pB1, alB, t + 1, 0, 1, 1);
    }
    const bool even = (NT & 1) == 0;
    if (even) { SBAR(); qkt<1, SK>(pB0, pB1, K_lds, r32, hi, S.qr, ACT(NT - 1), CUMT(NT - 1), ci); SBAR(); }
#define QROW(e) (nxt.Q + (size_t)(wid * QBLK + r32) * D + ((e) >> 1) * 16 + hi * 8 + ((e) & 1) * 4)
    if constexpr (F32) { SLOAD_F((const float*)nxt.K, kbn); SBAR();
#pragma unroll
        for (int e = 0; e < 8; ++e) S.tq[e] = *(const f32x4*)QROW(e); }
    else { SLOAD_H(nxt.K, nxt.V, kbn); SBAR();
#pragma unroll
        for (int d0 = 0; d0 < 8; ++d0) S.qr[d0] = load8<TIn>(nxt.Q + (size_t)(wid * QBLK + r32) * D + d0 * 16 + hi * 8); }
    SBAR();
    finishSM(pA0, pA1, alA, l_reg, pa0, pa1, pa2, pa3); SBAR();
    if constexpr (F32) {
#pragma unroll
        for (int e = 8; e < 16; ++e) S.tq[e] = *(const f32x4*)QROW(e); SBAR(); }
#undef QROW
    pv_tile<0, SK>(o, vb0, pa0, pa1, pa2, pa3, ACT(even ? NT - 2 : NT - 1));
    if (even) { MASKT(pB0, pB1, NT - 1); partialSM(pB0, pB1, m_reg, mnB, alB); __syncthreads(); RESC(alB);
        finishSM(pB0, pB1, alB, l_reg, pa0, pa1, pa2, pa3); SBAR(); pv_tile<1, SK>(o, vb0, pa0, pa1, pa2, pa3, ACT(NT - 1)); }
    SBAR(); SEAM_K0();
    if (hi == 0) li_l[r32] = l_reg; asm volatile("s_waitcnt lgkmcnt(0)" ::: "memory");
    float rli[16];
#pragma unroll
    for (int r = 0; r < 16; ++r) rli[r] = __builtin_amdgcn_rcpf(li_l[crow(r, hi)]);
    TOut* Ow = cur.O + (size_t)(wid * QBLK) * OST;
#pragma unroll
    for (int r = 0; r < 16; ++r) { const int orow = crow(r, hi);
#pragma unroll
        for (int d0 = 0; d0 < 4; ++d0) { const float v = o[d0][r] * rli[r];
            if constexpr (same_t<TOut, float>::v) { Ow[(size_t)orow * OST + d0 * 32 + r32] = v; }
            else { const float vn = __shfl_xor(v, 1);
                   if ((r32 & 1) == 0) *(unsigned*)(Ow + (size_t)orow * OST + d0 * 32 + r32) = cvtpk(v, vn); } } }
    if constexpr (F32) {
#pragma unroll
        for (int d0 = 0; d0 < 8; ++d0) S.qr[d0] = pack8(S.tq[2 * d0], S.tq[2 * d0 + 1]); }
    __syncthreads();
#undef RESC
#undef KBASE
#undef CUMT
#undef ACT
#undef MASKT
#undef SEAM_K0
#undef HALF_STEP
}
#undef ROW
#undef VMW
#undef VMWN
#undef SLOAD_H
#undef SWRITE_HK
#undef SWRITE_HV
#undef SWRITE_H
#undef SLOAD_F
#undef SWRITE_KF
#undef SWRITE_VF

constexpr int ATT_LDS = CUM_OFF + SKV * 4;
__device__ __forceinline__ void attn_phase(char* lds, const bf16* FQ, const bf16* FK, const bf16* FV, const float* FCUM, bf16* MERGED) {
    constexpr int NQB = SQ / QB, NX = NQB / 2, TOTAL = NX * H;
    { const int L = blockIdx.x; if (L >= TOTAL) return;
        const int h = L / NX, x = L % NX;
        __syncthreads();
        { float* cum = (float*)(lds + CUM_OFF); const float* src = FCUM + (size_t)h * SKV;
          for (int i = threadIdx.x; i < SKV / 4; i += 512) *(f32x4*)(cum + 4 * i) = *(const f32x4*)(src + 4 * i); }
        __syncthreads();
        BlockRef<bf16, bf16> b0, b1;
        const size_t hb = (size_t)h * SKV * D;
        b0.Q = FQ + hb + (size_t)x * QB * D; b0.K = FK + hb; b0.V = FV + hb; b0.O = MERGED + (size_t)x * QB * OST + h * D; b0.P0 = x * QB;
        const int y = NQB - 1 - x;
        b1.Q = FQ + hb + (size_t)y * QB * D; b1.K = FK + hb; b1.V = FV + hb; b1.O = MERGED + (size_t)y * QB * OST + h * D; b1.P0 = y * QB;
        Seam<bf16> S;
        causal_swa_prime<bf16, bf16>(b0, WINDOW, lds, S);
        BlockRef<bf16, bf16> cur = b0; int pass = 0;
        for (;;) { const bool last = pass == 1; const BlockRef<bf16, bf16> nxt = last ? cur : b1;
            causal_swa_block<bf16, bf16>(cur, nxt, SKV, WINDOW, lds, S);
            if (last) break; cur = nxt; pass = 1; }
    }
}
}
__global__ void __launch_bounds__(512, 2) k_attn(const bf16_t* FQ, const bf16_t* FK, const bf16_t* FV, const float* FCUM, bf16_t* MERGED) {
    extern __shared__ __attribute__((aligned(16))) unsigned char lds[];
    fox::attn_phase((char*)lds, (const fox::bf16*)FQ, (const fox::bf16*)FK, (const fox::bf16*)FV, FCUM, (fox::bf16*)MERGED);
}

__global__ void __launch_bounds__(512, 2) k_hgrn_seq(const bf16_t* HQ, const bf16_t* HK, const bf16_t* HV, const float* HLF, float* HO) {
    const int tid = threadIdx.x, lane = tid & 63, wave = tid >> 6;
    for (int it = blockIdx.x; it < NHEAD * 16; it += gridDim.x) {
        const int h = it >> 4, vc = (it & 15) * 8 + wave;
        const size_t hb = (size_t)h * T_ * HDIM;
        float Sa = 0.f, Sb = 0.f;
        for (int t0 = 0; t0 < T_; t0 += 8) {
            float fa[8], fb[8], ka[8], kb[8], qa[8], qb[8], vv[8];
#pragma unroll
            for (int i = 0; i < 8; ++i) { const size_t r = hb + (size_t)(t0 + i) * HDIM;
                fa[i] = HLF[r + lane]; fb[i] = HLF[r + lane + 64];
                ka[i] = bf2f(HK[r + lane]); kb[i] = bf2f(HK[r + lane + 64]);
                qa[i] = bf2f(HQ[r + lane]); qb[i] = bf2f(HQ[r + lane + 64]);
                vv[i] = bf2f(HV[r + vc]); }
            float p[8];
#pragma unroll
            for (int i = 0; i < 8; ++i) { Sa = expf(fa[i]) * Sa + ka[i] * vv[i]; Sb = expf(fb[i]) * Sb + kb[i] * vv[i]; p[i] = qa[i] * Sa + qb[i] * Sb; }
#pragma unroll
            for (int i = 0; i < 8; ++i) p[i] = wave_sum(p[i]);
            if (lane < 8) { float o = p[0];
#pragma unroll
                for (int i = 1; i < 8; ++i) o = (lane == i) ? p[i] : o;
                HO[hb + (size_t)(t0 + lane) * HDIM + vc] = o; }
        }
    }
}
__global__ void __launch_bounds__(512, 2) k_hgrn_post(const float* HO, const bf16_t* HG, const float* og, bf16_t* MERGED) {
    const int tid = threadIdx.x, lane = tid & 63, wave = tid >> 6;
    for (int i = blockIdx.x * 8 + wave; i < T_ * NHEAD; i += gridDim.x * 8) {
        const int h = i / T_, t = i % T_, c = 2 * lane;
        const size_t r = ((size_t)h * T_ + t) * HDIM + c;
        const f32x2 o = *(const f32x2*)(HO + r);
        const float rs = rsqrtf(wave_sum(o[0] * o[0] + o[1] * o[1]) * (1.f / HDIM) + EPS_);
        const unsigned g = *(const unsigned*)(HG + r);
        const float g0 = bf2f(g & 0xffffu), g1 = bf2f(g >> 16);
        *(unsigned*)(MERGED + (size_t)t * DM + FOXW + h * HDIM + c) = pk2(o[0] * rs * og[h * HDIM + c] * g0, o[1] * rs * og[h * HDIM + c + 1] * g1);
    }
}
__global__ void __launch_bounds__(512, 2) k_post2(const float* x, const float* MIX, const float* mod, const float* ada_b, const float* g2, float* OUT, bf16_t* H) {
    extern __shared__ __attribute__((aligned(16))) unsigned char lds[];
    float* A2 = (float*)lds; float* B2 = A2 + DM; float* G1 = B2 + DM;
    const int tid = threadIdx.x, lane = tid & 63, wave = tid >> 6;
    for (int i = tid; i < DM; i += 512) { G1[i] = mod[2 * DM + i] + ada_b[2 * DM + i]; A2[i] = g2[i] * (1.f + mod[4 * DM + i] + ada_b[4 * DM + i]); B2[i] = mod[3 * DM + i] + ada_b[3 * DM + i]; }
    __syncthreads();
    for (int t = blockIdx.x * 8 + wave; t < T_; t += gridDim.x * 8) {
        const f32x4* xr = (const f32x4*)(x + (size_t)t * DM) + lane; const f32x4* mr = (const f32x4*)(MIX + (size_t)t * DM) + lane;
        f32x4* orow = (f32x4*)(OUT + (size_t)t * DM) + lane;
        f32x4 v[16]; float ss = 0.f;
#pragma unroll
        for (int j = 0; j < 16; ++j) { const f32x4 g = *(const f32x4*)(G1 + 4 * lane + 256 * j); v[j] = xr[64 * j] + g * mr[64 * j]; orow[64 * j] = v[j];
            ss += (v[j][0] * v[j][0] + v[j][1] * v[j][1]) + (v[j][2] * v[j][2] + v[j][3] * v[j][3]);
            if ((j & 3) == 3) asm volatile("" ::: "memory"); }
        const float rstd = rsqrtf(wave_sum(ss) * (1.f / DM) + EPS_);
        u32x2* o8 = (u32x2*)(H + (size_t)t * DM) + lane;
#pragma unroll
        for (int j = 0; j < 16; ++j) { const f32x4 a = *(const f32x4*)(A2 + 4 * lane + 256 * j), b = *(const f32x4*)(B2 + 4 * lane + 256 * j);
            const f32x4 hh = v[j] * rstd * a + b; u32x2 o = {pk2(hh[0], hh[1]), pk2(hh[2], hh[3])}; o8[64 * j] = o; }
    }
}
__global__ void __launch_bounds__(512, 2) k_scores(const float* QP, const float* keys, float* SC) {
    extern __shared__ __attribute__((aligned(16))) unsigned char lds[];
    float* Ks = (float*)lds;
    float* Qs = Ks + 128 * 132;
    const int tid = threadIdx.x, n = tid & 127, tq = tid >> 7;
    for (int it = blockIdx.x; it < 16 * (T_ / 64); it += gridDim.x) {
        const int hp = it % 16, t0 = (it / 16) * 64;
        __syncthreads();
        for (int i = tid; i < 128 * 32; i += 512) { const int r = i >> 5, c4 = i & 31; *(f32x4*)(Ks + r * 132 + 4 * c4) = *(const f32x4*)(keys + ((size_t)hp * 128 + r) * 128 + 4 * c4); }
        for (int i = tid; i < 64 * 32; i += 512) { const int r = i >> 5, c4 = i & 31; *(f32x4*)(Qs + r * 128 + 4 * c4) = *(const f32x4*)(QP + (size_t)(t0 + r) * PEER_QW + hp * 128 + 4 * c4); }
        __syncthreads();
        float acc[16];
#pragma unroll
        for (int j = 0; j < 16; ++j) acc[j] = 0.f;
        for (int d = 0; d < 128; d += 4) {
            const f32x4 kv = *(const f32x4*)(Ks + n * 132 + d);
#pragma unroll
            for (int j = 0; j < 16; ++j) { const f32x4 q = *(const f32x4*)(Qs + (tq * 16 + j) * 128 + d); acc[j] += (q[0] * kv[0] + q[1] * kv[1]) + (q[2] * kv[2] + q[3] * kv[3]); }
        }
#pragma unroll
        for (int j = 0; j < 16; ++j) SC[((size_t)(t0 + tq * 16 + j) * 16 + hp) * 128 + n] = acc[j];
    }
}
__device__ __forceinline__ unsigned fkey(float f) { const unsigned u = __builtin_bit_cast(unsigned, f); return (u & 0x80000000u) ? ~u : (u | 0x80000000u); }
__device__ __forceinline__ float fkey_inv(unsigned k) { const unsigned u = (k & 0x80000000u) ? (k & 0x7fffffffu) : ~k; return __builtin_bit_cast(float, u); }
__device__ __forceinline__ unsigned long long wave_max_u64(unsigned long long v) {
#pragma unroll
    for (int o = 1; o < 64; o <<= 1) { const unsigned lo = __shfl_xor((unsigned)v, o), hi = __shfl_xor((unsigned)(v >> 32), o); const unsigned long long w = ((unsigned long long)hi << 32) | lo; v = w > v ? w : v; }
    return v;
}
__global__ void __launch_bounds__(512, 2) k_topk(const float* SC, int* PIDX, float* PGATE) {
    const int tid = threadIdx.x, lane = tid & 63, wave = tid >> 6;
    for (int i = blockIdx.x * 8 + wave; i < T_ * PEER_H; i += gridDim.x * 8) {
        const int t = i / PEER_H, h = i % PEER_H;
        float ts[2]; int ti[2];
#pragma unroll
        for (int p = 0; p < 2; ++p) {
            const float* s = SC + ((size_t)t * 16 + h * 2 + p) * 128;
            unsigned long long a = ((unsigned long long)fkey(s[lane]) << 32) | (unsigned)(127 - lane), b = ((unsigned long long)fkey(s[lane + 64]) << 32) | (unsigned)(127 - (lane + 64));
            float ms = 0.f; int mi = 0;
            for (int j = 0; j < 16; ++j) {
                const unsigned long long m = wave_max_u64(a > b ? a : b);
                if (a == m) a = 0ull; if (b == m) b = 0ull;
                if (lane == j) { ms = fkey_inv((unsigned)(m >> 32)); mi = 127 - (int)(m & 0xffffffffu); }
            }
            ts[p] = ms; ti[p] = mi;
        }
        unsigned long long cd[4];
#pragma unroll
        for (int c = 0; c < 4; ++c) { const int id = lane * 4 + c, ia = id >> 4, ib = id & 15;
            const float sa = __shfl(ts[0], ia), sb = __shfl(ts[1], ib); const int ea = __shfl(ti[0], ia), eb = __shfl(ti[1], ib);
            cd[c] = ((unsigned long long)fkey(sa + sb) << 32) | (unsigned)(0xffff - (ea * 128 + eb)); }
        float bs = 0.f; int be = 0;
        for (int j = 0; j < 16; ++j) {
            unsigned long long m = cd[0] > cd[1] ? cd[0] : cd[1]; const unsigned long long m2 = cd[2] > cd[3] ? cd[2] : cd[3]; m = m > m2 ? m : m2;
            m = wave_max_u64(m);
#pragma unroll
            for (int c = 0; c < 4; ++c) if (cd[c] == m) cd[c] = 0ull;
            if (lane == j) { bs = fkey_inv((unsigned)(m >> 32)); be = 0xffff - (int)(m & 0xffffffffu); }
        }
        const float mx = __shfl(bs, 0); float e = lane < 16 ? expf(bs - mx) : 0.f; const float den = wave_sum(e);
        if (lane < 16) { PIDX[(size_t)t * 128 + h * 16 + lane] = be; PGATE[(size_t)t * 128 + h * 16 + lane] = e / den; }
    }
}
template <class TW> __device__ __forceinline__ f32x4 ldw4(const TW* p);
template <> __device__ __forceinline__ f32x4 ldw4<float>(const float* p) { return *(const f32x4*)p; }
template <> __device__ __forceinline__ f32x4 ldw4<bf16_t>(const bf16_t* p) { const u32x2 w = *(const u32x2*)p; return (f32x4){bf2f(w.x & 0xffffu), bf2f(w.x >> 16), bf2f(w.y & 0xffffu), bf2f(w.y >> 16)}; }
template <class TW>
__global__ void __launch_bounds__(512, 2) k_expert(const bf16_t* H, const TW* U, const TW* V, const int* PIDX, const float* PGATE, const float* mod, const float* ada_b, float* OUT) {
    extern __shared__ __attribute__((aligned(16))) unsigned char lds[];
    float* red = (float*)lds;
    const int tid = threadIdx.x, lane = tid & 63, wave = tid >> 6;
    for (int t = blockIdx.x; t < T_; t += gridDim.x) {
        f32x4 hv[16];
#pragma unroll
        for (int j = 0; j < 16; ++j) hv[j] = ldw4<bf16_t>(H + (size_t)t * DM + 4 * lane + 256 * j);
        f32x4 acc[16];
#pragma unroll
        for (int j = 0; j < 16; ++j) acc[j] = (f32x4){0.f, 0.f, 0.f, 0.f};
        for (int k = 0; k < 16; ++k) {
            const int e = PIDX[(size_t)t * 128 + wave * 16 + k]; const float g = PGATE[(size_t)t * 128 + wave * 16 + k];
            const TW* ur = U + (size_t)e * DM + 4 * lane; float d = 0.f;
#pragma unroll
            for (int j = 0; j < 16; ++j) { const f32x4 w = ldw4<TW>(ur + 256 * j); d += (hv[j][0] * w[0] + hv[j][1] * w[1]) + (hv[j][2] * w[2] + hv[j][3] * w[3]); }
            d = wave_sum(d);
            const float a = g * 0.5f * d * (1.f + erff(d * 0.70710678118654752f));
            const TW* vr = V + (size_t)e * DM + 4 * lane;
#pragma unroll
            for (int j = 0; j < 16; ++j) acc[j] += ldw4<TW>(vr + 256 * j) * a;
        }
        __syncthreads();
#pragma unroll
        for (int j = 0; j < 16; ++j) *(f32x4*)(red + wave * DM + 4 * lane + 256 * j) = acc[j];
        __syncthreads();
        for (int c = tid; c < DM / 4; c += 512) {
            f32x4 s = *(const f32x4*)(red + 4 * c);
#pragma unroll
            for (int w = 1; w < 8; ++w) s += *(const f32x4*)(red + w * DM + 4 * c);
            const f32x4 g2 = *(const f32x4*)(mod + 5 * DM + 4 * c) + *(const f32x4*)(ada_b + 5 * DM + 4 * c);
            f32x4* o = (f32x4*)(OUT + (size_t)t * DM + 4 * c); *o = *o + g2 * s;
        }
    }
}
template <class Epi> __global__ __launch_bounds__(512, 2) void k_gemm(pg8::Gemm g, Epi E) {
    extern __shared__ __attribute__((aligned(16))) unsigned char shm[];
    pg8::StaticOrder S; S.init(g.M, g.N, (int)gridDim.x, (int)blockIdx.x);
    pg8::gemm_phase<Epi, pg8::StaticOrder, false>((PG8_LAS unsigned char*)shm, g, S, E, nullptr);
}

extern "C" void kernel_launch(void* const* d_in, const int* in_sizes, int n_in, void* d_out, int out_size, void* d_ws, size_t ws_size, hipStream_t stream) {
    static int grid = 0;
    if (!grid) {
        if (n_in != 17 || in_sizes[0] != T_ * DM || out_size != T_ * DM || ws_size < WS_END) { fprintf(stderr, "kernel_launch: unexpected shapes (n_in %d, in0 %d, out %d, ws %zu < %zu)\n", n_in, n_in > 0 ? in_sizes[0] : -1, out_size, ws_size, (size_t)WS_END); grid = -1; return; }
        int dev = 0, cus = 0; (void)hipGetDevice(&dev); (void)hipDeviceGetAttribute(&cus, hipDeviceAttributeMultiprocessorCount, dev); if (cus <= 0) cus = 256;
        (void)hipFuncSetAttribute((const void*)k_convert, hipFuncAttributeMaxDynamicSharedMemorySize, 131072);
        (void)hipFuncSetAttribute((const void*)k_norm1, hipFuncAttributeMaxDynamicSharedMemorySize, 32768);
        (void)hipFuncSetAttribute((const void*)k_post2, hipFuncAttributeMaxDynamicSharedMemorySize, 49152);
        (void)hipFuncSetAttribute((const void*)k_attn, hipFuncAttributeMaxDynamicSharedMemorySize, fox::ATT_LDS);
        (void)hipFuncSetAttribute((const void*)k_scores, hipFuncAttributeMaxDynamicSharedMemorySize, (128 * 132 + 64 * 128) * 4);
        (void)hipFuncSetAttribute((const void*)k_expert<float>, hipFuncAttributeMaxDynamicSharedMemorySize, 131072);
        (void)hipFuncSetAttribute((const void*)k_gemm<pg8::EpiF32>, hipFuncAttributeMaxDynamicSharedMemorySize, pg8::STAGE_BYTES);
        grid = cus;
    }
    if (grid < 0) return;
    const float* x = (const float*)d_in[0]; const float* c = (const float*)d_in[1]; const float* ada_w = (const float*)d_in[2]; const float* ada_b = (const float*)d_in[3];
    const float* g1 = (const float*)d_in[4]; const float* g2 = (const float*)d_in[5]; const float* w_in = (const float*)d_in[6]; const float* fbias = (const float*)d_in[7];
    const float* qg = (const float*)d_in[8]; const float* kg = (const float*)d_in[9]; const float* lbw = (const float*)d_in[10]; const float* og = (const float*)d_in[11];
    const float* w_out = (const float*)d_in[12]; const float* w_q = (const float*)d_in[13]; const float* keys = (const float*)d_in[14]; const float* pu = (const float*)d_in[15]; const float* pv = (const float*)d_in[16];
    unsigned char* ws = (unsigned char*)d_ws; float* out = (float*)d_out;
    float* mod = (float*)(ws + CTL_MOD);
    bf16_t *WinT = (bf16_t*)(ws + WS_WINT), *WoutT = (bf16_t*)(ws + WS_WOUTT), *WqT = (bf16_t*)(ws + WS_WQT), *Ubf = (bf16_t*)(ws + WS_UBF), *Vbf = (bf16_t*)(ws + WS_VBF), *H = (bf16_t*)(ws + WS_H);
    float* WFT = (float*)(ws + WS_WFT); float* FLOGF = (float*)(ws + WS_FLOGF); float* FCUM = (float*)(ws + WS_FCUM);
    bf16_t *FQ = (bf16_t*)(ws + WS_FQ), *FK = (bf16_t*)(ws + WS_FK), *FV = (bf16_t*)(ws + WS_FV), *HQ = (bf16_t*)(ws + WS_HQ), *HK = (bf16_t*)(ws + WS_HK), *HV = (bf16_t*)(ws + WS_HV), *HG = (bf16_t*)(ws + WS_HG);
    float* HLF = (float*)(ws + WS_HLF); float* HO = (float*)(ws + WS_HO); bf16_t* MERGED = (bf16_t*)(ws + WS_MERGED);
    float* QP = (float*)(ws + WS_QP); float* SC = (float*)(ws + WS_SC); int* PIDX = (int*)(ws + WS_PIDX); float* PGATE = (float*)(ws + WS_PGATE); float* PROJ = (float*)(ws + WS_PROJ);
    (void)Ubf; (void)Vbf;
    (void)hipMemsetAsync(ws + WS_CTL, 0, CTL_ZERO_BYTES, stream);
    k_convert<<<grid, 512, 131072, stream>>>(w_in, w_out, w_q, pu, pv, WinT, WoutT, WqT, WFT, Ubf, Vbf);
    k_adaln<<<grid, 512, 0, stream>>>(c, ada_w, mod);
    k_norm1<<<grid, 512, 32768, stream>>>(x, mod, ada_b, g1, WFT, fbias, H, FLOGF);
    { pg8::Gemm g{H, WinT, T_, NPROJ, DM}; pg8::EpiF32 E{PROJ, NPROJ, nullptr}; k_gemm<pg8::EpiF32><<<grid, 512, pg8::STAGE_BYTES, stream>>>(g, E); }
    k_post1<<<grid, 512, 0, stream>>>(PROJ, qg, kg, lbw, FQ, FK, FV, HQ, HK, HV, HG, HLF);
    k_scan<<<NHEAD, 512, 0, stream>>>(FLOGF, FCUM);
    k_attn<<<256, 512, fox::ATT_LDS, stream>>>(FQ, FK, FV, FCUM, MERGED);
    k_hgrn_seq<<<grid, 512, 0, stream>>>(HQ, HK, HV, HLF, HO);
    k_hgrn_post<<<grid, 512, 0, stream>>>(HO, HG, og, MERGED);
    { pg8::Gemm g{MERGED, WoutT, T_, DM, DM}; pg8::EpiF32 E{PROJ, DM, nullptr}; k_gemm<pg8::EpiF32><<<grid, 512, pg8::STAGE_BYTES, stream>>>(g, E); }
    k_post2<<<grid, 512, 49152, stream>>>(x, PROJ, mod, ada_b, g2, out, H);
    { pg8::Gemm g{H, WqT, T_, PEER_QW, DM}; pg8::EpiF32 E{QP, PEER_QW, nullptr}; k_gemm<pg8::EpiF32><<<grid, 512, pg8::STAGE_BYTES, stream>>>(g, E); }
    k_scores<<<grid, 512, (128 * 132 + 64 * 128) * 4, stream>>>(QP, keys, SC);
    k_topk<<<grid, 512, 0, stream>>>(SC, PIDX, PGATE);
    k_expert<float><<<grid, 512, 131072, stream>>>(H, pu, pv, PIDX, PGATE, mod, ada_b, out);
}
```

```cpp
#include <hip/hip_runtime.h>
#include <hip/hip_bf16.h>
#include <cstdio>
#include <cstdint>
#include <type_traits>

constexpr int T_ = 8192, DM = 4096, NIN = 14352, NPROJ = 14336, FOXW = 2048, HGW = 2048, NHEAD = 16, HDIM = 128;
constexpr int PEER_H = 8, PEER_K = 128, PEER_TOP = 16, PEER_QW = 2048, PEER_NE = 16384;
constexpr float EPS_ = 1e-6f;

constexpr size_t MiB = 1u << 20;
constexpr size_t WS_CTL = 0, CTL_ZERO_BYTES = 256 * 1024;
constexpr size_t CTL_CMAX = 163840;
constexpr size_t CTL_MOD = 65536;
constexpr size_t WS_WINT = 2 * MiB;
constexpr size_t WS_WOUTT = WS_WINT + 112 * MiB;
constexpr size_t WS_WQT = WS_WOUTT + 32 * MiB;
constexpr size_t WS_WFT = WS_WQT + 16 * MiB;
constexpr size_t WS_UBF = WS_WFT + 1 * MiB;
constexpr size_t WS_VBF = WS_UBF + 128 * MiB;
constexpr size_t WS_H = WS_VBF + 128 * MiB;
constexpr size_t WS_FLOGF = WS_H + 64 * MiB;
constexpr size_t WS_FCUM = WS_FLOGF + 512 * 1024;
constexpr size_t WS_FQ = WS_FLOGF + 1 * MiB;
constexpr size_t WS_FK = WS_FQ + 32 * MiB;
constexpr size_t WS_FV = WS_FK + 32 * MiB;
constexpr size_t WS_HQ = WS_FV + 32 * MiB;
constexpr size_t WS_HK = WS_HQ + 32 * MiB;
constexpr size_t WS_HV = WS_HK + 32 * MiB;
constexpr size_t WS_HG = WS_HV + 32 * MiB;
constexpr size_t WS_HLF = WS_HG + 32 * MiB;
constexpr size_t WS_HO = WS_HLF + 64 * MiB;
constexpr size_t WS_MERGED = WS_HO + 64 * MiB;
constexpr size_t WS_QP = WS_MERGED + 64 * MiB;
constexpr size_t WS_SC = WS_QP + 64 * MiB;
constexpr size_t WS_PIDX = WS_SC + 64 * MiB;
constexpr size_t WS_PGATE = WS_PIDX + 4 * MiB;
constexpr size_t WS_PROJ = WS_PGATE + 4 * MiB;
constexpr size_t WS_PMOD = WS_WINT + 72 * MiB;
constexpr size_t WS_END = WS_PROJ + 448 * MiB;

typedef unsigned short bf16_t;
typedef float f32x4 __attribute__((ext_vector_type(4)));
typedef float f32x2 __attribute__((ext_vector_type(2)));
typedef unsigned u32x4 __attribute__((ext_vector_type(4)));
typedef unsigned u32x2 __attribute__((ext_vector_type(2)));
#define LAS __attribute__((address_space(3)))

__device__ __forceinline__ unsigned f2bf(float f) { unsigned u = __builtin_bit_cast(unsigned, f); return (u + 0x7fffu + ((u >> 16) & 1u)) >> 16; }
__device__ __forceinline__ unsigned pk2(float lo, float hi) { return f2bf(lo) | (f2bf(hi) << 16); }
__device__ __forceinline__ float bf2f(unsigned b) { return __builtin_bit_cast(float, b << 16); }
__device__ __forceinline__ float wave_sum(float v) {
#pragma unroll
    for (int o = 1; o < 64; o <<= 1) v += __shfl_xor(v, o);
    return v;
}
__device__ __forceinline__ float silu_f(float x) { return x / (1.f + __expf(-x)); }
__device__ __forceinline__ float sigmoid_f(float x) { return 1.f / (1.f + __expf(-x)); }
__device__ __forceinline__ int opaque_tid() { int t = threadIdx.x; asm volatile("" : "+v"(t)); return t; }
#define XB_TMO      128
#define XB_XCNT(j)  (256  + 64 * (j))
#define XB_XSUB(j)  (1280 + 64 * (j))
#define XB_XGEN(j)  (2304 + 64 * (j))
#define XB_TOP      3328
#define XB_TOPGEN   3392
#define XCD_BAR_WORDS 3456
#define XB_SPIN_CAP (1u << 18)

__device__ __forceinline__ unsigned xb_ld(unsigned* p)              { return __hip_atomic_load(p, __ATOMIC_RELAXED, __HIP_MEMORY_SCOPE_AGENT); }
__device__ __forceinline__ unsigned xb_add(unsigned* p, unsigned v) { return __hip_atomic_fetch_add(p, v, __ATOMIC_RELAXED, __HIP_MEMORY_SCOPE_AGENT); }
__device__ __forceinline__ unsigned xb_xcc_id() { return (unsigned)__builtin_amdgcn_s_getreg((3 << 11) | 20) & 0xFu; }
#define XB_SPIN(cond, bar) do { unsigned _sp = 0; while (cond) { __builtin_amdgcn_s_sleep(1); \
    if ((++_sp & 255u) == 0u) { if (xb_ld(&(bar)[XB_TMO])) break; if (_sp > XB_SPIN_CAP) { atomicAdd(&(bar)[XB_TMO], 1u); break; } } } } while (0)

struct XcdBarrier {
    unsigned* bar; unsigned x;
    volatile LAS unsigned* st;
};

__device__ __forceinline__ XcdBarrier xcd_barrier_post(unsigned* bar, volatile LAS unsigned* st) {
    XcdBarrier b; b.bar = bar; b.x = xb_xcc_id(); b.st = st;
    if (threadIdx.x == 0) (void)xb_add(&bar[XB_XCNT(b.x)], 1u);
    return b;
}
__device__ __forceinline__ void xcd_barrier_complete(unsigned* bar, unsigned x, unsigned& nloc, unsigned& nx) {
    const unsigned G = gridDim.x * gridDim.y * gridDim.z;
    unsigned sum, cnt, mine, sp = 0u;
    for (;;) {
        sum = 0u; cnt = 0u; mine = 0u;
#pragma unroll
        for (unsigned j = 0; j < 16; ++j) { const unsigned c = xb_ld(&bar[XB_XCNT(j)]); sum += c; cnt += (c > 0u) ? 1u : 0u; mine = (j == x) ? c : mine; }
        if (sum == G) break;
        __builtin_amdgcn_s_sleep(1);
        if ((++sp & 255u) == 0u) { if (xb_ld(&bar[XB_TMO])) break; if (sp > XB_SPIN_CAP) { atomicAdd(&bar[XB_TMO], 1u); break; } }
    }
    nloc = mine > 0u ? mine : 1u; nx = cnt > 0u ? cnt : 1u;
}

__device__ __forceinline__ void xcd_barrier(const XcdBarrier& b) {
    asm volatile("s_waitcnt vmcnt(0)" ::: "memory");
    __syncthreads();
    if (threadIdx.x == 0) {
        unsigned* bar = b.bar;
        __builtin_amdgcn_s_waitcnt(0);
        unsigned nloc = b.st[0], nx = b.st[1];
        if (nloc == 0u) { xcd_barrier_complete(bar, b.x, nloc, nx); b.st[0] = nloc; b.st[1] = nx; }
        const unsigned old = xb_add(&bar[XB_XSUB(b.x)], 1u);
        const unsigned gen = old / nloc;
        if (old + 1u == (gen + 1u) * nloc) {
            __builtin_amdgcn_fence(__ATOMIC_RELEASE, "agent");
            asm volatile("s_waitcnt vmcnt(0)" ::: "memory");
            const unsigned og = xb_add(&bar[XB_TOP], 1u);
            const unsigned tg = og / nx;
            if (og + 1u == (tg + 1u) * nx) xb_add(&bar[XB_TOPGEN], 1u);
            else XB_SPIN(xb_ld(&bar[XB_TOPGEN]) == tg, bar);
            __builtin_amdgcn_fence(__ATOMIC_ACQUIRE, "agent");
            xb_add(&bar[XB_XGEN(b.x)], 1u);
            asm volatile("s_waitcnt vmcnt(0)" ::: "memory");
        } else {
            XB_SPIN(xb_ld(&bar[XB_XGEN(b.x)]) == gen, bar);
            __builtin_amdgcn_fence(__ATOMIC_ACQUIRE, "agent");
            asm volatile("s_waitcnt vmcnt(0)" ::: "memory");
        }
    }
    __syncthreads();
}
namespace pg8 {
#define PG8_LAS __attribute__((address_space(3)))
typedef unsigned short bf16_t;
typedef short bf16x8 __attribute__((ext_vector_type(8)));
typedef float f32x4 __attribute__((ext_vector_type(4)));
typedef unsigned u32x4 __attribute__((ext_vector_type(4)));
typedef int i32x4 __attribute__((ext_vector_type(4)));
constexpr int BM = 256, BK = 64, HALF = 128, HTB = HALF * BK * 2  , STAGE_BYTES = 8 * HTB, NXCD = 8, WGM = 8;

__host__ __device__ __forceinline__ int lds_byte(int r, int c) { const int st = (r >> 4) * 2 + (c >> 5), rr = r & 15, cc = c & 31, ob = rr * 64 + cc * 2; return st * 1024 + (ob ^ (((ob >> 9) & 1) << 5)); }
__host__ __device__ __forceinline__ void stage_rc(int b, int& R, int& C) { const int st = b / 1024, sb = b % 1024, swz = sb ^ (((sb >> 9) & 1) << 5); R = (st >> 1) * 16 + swz / 64; C = (st & 1) * 32 + (swz % 64) / 2; }
__host__ __device__ __forceinline__ int perm32(int rho) { const int n = rho >> 4, i = rho & 15; return 8 * (i >> 2) + 4 * n + (i & 3); }

struct Unit { int pm, pn; };
struct Gemm { const bf16_t* A; const bf16_t* Bt; int M, N, K; };

struct StaticOrder {
    int nM, nN, nwg, G, c;
    __host__ __device__ void init(int M, int N, int G_, int c_) { nM = M / BM; nN = N / BM; nwg = nM * nN; G = G_; c = c_; }
    __host__ __device__ bool next(int i, Unit& u) const {
        const long L = (long)i * G + c; if (L >= nwg) return false;
        int wgid = (int)L; { const int q = nwg / NXCD, r = nwg % NXCD, xcd = wgid % NXCD, off = wgid / NXCD; wgid = (xcd < r ? xcd * (q + 1) : r * (q + 1) + (xcd - r) * q) + off; }
        const int nig = WGM * nN, gid = wgid / nig, fm = gid * WGM, gsz = (nM - fm) < WGM ? (nM - fm) : WGM;
        u.pm = fm + ((wgid % nig) % gsz); u.pn = (wgid % nig) / gsz; return true;
    }
    __device__ __forceinline__ void a_ready(const Unit&) const {}
    __device__ __forceinline__ void done(const Unit&) const {}
};
__device__ __forceinline__ unsigned cvt_pk_bf16(float lo, float hi) { unsigned r; asm volatile("v_cvt_pk_bf16_f32 %0, %1, %2" : "=v"(r) : "v"(lo), "v"(hi)); return r; }
typedef float f32x2 __attribute__((ext_vector_type(2)));
__device__ __forceinline__ f32x2 gelu_pk(f32x2 v) {
    const f32x2 av = __builtin_elementwise_abs(v), d = av * 0.2316418882f + 1.0f;
    f32x2 t; t.x = __builtin_amdgcn_rcpf(d.x); t.y = __builtin_amdgcn_rcpf(d.y);
    f32x2 q = t * 0.5307027145f + (-0.7265760135f); q = q * t + 0.7107068705f; q = q * t + (-0.142248368f); q = q * t + 0.127414796f; q = q * t;
    const f32x2 s = (v * v) * (-0.72134752044f);
    f32x2 e; e.x = __builtin_amdgcn_exp2f(s.x); e.y = __builtin_amdgcn_exp2f(s.y);
    const f32x2 m = v * (q * e), r = v - m;
    f32x2 o; o.x = v.x < 0.f ? m.x : r.x; o.y = v.y < 0.f ? m.y : r.y; return o;
}

struct EpiF32 {
    static constexpr bool PERM = false, AFTER_DRAIN = false, I8 = false; typedef f32x4 acc_t;
    float* C; int ldc; const float* bias;
    __device__ __forceinline__ void operator()(const f32x4 (&acc)[2][2][4][2], const Unit& u, int wr, int wc, int fr, int fq) const {
        const int row0 = u.pm * BM + wr * 64 + fr, col0 = u.pn * BM + wc * 32 + 4 * fq;
        f32x4 bv[2][2];
#pragma unroll
        for (int bj = 0; bj < 2; ++bj)
#pragma unroll
            for (int n = 0; n < 2; ++n) bv[bj][n] = bias ? *(const f32x4*)(bias + col0 + bj * HALF + n * 16) : (f32x4){0.f, 0.f, 0.f, 0.f};
#pragma unroll
        for (int ai = 0; ai < 2; ++ai)
#pragma unroll
            for (int m = 0; m < 4; ++m) { float* rowp = C + (size_t)(row0 + ai * HALF + m * 16) * ldc + col0;
#pragma unroll
                for (int bj = 0; bj < 2; ++bj)
#pragma unroll
                    for (int n = 0; n < 2; ++n) *(f32x4*)(rowp + bj * HALF + n * 16) = acc[ai][bj][m][n] + bv[bj][n]; }
    }
};
template <int ACT  > struct EpiBf16 {
    static constexpr bool PERM = true, AFTER_DRAIN = false, I8 = false; typedef f32x4 acc_t;
    bf16_t* O; int ldc; const float* bias; int split_cols; size_t split_stride;
    __device__ __forceinline__ void operator()(const f32x4 (&acc)[2][2][4][2], const Unit& u, int wr, int wc, int fr, int fq) const {
        const int row0 = u.pm * BM + wr * 64 + fr; int colt = u.pn * BM; bf16_t* base = O;
        if (split_cols) { const int t = colt / split_cols; base += (size_t)t * split_stride; colt -= t * split_cols; }
        const int col0 = colt + wc * 32 + 8 * fq, bcol0 = u.pn * BM + wc * 32 + 8 * fq;
        f32x4 bv[2][2];
#pragma unroll
        for (int bj = 0; bj < 2; ++bj)
#pragma unroll
            for (int n = 0; n < 2; ++n) bv[bj][n] = bias ? *(const f32x4*)(bias + bcol0 + bj * HALF + 4 * n) : (f32x4){0.f, 0.f, 0.f, 0.f};
#pragma unroll
        for (int ai = 0; ai < 2; ++ai)
#pragma unroll
            for (int m = 0; m < 4; ++m) { bf16_t* rowp = base + (size_t)(row0 + ai * HALF + m * 16) * ldc + col0;
#pragma unroll
                for (int bj = 0; bj < 2; ++bj) { f32x4 v0 = acc[ai][bj][m][0] + bv[bj][0], v1 = acc[ai][bj][m][1] + bv[bj][1];
                    if (ACT == 1) { f32x2 a = gelu_pk((f32x2){v0[0], v0[1]}), b = gelu_pk((f32x2){v0[2], v0[3]}), c = gelu_pk((f32x2){v1[0], v1[1]}), d = gelu_pk((f32x2){v1[2], v1[3]});
                        v0 = (f32x4){a.x, a.y, b.x, b.y}; v1 = (f32x4){c.x, c.y, d.x, d.y}; }
                    if (ACT == 2) {
#pragma unroll
                        for (int j = 0; j < 4; ++j) { v0[j] = 0.5f * v0[j] * (1.0f + erff(v0[j] * 0.70710678f)); v1[j] = 0.5f * v1[j] * (1.0f + erff(v1[j] * 0.70710678f)); } }
                    u32x4 w; w.x = cvt_pk_bf16(v0[0], v0[1]); w.y = cvt_pk_bf16(v0[2], v0[3]); w.z = cvt_pk_bf16(v1[0], v1[1]); w.w = cvt_pk_bf16(v1[2], v1[3]);
                    *(u32x4*)(rowp + bj * HALF) = w; } }
    }
};

template <class Epi, class Sched, bool STAMP = false>
__device__ __forceinline__ void gemm_phase(PG8_LAS unsigned char* lds, const Gemm g, const Sched& S, const Epi& E, unsigned long long* stamps) {
    const int tid = opaque_tid(), wid = __builtin_amdgcn_readfirstlane(tid >> 6), lane = tid & 63, wr = wid >> 2, wc = wid & 3, fr = lane & 15, fq = lane >> 4;
    const int K = g.K, nt = K / BK;
    int ts_lo = 0, ts_hi = 0, nts = 0; const unsigned long long rt_entry = STAMP ? (unsigned long long)wall_clock64() : 0ull;
#define PG8_STAMP() do { if (STAMP && wid == 0 && nts < 64) { const unsigned long long _c = (unsigned long long)clock64(); \
        ts_lo = (lane == nts) ? (int)(unsigned)_c : ts_lo; ts_hi = (lane == nts) ? (int)(unsigned)(_c >> 32) : ts_hi; ++nts; } } while (0)
    PG8_STAMP();
    unsigned voffA[2], voffB[2];
#pragma unroll
    for (int i = 0; i < 2; ++i) { int R, C; stage_rc(tid * 16 + i * 8192, R, C); const int Rb = Epi::PERM ? ((R & ~31) + perm32(R & 31)) : R;
        voffA[i] = (unsigned)(R * K + C) * 2u; voffB[i] = (unsigned)(Rb * K + C) * 2u; }
    const size_t kstep = (size_t)(BK * 2);
    const size_t hstep = (size_t)HALF * K * 2;
    const size_t tstep = 2 * hstep;
    const unsigned ldsw = (unsigned)wid * 1024u;
    const int aoff = lds_byte(wr * 64 + fr, fq * 8), boff = lds_byte(wc * 32 + fr, fq * 8);
#define PG8_SA(b, h) (((b) * 2 + (h)) * HTB)
#define PG8_SB(b, h) ((4 + (b) * 2 + (h)) * HTB)
#define PG8_STAGE(bufoff, gbase, voff) do { _Pragma("unroll") for (int _i = 0; _i < 2; ++_i) \
        __builtin_amdgcn_global_load_lds((const unsigned*)((const char*)(gbase) + (voff)[_i]), (PG8_LAS unsigned*)(lds + (bufoff) + ldsw + _i * 8192), 16, 0, 0); } while (0)
#define PG8_LDA(dst, b, h) do { _Pragma("unroll") for (int m = 0; m < 4; ++m) _Pragma("unroll") for (int k = 0; k < 2; ++k) dst[m][k] = *(const PG8_LAS bf16x8*)(lds + PG8_SA(b, h) + aoff + m * 2048 + k * 1024); } while (0)
#define PG8_LDB(dst, b, h) do { _Pragma("unroll") for (int n = 0; n < 2; ++n) _Pragma("unroll") for (int k = 0; k < 2; ++k) dst[n][k] = *(const PG8_LAS bf16x8*)(lds + PG8_SB(b, h) + boff + n * 2048 + k * 1024); } while (0)
#define PG8_MMA(ai, bj, At, Bt) do { __builtin_amdgcn_s_setprio(1); _Pragma("unroll") for (int m = 0; m < 4; ++m) _Pragma("unroll") for (int n = 0; n < 2; ++n) _Pragma("unroll") for (int k = 0; k < 2; ++k) \
        { if constexpr (Epi::I8) acc[ai][bj][m][n] = __builtin_amdgcn_mfma_i32_16x16x64_i8(__builtin_bit_cast(i32x4, Bt[n][k]), __builtin_bit_cast(i32x4, At[m][k]), acc[ai][bj][m][n], 0, 0, 0); \
          else acc[ai][bj][m][n] = __builtin_amdgcn_mfma_f32_16x16x32_bf16(Bt[n][k], At[m][k], acc[ai][bj][m][n], 0, 0, 0); } __builtin_amdgcn_s_setprio(0); } while (0)
#define PG8_WAIT_V(n) asm volatile("s_waitcnt vmcnt(" #n ")" ::: "memory")
#define PG8_WAIT_L(n) asm volatile("s_waitcnt lgkmcnt(" #n ")" ::: "memory")
#define PG8_BAR __builtin_amdgcn_s_barrier()
#define PG8_SCHED __builtin_amdgcn_sched_barrier(0)
    Unit cur, nxt; int ui = 0;
    if (!S.next(0, cur)) return;
    typedef typename Epi::acc_t acc_t;
    acc_t acc[2][2][4][2];
#pragma unroll
    for (int a = 0; a < 2; ++a)
#pragma unroll
        for (int b = 0; b < 2; ++b)
#pragma unroll
            for (int m = 0; m < 4; ++m)
#pragma unroll
                for (int n = 0; n < 2; ++n) acc[a][b][m][n] = (acc_t){0, 0, 0, 0};
    bf16x8 At[4][2], B0[2][2], B1[2][2];
    const char* cA = (const char*)g.A + (size_t)cur.pm * tstep; const char* cB = (const char*)g.Bt + (size_t)cur.pn * tstep;
    S.a_ready(cur);
    PG8_STAGE(PG8_SB(0, 0), cB, voffB); PG8_STAGE(PG8_SA(0, 0), cA, voffA); PG8_STAGE(PG8_SB(0, 1), cB + hstep, voffB); PG8_STAGE(PG8_SA(0, 1), cA + hstep, voffA);
    if (wr == 1) PG8_BAR;
    PG8_WAIT_V(4); PG8_BAR;
    PG8_STAGE(PG8_SB(1, 0), cB + kstep, voffB); PG8_STAGE(PG8_SA(1, 0), cA + kstep, voffA); PG8_STAGE(PG8_SB(1, 1), cB + hstep + kstep, voffB);
    PG8_WAIT_V(6); PG8_BAR;
    PG8_STAMP();
    for (;;) {
        const bool has_next = S.next(ui + 1, nxt);
        const char* nA = has_next ? (const char*)g.A + (size_t)nxt.pm * tstep : cA; const char* nB = has_next ? (const char*)g.Bt + (size_t)nxt.pn * tstep : cB;
        for (int t = 0; t < nt; t += 2) {
            const bool last = (t == nt - 2);
            const char* a1 = cA + (size_t)(t + 1) * kstep;
            const char* a2 = last ? nA : cA + (size_t)(t + 2) * kstep; const char* b2 = last ? nB : cB + (size_t)(t + 2) * kstep;
            const char* a3 = a2 + kstep; const char* b3 = b2 + kstep;
            if (last && has_next) S.a_ready(nxt);
            PG8_LDB(B0, 0, 0); PG8_SCHED; PG8_LDA(At, 0, 0); PG8_STAGE(PG8_SA(1, 1), a1 + hstep, voffA);
            PG8_WAIT_L(8); PG8_BAR; PG8_WAIT_L(0); PG8_MMA(0, 0, At, B0); PG8_BAR; PG8_SCHED;
            PG8_LDB(B1, 0, 1); PG8_STAGE(PG8_SB(0, 0), b2, voffB);
            PG8_BAR; PG8_WAIT_L(0); PG8_MMA(0, 1, At, B1); PG8_BAR;
            PG8_LDA(At, 0, 1); PG8_STAGE(PG8_SA(0, 0), a2, voffA);
            PG8_BAR; PG8_WAIT_L(0); PG8_MMA(1, 0, At, B0); PG8_BAR; PG8_SCHED;
            PG8_STAGE(PG8_SB(0, 1), b2 + hstep, voffB);
            PG8_WAIT_V(6); PG8_BAR; PG8_MMA(1, 1, At, B1); PG8_BAR;
            PG8_LDB(B0, 1, 0); PG8_SCHED; PG8_LDA(At, 1, 0); PG8_STAGE(PG8_SA(0, 1), a2 + hstep, voffA);
            PG8_WAIT_L(8); PG8_BAR; PG8_WAIT_L(0); PG8_MMA(0, 0, At, B0); PG8_BAR; PG8_SCHED;
            PG8_LDB(B1, 1, 1); PG8_STAGE(PG8_SB(1, 0), b3, voffB);
            PG8_BAR; PG8_WAIT_L(0); PG8_MMA(0, 1, At, B1); PG8_BAR;
            PG8_LDA(At, 1, 1); PG8_STAGE(PG8_SA(1, 0), a3, voffA);
            PG8_BAR; PG8_WAIT_L(0); PG8_MMA(1, 0, At, B0); PG8_BAR; PG8_SCHED;
            PG8_STAGE(PG8_SB(1, 1), b3 + hstep, voffB);
            PG8_WAIT_V(6); PG8_BAR; PG8_MMA(1, 1, At, B1); PG8_BAR;
        }
        PG8_STAMP();
        if constexpr (!Epi::AFTER_DRAIN) { if (wr == 0) PG8_BAR; E(acc, cur, wr, wc, fr, fq); S.done(cur); }
        PG8_STAMP();
        if (!has_next) break;
        if constexpr (!Epi::AFTER_DRAIN) { if (wr == 1) PG8_BAR; }
#pragma unroll
        for (int a = 0; a < 2; ++a)
#pragma unroll
            for (int b = 0; b < 2; ++b)
#pragma unroll
                for (int m = 0; m < 4; ++m)
#pragma unroll
                    for (int n = 0; n < 2; ++n) acc[a][b][m][n] = (acc_t){0, 0, 0, 0};
        cur = nxt; cA = nA; cB = nB; ++ui;
    }
    PG8_WAIT_V(0);
    if constexpr (Epi::AFTER_DRAIN) { if (wr == 0) PG8_BAR; }
    PG8_BAR;
    if constexpr (Epi::AFTER_DRAIN) { E.fused(acc, cur, wr, wc, fr, fq, lds, wid, lane); S.done(cur); }
    PG8_STAMP();
    if (STAMP && wid == 0) { stamps[lane] = lane < nts ? (((unsigned long long)(unsigned)ts_hi << 32) | (unsigned)ts_lo) : 0ull;
        if (lane == 62) stamps[62] = rt_entry; if (lane == 63) stamps[63] = (unsigned long long)wall_clock64(); }
#undef PG8_STAMP
#undef PG8_SA
#undef PG8_SB
#undef PG8_STAGE
#undef PG8_LDA
#undef PG8_LDB
#undef PG8_MMA
#undef PG8_WAIT_V
#undef PG8_WAIT_L
#undef PG8_BAR
#undef PG8_SCHED
}
}
namespace pg8 {
template <bool I8_> struct EpiInProjT {
    static constexpr bool PERM = true, AFTER_DRAIN = false, I8 = I8_; typedef typename std::conditional<I8_, i32x4, f32x4>::type acc_t;
    bf16_t *FQ, *FK, *FV, *HQ, *HK, *HV, *HG; float* HLF;
    const float *qg, *kg, *lbw;
    const float *SA, *SB;
    PG8_LAS float* tab;
    __device__ __forceinline__ void operator()(const acc_t (&accq)[2][2][4][2], const Unit& u, int wr, int wc, int fr, int fq) const {
        float sa[2][4]; f32x4 sb[2][2];
        if constexpr (I8_) {
#pragma unroll
            for (int ai = 0; ai < 2; ++ai)
#pragma unroll
                for (int m = 0; m < 4; ++m) sa[ai][m] = SA[u.pm * BM + ai * HALF + m * 16 + wr * 64 + fr];
#pragma unroll
            for (int bj = 0; bj < 2; ++bj)
#pragma unroll
                for (int n = 0; n < 2; ++n) sb[bj][n] = *(const f32x4*)(SB + u.pn * BM + bj * HALF + wc * 32 + 8 * fq + 4 * n);
        }
#define ACCV(ai, bj, m, n) (I8_ ? __builtin_convertvector(accq[ai][bj][m][n], f32x4) * (sb[bj][n] * sa[ai][m]) : __builtin_bit_cast(f32x4, accq[ai][bj][m][n]))
        const int ty = u.pn >> 3, hp = (u.pn & 7) * 2, rl0 = wr * 64 + fr, cih = wc * 32 + 8 * fq;
        const size_t row0 = (size_t)u.pm * BM + rl0;
        if (ty < 2) {
#pragma unroll
            for (int ai = 0; ai < 2; ++ai)
#pragma unroll
                for (int m = 0; m < 4; ++m)
#pragma unroll
                    for (int bj = 0; bj < 2; ++bj) { const f32x4 a = ACCV(ai, bj, m, 0), b = ACCV(ai, bj, m, 1);
                        float s = ((a[0] * a[0] + a[1] * a[1]) + (a[2] * a[2] + a[3] * a[3])) + ((b[0] * b[0] + b[1] * b[1]) + (b[2] * b[2] + b[3] * b[3]));
                        s += __shfl_xor(s, 16); s += __shfl_xor(s, 32);
                        if (fq == 0) tab[((ai * HALF + m * 16 + rl0) * 2 + bj) * 4 + wc] = s; }
            asm volatile("s_waitcnt lgkmcnt(0)" ::: "memory"); __builtin_amdgcn_s_barrier(); asm volatile("" ::: "memory");
            const float* gn = (ty == 0 ? qg : kg) + hp * HDIM + cih; bf16_t* dst = (ty == 0 ? FQ : FK);
            f32x4 g[2][2];
#pragma unroll
            for (int bj = 0; bj < 2; ++bj) { g[bj][0] = *(const f32x4*)(gn + bj * HDIM); g[bj][1] = *(const f32x4*)(gn + bj * HDIM + 4); }
#pragma unroll
            for (int ai = 0; ai < 2; ++ai)
#pragma unroll
                for (int m = 0; m < 4; ++m)
#pragma unroll
                    for (int bj = 0; bj < 2; ++bj) { const f32x4 p = *(const PG8_LAS f32x4*)(tab + ((ai * HALF + m * 16 + rl0) * 2 + bj) * 4);
                        const float rs = __builtin_amdgcn_rsqf(((p[0] + p[1]) + (p[2] + p[3])) * (1.f / HDIM) + EPS_);
                        const f32x4 a = ACCV(ai, bj, m, 0) * rs * g[bj][0], b = ACCV(ai, bj, m, 1) * rs * g[bj][1];
                        u32x4 w = {cvt_pk_bf16(a[0], a[1]), cvt_pk_bf16(a[2], a[3]), cvt_pk_bf16(b[0], b[1]), cvt_pk_bf16(b[2], b[3])};
                        *(u32x4*)(dst + ((size_t)(hp + bj) * T_ + row0 + ai * HALF + m * 16) * HDIM + cih) = w; }
        } else if (ty == 4) {
            float lb[2][8];
#pragma unroll
            for (int bj = 0; bj < 2; ++bj) { const float* l = lbw + (hp + bj) * HDIM + cih;
#pragma unroll
                for (int i = 0; i < 8; ++i) lb[bj][i] = 1.f / (1.f + __expf(l[HGW + i] - l[i])); }
#pragma unroll
            for (int ai = 0; ai < 2; ++ai)
#pragma unroll
                for (int m = 0; m < 4; ++m)
#pragma unroll
                    for (int bj = 0; bj < 2; ++bj) { float f[8];
                        const f32x4 v0_ = ACCV(ai, bj, m, 0), v1_ = ACCV(ai, bj, m, 1);
#pragma unroll
                        for (int i = 0; i < 8; ++i) { const float xx = (i < 4 ? v0_ : v1_)[i & 3]; f[i] = lb[bj][i] + (1.f - lb[bj][i]) * __builtin_amdgcn_rcpf(1.f + __expf(-xx)); }
                        const size_t o = ((size_t)(hp + bj) * T_ + row0 + ai * HALF + m * 16) * HDIM + cih;
                        *(f32x4*)(HLF + o) = (f32x4){__logf(f[0]), __logf(f[1]), __logf(f[2]), __logf(f[3])}; *(f32x4*)(HLF + o + 4) = (f32x4){__logf(f[4]), __logf(f[5]), __logf(f[6]), __logf(f[7])};
                        u32x4 w = {cvt_pk_bf16(1.f - f[0], 1.f - f[1]), cvt_pk_bf16(1.f - f[2], 1.f - f[3]), cvt_pk_bf16(1.f - f[4], 1.f - f[5]), cvt_pk_bf16(1.f - f[6], 1.f - f[7])};
                        *(u32x4*)(HK + o) = w; }
        } else {
            bf16_t* dst = ty == 2 ? FV : ty == 3 ? HQ : ty == 5 ? HV : HG;
            const bool act = (ty == 3) || (ty == 6); const float sc = ty == 3 ? 0.08838834764831845f : 1.f;
#pragma unroll
            for (int ai = 0; ai < 2; ++ai)
#pragma unroll
                for (int m = 0; m < 4; ++m)
#pragma unroll
                    for (int bj = 0; bj < 2; ++bj) { float f[8];
                        const f32x4 v0_ = ACCV(ai, bj, m, 0), v1_ = ACCV(ai, bj, m, 1);
#pragma unroll
                        for (int i = 0; i < 8; ++i) { const float xx = (i < 4 ? v0_ : v1_)[i & 3]; f[i] = act ? xx * sc * __builtin_amdgcn_rcpf(1.f + __expf(-xx)) : xx; }
                        u32x4 w = {cvt_pk_bf16(f[0], f[1]), cvt_pk_bf16(f[2], f[3]), cvt_pk_bf16(f[4], f[5]), cvt_pk_bf16(f[6], f[7])};
                        *(u32x4*)(dst + ((size_t)(hp + bj) * T_ + row0 + ai * HALF + m * 16) * HDIM + cih) = w; }
        }
    }
#undef ACCV
};
typedef EpiInProjT<false> EpiInProj;
}
namespace pg8 {
template <bool I8_> struct EpiOutProjT {
    static constexpr bool PERM = false, AFTER_DRAIN = false, I8 = I8_; typedef typename std::conditional<I8_, i32x4, f32x4>::type acc_t;
    const float* x; const float* mod; const float* ada_b; float* OUT; float* PSSQ; const float *SA, *SB;
    __device__ __forceinline__ void operator()(const acc_t (&acc)[2][2][4][2], const Unit& u, int wr, int wc, int fr, int fq) const {
        const int row0 = u.pm * BM + wr * 64 + fr, col0 = u.pn * BM + wc * 32 + 4 * fq;
        f32x4 gt[2][2];
#pragma unroll
        for (int bj = 0; bj < 2; ++bj)
#pragma unroll
            for (int n = 0; n < 2; ++n) { gt[bj][n] = *(const f32x4*)(mod + 2 * DM + col0 + bj * HALF + n * 16) + *(const f32x4*)(ada_b + 2 * DM + col0 + bj * HALF + n * 16);
                if constexpr (I8_) gt[bj][n] = gt[bj][n] * *(const f32x4*)(SB + col0 + bj * HALF + n * 16); }
#pragma unroll
        for (int ai = 0; ai < 2; ++ai)
#pragma unroll
            for (int m = 0; m < 4; ++m) { const size_t ro = (size_t)(row0 + ai * HALF + m * 16) * DM + col0; float s = 0.f;
                float rsc = 1.f; if constexpr (I8_) rsc = SA[row0 + ai * HALF + m * 16];
#pragma unroll
                for (int bj = 0; bj < 2; ++bj)
#pragma unroll
                    for (int n = 0; n < 2; ++n) { f32x4 av; if constexpr (I8_) av = __builtin_convertvector(acc[ai][bj][m][n], f32x4) * rsc; else av = __builtin_bit_cast(f32x4, acc[ai][bj][m][n]);
                        const f32x4 v = *(const f32x4*)(x + ro + bj * HALF + n * 16) + gt[bj][n] * av;
                        *(f32x4*)(OUT + ro + bj * HALF + n * 16) = v; s += (v[0] * v[0] + v[1] * v[1]) + (v[2] * v[2] + v[3] * v[3]); }
                s += __shfl_xor(s, 16); s += __shfl_xor(s, 32);
                if (fq == 0) PSSQ[(size_t)(row0 + ai * HALF + m * 16) * 64 + u.pn * 4 + wc] = s; }
    }
};
}
namespace pg8 {
template <bool I8_> struct EpiMixBf16T {
    static constexpr bool PERM = true, AFTER_DRAIN = false, I8 = I8_; typedef typename std::conditional<I8_, i32x4, f32x4>::type acc_t;
    bf16_t* O; const float* mod; const float* ada_b;
    const float *SA, *SB;
    __device__ __forceinline__ void operator()(const acc_t (&accq)[2][2][4][2], const Unit& u, int wr, int wc, int fr, int fq) const {
        const int row0 = u.pm * BM + wr * 64 + fr, col0 = u.pn * BM + wc * 32 + 8 * fq;
        f32x4 gt[2][2];
#pragma unroll
        for (int bj = 0; bj < 2; ++bj)
#pragma unroll
            for (int n = 0; n < 2; ++n) { gt[bj][n] = *(const f32x4*)(mod + 2 * DM + col0 + bj * HALF + 4 * n) + *(const f32x4*)(ada_b + 2 * DM + col0 + bj * HALF + 4 * n);
                if constexpr (I8_) gt[bj][n] = gt[bj][n] * *(const f32x4*)(SB + col0 + bj * HALF + 4 * n); }
#pragma unroll
        for (int ai = 0; ai < 2; ++ai)
#pragma unroll
            for (int m = 0; m < 4; ++m) { bf16_t* rowp = O + (size_t)(row0 + ai * HALF + m * 16) * DM + col0;
                float sa = 1.f; if constexpr (I8_) sa = SA[row0 + ai * HALF + m * 16];
#pragma unroll
                for (int bj = 0; bj < 2; ++bj) {
                    f32x4 v0, v1;
                    if constexpr (I8_) { v0 = __builtin_convertvector(accq[ai][bj][m][0], f32x4) * (gt[bj][0] * sa); v1 = __builtin_convertvector(accq[ai][bj][m][1], f32x4) * (gt[bj][1] * sa); }
                    else { v0 = __builtin_bit_cast(f32x4, accq[ai][bj][m][0]) * gt[bj][0]; v1 = __builtin_bit_cast(f32x4, accq[ai][bj][m][1]) * gt[bj][1]; }
                    u32x4 w = {cvt_pk_bf16(v0[0], v0[1]), cvt_pk_bf16(v0[2], v0[3]), cvt_pk_bf16(v1[0], v1[1]), cvt_pk_bf16(v1[2], v1[3])};
                    *(u32x4*)(rowp + bj * HALF) = w; } }
    }
};
}
__device__ __forceinline__ void transpose_item(const float* W, int ld, int c0, bf16_t* WT, int K, int r0, int nblk, LAS float* scr, int item, int lane) {
    const int kb = item / nblk, nb = item % nblk, k0 = 64 * kb, n0 = 32 * nb;
#pragma unroll 8
    for (int i = 0; i < 32; ++i) { const int kk = 2 * i + (lane >> 5); scr[kk * 33 + (lane & 31)] = W[(size_t)(k0 + kk) * ld + c0 + n0 + (lane & 31)]; }
    asm volatile("s_waitcnt lgkmcnt(0)" ::: "memory");
    const int c = lane & 7;
#pragma unroll
    for (int j = 0; j < 4; ++j) { const int n = (lane >> 3) + 8 * j; const LAS float* s = scr + (8 * c) * 33 + n;
        u32x4 o; o.x = pk2(s[0 * 33], s[1 * 33]); o.y = pk2(s[2 * 33], s[3 * 33]); o.z = pk2(s[4 * 33], s[5 * 33]); o.w = pk2(s[6 * 33], s[7 * 33]);
        *(u32x4*)(WT + (size_t)(r0 + n0 + n) * K + k0 + 8 * c) = o; }
    asm volatile("s_waitcnt lgkmcnt(0)" ::: "memory");
}
__device__ __forceinline__ void p_convert(unsigned char* lds, const float* w_in, const float* w_out, const float* w_q,
                                                    bf16_t* WinT, bf16_t* WoutT, bf16_t* WqT, float* WFT) {
    const int tid = opaque_tid(), lane = tid & 63, wave = tid >> 6;
    constexpr int TP = 272, I_O = 0  , NIT = I_O + 8 * 32, PER = NIT / 256;
    static_assert(NIT % 256 == 0, "items must divide evenly over 256 workgroups");
    unsigned char* tile = lds;
    f32x4 x[16];
#define CV_ITEM(it_, src_, ld_, dst_, n0_, k0_) const bool isq_ = (it_) >= I_O; const int j_ = isq_ ? (it_) - I_O : (it_); const float* src_ = isq_ ? w_q : w_out; const int ld_ = isq_ ? PEER_QW : DM; \
        bf16_t* dst_ = isq_ ? WqT : WoutT; const int n0_ = 256 * (j_ >> 5), k0_ = 128 * (j_ & 31)
    { CV_ITEM(blockIdx.x * PER, src, ld, dst, n0, k0); (void)dst;
#pragma unroll
      for (int r = 0; r < 16; ++r) x[r] = *(const f32x4*)(src + (size_t)(k0 + 16 * wave + r) * ld + n0 + 4 * lane); }
#pragma unroll 1
    for (int i = 0; i < PER; ++i) {
        CV_ITEM(blockIdx.x * PER + i, src, ld, dst, n0, k0); (void)src; (void)ld;
        u32x4 P[4][2];
#pragma unroll
        for (int b4 = 0; b4 < 4; ++b4)
#pragma unroll
            for (int d = 0; d < 8; ++d) P[b4][d >> 2][d & 3] = pk2(x[2 * d][b4], x[2 * d + 1][b4]);
        if (i + 1 < PER) { CV_ITEM(blockIdx.x * PER + i + 1, src1, ld1, dst1, n1, k1); (void)dst1;
#pragma unroll
            for (int r = 0; r < 16; ++r) x[r] = *(const f32x4*)(src1 + (size_t)(k1 + 16 * wave + r) * ld1 + n1 + 4 * lane); }
#pragma unroll
        for (int b4 = 0; b4 < 4; ++b4) { *(u32x4*)(tile + (4 * lane + b4) * TP + 32 * wave) = P[b4][0]; *(u32x4*)(tile + (4 * lane + b4) * TP + 32 * wave + 16) = P[b4][1]; }
        __syncthreads();
#pragma unroll
        for (int ps = 0; ps < 8; ++ps) { const int n = 32 * ps + (tid >> 4), pc = tid & 15;
            *(u32x4*)((unsigned char*)(dst + (size_t)(n0 + n) * DM + k0) + 16 * pc) = *(const u32x4*)(tile + n * TP + 16 * pc); }
        __syncthreads();
    }
#undef CV_ITEM
    const size_t gt = (size_t)blockIdx.x * 512 + tid, NGT = (size_t)gridDim.x * 512;
    for (size_t i = gt; i < (size_t)16 * DM; i += NGT) { const int h = (int)(i / DM), k = (int)(i % DM); WFT[i] = w_in[(size_t)k * NIN + 6144 + h]; }
}
__device__ __forceinline__ void p_adaln(unsigned char* lds, const float* c, const float* ada_w, float* mod) {
    float* cact = (float*)lds;
    float* part = cact + DM;
    const int tid = opaque_tid();
    for (int i = tid; i < DM; i += 512) cact[i] = silu_f(c[i]);
    __syncthreads();
    const int g = tid / 24, q = tid % 24;
    for (int cb = blockIdx.x; cb < 6 * DM / 96; cb += gridDim.x) {
        f32x4 acc = {0.f, 0.f, 0.f, 0.f};
        if (g < 21) {
            const float* wp = ada_w + (size_t)cb * 96 + 4 * q;
#pragma unroll 8
            for (int k = g; k < DM; k += 21) { const f32x4 w = *(const f32x4*)(wp + (size_t)k * (6 * DM)); acc += w * cact[k]; }
            *(f32x4*)(part + g * 96 + 4 * q) = acc;
        }
        __syncthreads();
        if (tid < 96) { float s = 0.f;
#pragma unroll
            for (int j = 0; j < 21; ++j) s += part[j * 96 + tid];
            mod[cb * 96 + tid] = s; }
        __syncthreads();
    }
}
__device__ __forceinline__ float dot2_bf16(unsigned a, unsigned b, float c) { typedef __bf16 bf2_ __attribute__((ext_vector_type(2))); return __builtin_amdgcn_fdot2_f32_bf16(__builtin_bit_cast(bf2_, a), __builtin_bit_cast(bf2_, b), c, false); }
__device__ __forceinline__ void p_norm1(unsigned char* lds, const float* x, const float* mod, const float* ada_b, const float* g1, const float* WFT, const float* fbias, unsigned char* H1Q, float* SA, float* FLOGF) {
    unsigned short* A1h = (unsigned short*)lds; unsigned short* B1h = A1h + DM; unsigned short* WFh = B1h + DM;
    const int tid = opaque_tid(), lane = tid & 63, wave = tid >> 6;
    for (int i = tid; i < DM; i += 512) { A1h[i] = (unsigned short)f2bf(g1[i] * (1.f + mod[DM + i] + ada_b[DM + i])); B1h[i] = (unsigned short)f2bf(mod[i] + ada_b[i]); }
    for (int i = tid; i < 16 * DM / 4; i += 512) { const f32x4 w = *(const f32x4*)(WFT + 4 * i); *(u32x2*)(WFh + 4 * i) = (u32x2){pk2(w[0], w[1]), pk2(w[2], w[3])}; }
    __syncthreads();
#define UNPK4(p_) ((f32x4){bf2f((p_).x & 0xffffu), bf2f((p_).x >> 16), bf2f((p_).y & 0xffffu), bf2f((p_).y >> 16)})
    for (int t0 = (blockIdx.x * 8 + wave) * 2; t0 < T_; t0 += gridDim.x * 16) {
        u32x2 hp[2][16];
#pragma unroll
        for (int tk = 0; tk < 2; ++tk) {
            const f32x4* xr = (const f32x4*)(x + (size_t)(t0 + tk) * DM) + lane;
            f32x4 v[16]; float ss = 0.f;
#pragma unroll
            for (int j = 0; j < 16; ++j) { v[j] = xr[64 * j]; ss += (v[j][0] * v[j][0] + v[j][1] * v[j][1]) + (v[j][2] * v[j][2] + v[j][3] * v[j][3]); }
            const float rstd = rsqrtf(wave_sum(ss) * (1.f / DM) + EPS_);
            float mx = 0.f;
#pragma unroll
            for (int j = 0; j < 16; ++j) { const u32x2 ap = *(const u32x2*)(A1h + 4 * lane + 256 * j), bp = *(const u32x2*)(B1h + 4 * lane + 256 * j);
                const f32x4 hh = v[j] * rstd * UNPK4(ap) + UNPK4(bp); hp[tk][j] = (u32x2){pk2(hh[0], hh[1]), pk2(hh[2], hh[3])}; v[j] = hh;
                mx = fmaxf(fmaxf(mx, fmaxf(fabsf(hh[0]), fabsf(hh[1]))), fmaxf(fabsf(hh[2]), fabsf(hh[3]))); }
#pragma unroll
            for (int o = 1; o < 64; o <<= 1) mx = fmaxf(mx, __shfl_xor(mx, o));
            const float sc = fmaxf(mx, 1e-30f) * (1.f / 127.f), inv = 1.f / sc;
            unsigned* q8 = (unsigned*)(H1Q + (size_t)(t0 + tk) * DM) + lane;
#pragma unroll
            for (int j = 0; j < 16; ++j) { const int b0 = (int)rintf(v[j][0] * inv) & 0xff, b1 = (int)rintf(v[j][1] * inv) & 0xff, b2 = (int)rintf(v[j][2] * inv) & 0xff, b3 = (int)rintf(v[j][3] * inv) & 0xff;
                q8[64 * j] = (unsigned)b0 | ((unsigned)b1 << 8) | ((unsigned)b2 << 16) | ((unsigned)b3 << 24); }
            if (lane == 0) SA[t0 + tk] = sc;
            asm volatile("" ::: "memory");
        }
        float dd0[16], dd1[16];
#pragma unroll
        for (int h = 0; h < 16; ++h) { float d0 = 0.f, d1 = 0.f;
#pragma unroll
            for (int j = 0; j < 16; ++j) { const u32x2 wp = *(const u32x2*)(WFh + h * DM + 4 * lane + 256 * j);
                d0 = dot2_bf16(hp[0][j].x, wp.x, d0); d0 = dot2_bf16(hp[0][j].y, wp.y, d0); d1 = dot2_bf16(hp[1][j].x, wp.x, d1); d1 = dot2_bf16(hp[1][j].y, wp.y, d1); }
            dd0[h] = d0; dd1[h] = d1; }
        float r16[16], r8[8], r4[4], r2[2], r1;
        { const bool hi = lane & 32;
#pragma unroll
          for (int j = 0; j < 16; ++j) r16[j] = (hi ? dd1[j] : dd0[j]) + __shfl_xor(hi ? dd0[j] : dd1[j], 32); }
        { const bool hi = lane & 16;
#pragma unroll
          for (int j = 0; j < 8; ++j) r8[j] = (hi ? r16[j + 8] : r16[j]) + __shfl_xor(hi ? r16[j] : r16[j + 8], 16); }
        { const bool hi = lane & 8;
#pragma unroll
          for (int j = 0; j < 4; ++j) r4[j] = (hi ? r8[j + 4] : r8[j]) + __shfl_xor(hi ? r8[j] : r8[j + 4], 8); }
        { const bool hi = lane & 4;
#pragma unroll
          for (int j = 0; j < 2; ++j) r2[j] = (hi ? r4[j + 2] : r4[j]) + __shfl_xor(hi ? r4[j] : r4[j + 2], 4); }
        { const bool hi = lane & 2; r1 = (hi ? r2[1] : r2[0]) + __shfl_xor(hi ? r2[0] : r2[1], 2); }
        r1 += __shfl_xor(r1, 1);
        if ((lane & 1) == 0) { const int h = (lane >> 1) & 15; const float z = r1 + fbias[h]; FLOGF[(size_t)h * T_ + t0 + (lane >> 5)] = fminf(z, 0.f) - log1pf(__expf(-fabsf(z))); }
    }
#undef UNPK4
}
__device__ __forceinline__ void p_post1(unsigned char* lds, const float* PROJ, const float* qg, const float* kg, const float* lbw,
                                                  bf16_t* FQ, bf16_t* FK, bf16_t* FV, bf16_t* HQ, bf16_t* HK, bf16_t* HV, bf16_t* HG, float* HLF) {
    const int tid = opaque_tid(), lane = tid & 63, wave = tid >> 6;
    for (int t = blockIdx.x * 8 + wave; t < T_; t += gridDim.x * 8) {
        const float* row = PROJ + (size_t)t * NPROJ;
        for (int s = 0; s < 112; ++s) {
            const int ty = s >> 4, h = s & 15, c = 2 * lane;
            const f32x2 p = *(const f32x2*)(row + s * 128 + c);
            const size_t o = ((size_t)h * T_ + t) * HDIM + c;
            if (ty < 2) {
                const float rs = rsqrtf(wave_sum(p[0] * p[0] + p[1] * p[1]) * (1.f / HDIM) + EPS_);
                const float* g = (ty == 0 ? qg : kg) + h * HDIM + c;
                *(unsigned*)((ty == 0 ? FQ : FK) + o) = pk2(p[0] * rs * g[0], p[1] * rs * g[1]);
            } else if (ty == 2) { *(unsigned*)(FV + o) = pk2(p[0], p[1]); }
            else if (ty == 3) { *(unsigned*)(HQ + o) = pk2(silu_f(p[0]) * 0.08838834764831845f, silu_f(p[1]) * 0.08838834764831845f); }
            else if (ty == 4) {
                const int j = h * HDIM + c;
                const float lb0 = 1.f / (1.f + __expf(lbw[HGW + j] - lbw[j])), lb1 = 1.f / (1.f + __expf(lbw[HGW + j + 1] - lbw[j + 1]));
                const float f0 = lb0 + (1.f - lb0) * sigmoid_f(p[0]), f1 = lb1 + (1.f - lb1) * sigmoid_f(p[1]);
                *(f32x2*)(HLF + o) = (f32x2){__logf(f0), __logf(f1)};
                *(unsigned*)(HK + o) = pk2(1.f - f0, 1.f - f1);
            } else if (ty == 5) { *(unsigned*)(HV + o) = pk2(p[0], p[1]); }
            else { *(unsigned*)(HG + o) = pk2(silu_f(p[0]), silu_f(p[1])); }
        }
    }
}
__device__ __forceinline__ void p_scan(unsigned char* lds, const float* FLOGF, float* FCUM) {
    float* part = (float*)lds;
    const int tid = opaque_tid();
    for (int h = blockIdx.x; h < NHEAD; h += gridDim.x) {
        const float* src = FLOGF + (size_t)h * T_ + tid * 16; float v[16]; float s = 0.f;
#pragma unroll
        for (int i = 0; i < 16; ++i) { s += src[i]; v[i] = s; }
        part[tid] = s; __syncthreads();
        if (tid == 0) { float run = 0.f; for (int i = 0; i < 512; ++i) { const float p = part[i]; part[i] = run; run += p; } }
        __syncthreads();
        const float off = part[tid]; float* dst = FCUM + (size_t)h * T_ + tid * 16;
#pragma unroll
        for (int i = 0; i < 16; ++i) dst[i] = v[i] + off;
        __syncthreads();
    }
}
constexpr int SLB = 256;
__device__ __forceinline__ void p_convert_uv4(unsigned char* lds, unsigned* qhead, const float* u, const float* v, unsigned char* U4, float* SU, unsigned char* V4, float* SV) {
    const int tid = opaque_tid(), lane = tid & 63, wave = tid >> 6;
    volatile unsigned* slot = (volatile unsigned*)lds;
    for (;;) {
        __syncthreads();
        if (tid == 0) *slot = __hip_atomic_fetch_add(qhead, 1u, __ATOMIC_RELAXED, __HIP_MEMORY_SCOPE_AGENT);
        __syncthreads();
        const unsigned chunk = *slot;
        if (chunk >= 2u * PEER_NE / 8u) break;
        { const int r = (int)chunk * 8 + wave;
        const bool isv = r >= PEER_NE; const int e = isv ? r - PEER_NE : r;
        const float* src = (isv ? v : u) + (size_t)e * DM;
        f32x4 x[16]; float mx = 0.f, ss = 0.f;
#pragma unroll
        for (int i = 0; i < 16; ++i) {
            const int m = lane + 64 * (i >> 3);
            x[i] = *(const f32x4*)(src + 512 * (m >> 4) + 16 * (m & 15) + 256 * ((i >> 2) & 1) + 4 * (i & 3));
            ss += (x[i][0] * x[i][0] + x[i][1] * x[i][1]) + (x[i][2] * x[i][2] + x[i][3] * x[i][3]);
            mx = fmaxf(fmaxf(mx, fmaxf(fabsf(x[i][0]), fabsf(x[i][1]))), fmaxf(fabsf(x[i][2]), fabsf(x[i][3]))); }
#pragma unroll
        for (int o = 1; o < 64; o <<= 1) { mx = fmaxf(mx, __shfl_xor(mx, o)); ss += __shfl_xor(ss, o); }
        const float sc = fmaxf(fminf(0.3352f * sqrtf(ss * (1.f / DM)), mx * (1.f / 7.5f)), 1e-30f), inv = 1.f / sc;
        unsigned qd[16];
#pragma unroll
        for (int i = 0; i < 16; ++i) { qd[i] = 0u;
#pragma unroll
            for (int b4 = 0; b4 < 4; ++b4) qd[i] |= (unsigned)(int)fminf(fmaxf(floorf(x[i][b4] * inv) + 8.f, 0.f), 15.f) << (8 * b4);
            if (!isv || (i & 4)) qd[i] ^= 0x08080808u; }
        unsigned char* dst = (isv ? V4 : U4) + ((size_t)(lane >> 4) * PEER_NE + e) * SLB + 16 * (lane & 15);
        *(u32x4*)(dst) = (u32x4){qd[0] | (qd[4] << 4), qd[1] | (qd[5] << 4), qd[2] | (qd[6] << 4), qd[3] | (qd[7] << 4)};
        *(u32x4*)(dst + (size_t)4 * PEER_NE * SLB) = (u32x4){qd[8] | (qd[12] << 4), qd[9] | (qd[13] << 4), qd[10] | (qd[14] << 4), qd[11] | (qd[15] << 4)};
        if (lane == 0) (isv ? SV : SU)[e] = sc; }
    }
}
template <int LD> __device__ __forceinline__ void p_colmax(const float* W, float* PM) {
    const int tid = opaque_tid();
    constexpr int NCH = (LD + 2047) / 2048;
    for (int it = blockIdx.x; it < 64 * NCH; it += gridDim.x) {
        const int ch = it % NCH, ks = it / NCH, col = ch * 2048 + tid * 4;
        if (col < LD) {
            f32x4 mx = {0.f, 0.f, 0.f, 0.f};
#pragma unroll 16
            for (int k = 0; k < 64; ++k) { const f32x4 w = *(const f32x4*)(W + (size_t)(ks * 64 + k) * LD + col); mx = (f32x4){fmaxf(mx[0], fabsf(w[0])), fmaxf(mx[1], fabsf(w[1])), fmaxf(mx[2], fabsf(w[2])), fmaxf(mx[3], fabsf(w[3]))}; }
            *(f32x4*)(PM + (size_t)ks * LD + col) = mx;
        }
    }
}
template <int LD, int NOUT, bool GAP16> __device__ __forceinline__ void p_quant_w(unsigned char* lds, const float* W, const float* PM, unsigned char* WT8, float* SB) {
    const int tid = opaque_tid(), lane = tid & 63, wave = tid >> 6;
    constexpr int TP = 144, NIT = (NOUT / 256) * (DM / 128), PER = NIT / 256;
    static_assert(NIT % 256 == 0, "items must divide evenly over 256 workgroups");
    unsigned char* tile = lds;
    float* redm = (float*)(lds + 256 * TP);
    float* scl = redm + 512;
    int gcur = -1; f32x4 inv = {0.f, 0.f, 0.f, 0.f};
    f32x4 x[16];
    { const int it = blockIdx.x * PER, g = it / (DM / 128), kt = it % (DM / 128), n0 = 256 * g, c0 = (GAP16 && n0 >= 6144) ? n0 + 16 : n0;
#pragma unroll
      for (int r = 0; r < 16; ++r) x[r] = *(const f32x4*)(W + (size_t)(128 * kt + 16 * wave + r) * LD + c0 + 4 * lane); }
#pragma unroll 1
    for (int i = 0; i < PER; ++i) {
        const int it = blockIdx.x * PER + i, g = it / (DM / 128), kt = it % (DM / 128), n0 = 256 * g, c0 = (GAP16 && n0 >= 6144) ? n0 + 16 : n0, k0 = 128 * kt;
        if (g != gcur) {
            gcur = g;
            { const int c = tid & 255, hf = tid >> 8; float m = 0.f;
#pragma unroll 8
              for (int p = 0; p < 32; ++p) m = fmaxf(m, PM[(size_t)(32 * hf + p) * LD + c0 + c]);
              redm[hf * 256 + c] = m; }
            __syncthreads();
            if (tid < 256) { const float sc = fmaxf(fmaxf(redm[tid], redm[256 + tid]), 1e-30f) * (1.f / 127.f); scl[tid] = 1.f / sc; if (kt == 0) SB[n0 + tid] = sc; }
            __syncthreads();
            inv = *(const f32x4*)(scl + 4 * lane);
        }
        u32x4 P[4];
#pragma unroll
        for (int b4 = 0; b4 < 4; ++b4)
#pragma unroll
            for (int d = 0; d < 4; ++d) { unsigned v = 0u;
#pragma unroll
                for (int e2 = 0; e2 < 4; ++e2) v |= ((unsigned)((int)fminf(fmaxf(rintf(x[4 * d + e2][b4] * inv[b4]), -127.f), 127.f) & 0xff)) << (8 * e2);
                P[b4][d] = v; }
        if (i + 1 < PER) { const int it1 = it + 1, g1 = it1 / (DM / 128), kt1 = it1 % (DM / 128), n1 = 256 * g1, c1 = (GAP16 && n1 >= 6144) ? n1 + 16 : n1;
#pragma unroll
            for (int r = 0; r < 16; ++r) x[r] = *(const f32x4*)(W + (size_t)(128 * kt1 + 16 * wave + r) * LD + c1 + 4 * lane); }
#pragma unroll
        for (int b4 = 0; b4 < 4; ++b4) *(u32x4*)(tile + (4 * lane + b4) * TP + 16 * wave) = P[b4];
        __syncthreads();
#pragma unroll
        for (int ps = 0; ps < 4; ++ps) { const int n = 64 * ps + (tid >> 3), pc = tid & 7;
            *(u32x4*)(WT8 + (size_t)(n0 + n) * DM + k0 + 16 * pc) = *(const u32x4*)(tile + n * TP + 16 * pc); }
        __syncthreads();
    }
}
__device__ __forceinline__ void p_quant_merged(const bf16_t* MERGED, unsigned char* M8, float* SM) {
    const int tid = opaque_tid(), lane = tid & 63, wave = tid >> 6;
    for (int t = blockIdx.x * 8 + wave; t < T_; t += gridDim.x * 8) {
        const u32x4* src = (const u32x4*)(MERGED + (size_t)t * DM + 16 * lane);
        u32x4 w[4][2]; float mx = 0.f;
#pragma unroll
        for (int j = 0; j < 4; ++j) { w[j][0] = src[128 * j]; w[j][1] = src[128 * j + 1];
#pragma unroll
            for (int h = 0; h < 2; ++h)
#pragma unroll
                for (int c = 0; c < 4; ++c) mx = fmaxf(mx, fmaxf(fabsf(bf2f(w[j][h][c] & 0xffffu)), fabsf(bf2f(w[j][h][c] >> 16)))); }
#pragma unroll
        for (int o = 1; o < 64; o <<= 1) mx = fmaxf(mx, __shfl_xor(mx, o));
        const float sc = fmaxf(mx, 1e-30f) * (1.f / 127.f), inv = 1.f / sc;
#pragma unroll
        for (int j = 0; j < 4; ++j) { u32x4 o;
#pragma unroll
            for (int q = 0; q < 4; ++q) { const unsigned a = w[j][q >> 1][2 * (q & 1)], b = w[j][q >> 1][2 * (q & 1) + 1];
                o[q] = ((unsigned)((int)rintf(bf2f(a & 0xffffu) * inv) & 0xff)) | (((unsigned)((int)rintf(bf2f(a >> 16) * inv) & 0xff)) << 8) |
                       (((unsigned)((int)rintf(bf2f(b & 0xffffu) * inv) & 0xff)) << 16) | (((unsigned)((int)rintf(bf2f(b >> 16) * inv) & 0xff)) << 24); }
            *(u32x4*)(M8 + (size_t)t * DM + 16 * lane + 1024 * j) = o; }
        if (lane == 0) SM[t] = sc;
    }
}
namespace fox {
constexpr int B = 1, H = NHEAD, HKV = NHEAD, SQ = T_, SKV = T_, D = HDIM, QOFF = 0, WINDOW = SKV;
constexpr float THR = 8.f;
constexpr bool WSKIP = false;
constexpr float SCALE = 0.08838834764831845f;
constexpr float INV_SCALE = 11.313708498984761f;
constexpr int NW = 8, QBLK = 32, KVBLK = 64, QB = NW * QBLK;
constexpr int SHM_V = KVBLK * D * 2, SHM_K = KVBLK * D * 2;
constexpr int LDS_BYTES = 2 * SHM_V + 2 * SHM_K + NW * 64 * 4;
constexpr int CUM_OFF = LDS_BYTES;
constexpr int OST = 4096;
static_assert(D == 128 && SQ % QB == 0 && SKV % KVBLK == 0 && H % HKV == 0 && QOFF >= 0 && QOFF + SQ <= SKV && WINDOW >= 1, "geometry");

using bf16 = __hip_bfloat16;
typedef short bf16x8 __attribute__((ext_vector_type(8)));
typedef short s16x4 __attribute__((ext_vector_type(4)));
typedef float f32x16 __attribute__((ext_vector_type(16)));
typedef float f32x4 __attribute__((ext_vector_type(4)));
typedef unsigned u32x4 __attribute__((ext_vector_type(4)));
template <class A, class Bt> struct same_t { static constexpr bool v = false; };
template <class A> struct same_t<A, A> { static constexpr bool v = true; };

#define KSWZ(row, colB) ((row) * 256 + ((colB) ^ (((row) & 7) << 4)))
#define SBAR() __builtin_amdgcn_sched_barrier(0)
__device__ __forceinline__ int v_st(int k, int c) { const int kk = (k & ~0xC) | ((k & 4) << 1) | ((k & 8) >> 1); return ((kk >> 3) * 4 + (c >> 5)) * 512 + ((kk & 7) * 32 + (c & 31)) * 2; }
__device__ __forceinline__ int v_rd_base(int lane) { return ((lane & 3) << 3) | (((lane >> 2) & 3) << 6) | (((lane >> 4) & 1) << 5) | (((lane >> 5) & 1) << 8); }
constexpr int v_rd_off(int d0, int ks, int half) { return d0 * 512 + ks * 4096 + half * 2048; }
__device__ __forceinline__ int crow(int r, int hi) { return (r & 3) + 8 * (r >> 2) + 4 * hi; }
__device__ __forceinline__ unsigned cvtpk(float lo, float hi) {
    unsigned r; asm volatile("v_cvt_pk_bf16_f32 %0, %1, %2" : "=v"(r) : "v"(lo), "v"(hi)); return r;
}
__device__ __forceinline__ bf16x8 pack8(f32x4 a, f32x4 b) {
    u32x4 w = {cvtpk(a[0], a[1]), cvtpk(a[2], a[3]), cvtpk(b[0], b[1]), cvtpk(b[2], b[3])};
    return *reinterpret_cast<bf16x8*>(&w);
}
template <class T> __device__ __forceinline__ bf16x8 load8(const T* p) {
    if constexpr (same_t<T, float>::v) { return pack8(*(const f32x4*)p, *(const f32x4*)(p + 4)); }
    else { return *reinterpret_cast<const bf16x8*>(p); }
}
__device__ __forceinline__ void mask_tile(f32x16& p0, f32x16& p1, int dq, unsigned W) {
    const float NEG = -__builtin_inff();
#pragma unroll
    for (int r = 0; r < 16; ++r) {
        const int c = (r & 3) + 8 * (r >> 2);
        if ((unsigned)(dq - c) >= W) p0[r] = NEG;
        if ((unsigned)(dq - c - 32) >= W) p1[r] = NEG;
    }
}
__device__ __forceinline__ void partialSM(f32x16& p0, f32x16& p1, float& m_reg, float& mn, float& alpha) {
    float pmax = p0[0]; for (int r = 1; r < 16; ++r) pmax = fmaxf(pmax, p0[r]); for (int r = 0; r < 16; ++r) pmax = fmaxf(pmax, p1[r]);
    { auto rr = __builtin_amdgcn_permlane32_swap(__float_as_uint(pmax), __float_as_uint(pmax), false, false);
      pmax = fmaxf(__uint_as_float(rr[0]), __uint_as_float(rr[1])); }
    constexpr float C2 = 1.4426950408889634f * SCALE;
    if (__builtin_expect(__all((pmax - m_reg) * SCALE <= THR), 1)) { mn = m_reg; alpha = 1.f; }
    else { mn = fmaxf(m_reg, pmax); alpha = __builtin_amdgcn_exp2f((m_reg - mn) * C2); m_reg = mn; }
    const float mnL = -mn * C2;
    for (int r = 0; r < 16; ++r) p0[r] = fmaf(p0[r], C2, mnL); for (int r = 0; r < 16; ++r) p1[r] = fmaf(p1[r], C2, mnL);
    for (int r = 0; r < 16; ++r) p0[r] = __builtin_amdgcn_exp2f(p0[r]);
}
__device__ __forceinline__ void finishSM(f32x16& p0, f32x16& p1, float alpha, float& l_reg, bf16x8& pa0, bf16x8& pa1, bf16x8& pa2, bf16x8& pa3) {
    for (int r = 0; r < 16; ++r) p1[r] = __builtin_amdgcn_exp2f(p1[r]);
    float ps = 0; for (int r = 0; r < 16; ++r) ps += p0[r]; for (int r = 0; r < 16; ++r) ps += p1[r];
    { auto rr = __builtin_amdgcn_permlane32_swap(__float_as_uint(ps), __float_as_uint(ps), false, false);
      ps = __uint_as_float(rr[0]) + __uint_as_float(rr[1]); }
    l_reg = l_reg * alpha + ps;
#define PK4(P, B_, OUT) do { unsigned a0 = cvtpk(P[B_+0], P[B_+1]), a1 = cvtpk(P[B_+2], P[B_+3]);                          \
        unsigned b0 = cvtpk(P[B_+4], P[B_+5]), b1 = cvtpk(P[B_+6], P[B_+7]);                                             \
        auto r0 = __builtin_amdgcn_permlane32_swap(a0, b0, false, false); auto r1 = __builtin_amdgcn_permlane32_swap(a1, b1, false, false); \
        u32x4 w = {r0[0], r1[0], r0[1], r1[1]}; OUT = *reinterpret_cast<bf16x8*>(&w); } while (0)
    PK4(p0, 0, pa0); PK4(p0, 8, pa1); PK4(p1, 0, pa2); PK4(p1, 8, pa3);
#undef PK4
}
template <int KB, bool SK>
__device__ __forceinline__ void qkt(f32x16& p0, f32x16& p1, const char* K_lds, int r32, int hi, const bf16x8* qr, bool act, const float* cb) {
    if (SK && !act) { const float NEG = -__builtin_inff();
#pragma unroll
        for (int r = 0; r < 16; ++r) { p0[r] = NEG; p1[r] = NEG; } return; }
#pragma unroll
    for (int g = 0; g < 4; ++g) { const f32x4 c0 = *(const f32x4*)(cb + 8 * g), c1 = *(const f32x4*)(cb + 32 + 8 * g);
#pragma unroll
        for (int e = 0; e < 4; ++e) { p0[4 * g + e] = c0[e]; p1[4 * g + e] = c1[e]; } }
    const char* kb[4];
#pragma unroll
    for (int dd = 0; dd < 4; ++dd) kb[dd] = K_lds + KB * SHM_K + KSWZ(r32, (dd * 16 + hi * 8) * 2);
#pragma unroll
    for (int d0 = 0; d0 < 8; ++d0) { const char* a = kb[d0 & 3] + (d0 >> 2) * 128;
        bf16x8 b0 = *reinterpret_cast<const bf16x8*>(a);
        bf16x8 b1 = *reinterpret_cast<const bf16x8*>(a + 32 * 256);
        p0 = __builtin_amdgcn_mfma_f32_32x32x16_bf16(b0, qr[d0], p0, 0, 0, 0);
        p1 = __builtin_amdgcn_mfma_f32_32x32x16_bf16(b1, qr[d0], p1, 0, 0, 0); }
}
template <int VB, bool SK>
__device__ __forceinline__ void pv_tile(f32x16* o, int vb0, bf16x8 pa0, bf16x8 pa1, bf16x8 pa2, bf16x8 pa3, bool act) {
    if (SK && !act) return;
#define TRRD(dst, off) asm volatile("ds_read_b64_tr_b16 %0, %1 offset:%2" : "=&v"(dst) : "v"(vb0), "i"(off) : "memory")
#define PV_D0(d0) do { s16x4 l0, l1, l2, l3, h0, h1, h2, h3; constexpr int b_ = VB * SHM_V + v_rd_off(d0, 0, 0);     \
        TRRD(l0, b_); TRRD(h0, b_ + 2048); TRRD(l1, b_ + 4096); TRRD(h1, b_ + 6144); TRRD(l2, b_ + 8192); TRRD(h2, b_ + 10240); TRRD(l3, b_ + 12288); TRRD(h3, b_ + 14336); \
        asm volatile("s_waitcnt lgkmcnt(0)" ::: "memory"); SBAR();                 \
        o[d0] = __builtin_amdgcn_mfma_f32_32x32x16_bf16(pa0, (bf16x8){l0[0], l0[1], l0[2], l0[3], h0[0], h0[1], h0[2], h0[3]}, o[d0], 0, 0, 0);   \
        o[d0] = __builtin_amdgcn_mfma_f32_32x32x16_bf16(pa1, (bf16x8){l1[0], l1[1], l1[2], l1[3], h1[0], h1[1], h1[2], h1[3]}, o[d0], 0, 0, 0);   \
        o[d0] = __builtin_amdgcn_mfma_f32_32x32x16_bf16(pa2, (bf16x8){l2[0], l2[1], l2[2], l2[3], h2[0], h2[1], h2[2], h2[3]}, o[d0], 0, 0, 0);   \
        o[d0] = __builtin_amdgcn_mfma_f32_32x32x16_bf16(pa3, (bf16x8){l3[0], l3[1], l3[2], l3[3], h3[0], h3[1], h3[2], h3[3]}, o[d0], 0, 0, 0); } while (0)
    PV_D0(0); PV_D0(1); PV_D0(2); PV_D0(3);
#undef PV_D0
#undef TRRD
}

template <class TIn, class TOut> struct BlockRef { const TIn* Q; const TIn* K; const TIn* V; TOut* O; int P0; };
template <class TIn> struct Seam {
    bf16x8 qr[8];
    bf16x8 st_v0, st_v1, st_k0, st_k1; f32x4 sf0, sf1, sf2, sf3;
    f32x4 tq[16];
};
__device__ __forceinline__ int swa_jlo(int P0, int W) { const int lowk = P0 - W + 1; return lowk > 0 ? lowk / KVBLK : 0; }
#define ROW(p, k0, rr) ((p) + (size_t)((k0) + (rr)) * D + sc)
#define VMW() asm volatile("s_waitcnt vmcnt(0)" ::: "memory")
#define VMWN(n) asm volatile("s_waitcnt vmcnt(%0)" :: "i"(n) : "memory")
#define SLOAD_H(Kp, Vp, k0) do { S.st_v0 = load8<TIn>(ROW(Vp, k0, sr)); S.st_v1 = load8<TIn>(ROW(Vp, k0, 32 + sr));              \
                         S.st_k0 = load8<TIn>(ROW(Kp, k0, sr)); S.st_k1 = load8<TIn>(ROW(Kp, k0, 32 + sr)); } while (0)
#define SWRITE_HK(bf) do { *(bf16x8*)(K_lds + (bf) * SHM_K + kws) = S.st_k0; *(bf16x8*)(K_lds + (bf) * SHM_K + kws + 32 * 256) = S.st_k1; } while (0)
#define SWRITE_HV(bf) do { *(bf16x8*)(V_lds + (bf) * SHM_V + vst0) = S.st_v0; *(bf16x8*)(V_lds + (bf) * SHM_V + vst1) = S.st_v1; } while (0)
#define SWRITE_H(bf) do { SWRITE_HV(bf); SWRITE_HK(bf); } while (0)
#define SLOAD_F(p, k0) do { S.sf0 = *(const f32x4*)ROW(p, k0, sr); S.sf1 = *(const f32x4*)(ROW(p, k0, sr) + 4);                \
                            S.sf2 = *(const f32x4*)ROW(p, k0, 32 + sr); S.sf3 = *(const f32x4*)(ROW(p, k0, 32 + sr) + 4); } while (0)
#define SWRITE_KF(bf) do { *(bf16x8*)(K_lds + (bf) * SHM_K + kws) = pack8(S.sf0, S.sf1); *(bf16x8*)(K_lds + (bf) * SHM_K + kws + 32 * 256) = pack8(S.sf2, S.sf3); } while (0)
#define SWRITE_VF(bf) do { *(bf16x8*)(V_lds + (bf) * SHM_V + vst0) = pack8(S.sf0, S.sf1); *(bf16x8*)(V_lds + (bf) * SHM_V + vst1) = pack8(S.sf2, S.sf3); } while (0)
template <class TIn, class TOut>
__device__ __forceinline__ void causal_swa_prime(const BlockRef<TIn, TOut>& cur, int W, char* lds, Seam<TIn>& S) {
    constexpr bool F32 = same_t<TIn, float>::v;
    const int tid = opaque_tid(), wid = __builtin_amdgcn_readfirstlane(tid >> 6), lane = tid & 63, r32 = lane & 31, hi = lane >> 5;
    const int sr = tid >> 4, sc = (tid & 15) * 8, kws = KSWZ(sr, sc * 2); char* K_lds = lds + 2 * SHM_V;
    const int kb0 = swa_jlo(cur.P0, W) * KVBLK;
    for (int d0 = 0; d0 < 8; ++d0) S.qr[d0] = load8<TIn>(cur.Q + (size_t)(wid * QBLK + r32) * D + d0 * 16 + hi * 8);
    if constexpr (F32) { SLOAD_F((const float*)cur.K, kb0); VMW(); SWRITE_KF(0); SBAR(); SLOAD_F((const float*)cur.V, kb0); }
    else { SLOAD_H(cur.K, cur.V, kb0); VMW(); SWRITE_HK(0); }
    __syncthreads();
}
template <class TIn, class TOut>
__device__ __forceinline__ void causal_swa_block(const BlockRef<TIn, TOut>& cur, const BlockRef<TIn, TOut>& nxt, int skv, int W, char* lds, Seam<TIn>& S) {
    constexpr bool F32 = same_t<TIn, float>::v;
    const int tid = opaque_tid(), wid = __builtin_amdgcn_readfirstlane(tid >> 6), lane = tid & 63, r32 = lane & 31, hi = lane >> 5;
    const int j_lo = swa_jlo(cur.P0, W);
    int j_hi = (cur.P0 + QB - 1) / KVBLK + 1; if (j_hi > skv / KVBLK) j_hi = skv / KVBLK;
    const int NT = j_hi - j_lo;
    const int kbn = swa_jlo(nxt.P0, W) * KVBLK;
    const int qlo = cur.P0 + wid * QBLK, qm = qlo + r32 - 4 * hi;
    char* V_lds = lds; char* K_lds = lds + 2 * SHM_V;
    float* ws = (float*)(lds + 2 * SHM_V + 2 * SHM_K) + wid * 64; float* li_l = ws, * al_l = ws + 32;
    const float* cum = (const float*)(lds + CUM_OFF);
    float m_reg = -1e30f, l_reg = 0; f32x16 o[4] = {};
    const int sr = tid >> 4, sc = (tid & 15) * 8, vst0 = v_st(sr, sc), vst1 = v_st(32 + sr, sc), kws = KSWZ(sr, sc * 2);
    const int vb0 = (int)(uintptr_t)V_lds + v_rd_base(lane);
    const TIn* Kh = cur.K; const TIn* Vh = cur.V;
#define RESC(a) do { if (__any((a) < 1.f)) { if (hi == 0) al_l[r32] = (a); asm volatile("s_waitcnt lgkmcnt(0)" ::: "memory");              \
                     for (int d_ = 0; d_ < 4; ++d_) for (int r = 0; r < 16; ++r) o[d_][r] *= al_l[crow(r, hi)]; } } while (0)
#define KBASE(t) ((j_lo + (t)) * KVBLK)
#define CUMT(t) (cum + KBASE(t) + 4 * hi)
#define ACT(t) (KBASE(t) <= qlo + QBLK - 1 && KBASE(t) + KVBLK - 1 >= qlo - W + 1)
#define MASKT(P0_, P1_, t) do { const int kb_ = KBASE(t); if ((!SK || ACT(t)) && (kb_ + KVBLK - 1 > qlo || kb_ <= qlo + QBLK - 1 - W)) mask_tile(P0_, P1_, qm - kb_, (unsigned)W); } while (0)
    constexpr int NQL = F32 ? 16 : 8;
    constexpr bool SK = WSKIP && !F32;
#define SEAM_K0() do { VMWN(NQL); if constexpr (F32) { SWRITE_KF(0); SBAR(); SLOAD_F((const float*)nxt.V, kbn); } else { SWRITE_HK(0); } SBAR(); } while (0)
    f32x16 pA0, pA1, pB0, pB1; float mnA, mnB, alA, alB; bf16x8 pa0, pa1, pa2, pa3;
    if constexpr (F32) { VMW(); SWRITE_VF(0); SBAR(); } else { SWRITE_HV(0); SBAR(); }
    if (NT > 1) { if constexpr (F32) SLOAD_F((const float*)Kh, KBASE(1)); else SLOAD_H(Kh, Vh, KBASE(1)); }
    SBAR(); qkt<0, SK>(pA0, pA1, K_lds, r32, hi, S.qr, ACT(0), CUMT(0));
    if constexpr (F32) { if (NT > 1) { VMW(); SWRITE_KF(1); SBAR(); SLOAD_F((const float*)Vh, KBASE(1)); } }
    MASKT(pA0, pA1, 0); partialSM(pA0, pA1, m_reg, mnA, alA);
    if (NT > 1) { VMW(); if constexpr (F32) { SWRITE_VF(1); SBAR(); if (NT > 2) SLOAD_F((const float*)Kh, KBASE(2)); } else SWRITE_H(1); }
    __syncthreads();
#define HALF_STEP(PX0, PX1, mnX, alX, PY0, PY1, alY, t, KB, VB, SB) do {                                                      \
        SBAR(); qkt<KB, SK>(PX0, PX1, K_lds, r32, hi, S.qr, ACT(t), CUMT(t));                                             \
        finishSM(PY0, PY1, alY, l_reg, pa0, pa1, pa2, pa3); SBAR();                                                           \
        if ((t) + 1 < NT) { if constexpr (F32) { VMW(); SWRITE_KF(SB); SBAR(); SLOAD_F((const float*)Vh, KBASE((t) + 1)); }  \
                            else { SLOAD_H(Kh, Vh, KBASE((t) + 1)); } SBAR(); }                                               \
        pv_tile<VB, SK>(o, vb0, pa0, pa1, pa2, pa3, ACT((t) - 1)); MASKT(PX0, PX1, (t)); partialSM(PX0, PX1, m_reg, mnX, alX);                                        \
        __syncthreads();                                                                                                      \
        if ((t) + 1 < NT) { VMW(); if constexpr (F32) { SWRITE_VF(SB); SBAR(); if ((t) + 2 < NT) SLOAD_F((const float*)Kh, KBASE((t) + 2)); } \
                            else { SWRITE_H(SB); } }                                                                          \
        RESC(alX); __syncthreads(); } while (0)
    for (int t = 1; t + 1 < NT; t += 2) {
        HALF_STEP(pB0, pB1, mnB, alB, pA0, pA1, alA, t, 1, 0, 0);
        HALF_STEP(pA0, pA1, mnA, alA, pB0, pB1, alB, t + 1, 0, 1, 1);
    }
    const bool even = (NT & 1) == 0;
    if (even) { SBAR(); qkt<1, SK>(pB0, pB1, K_lds, r32, hi, S.qr, ACT(NT - 1), CUMT(NT - 1)); SBAR(); }
#define QROW(e) (nxt.Q + (size_t)(wid * QBLK + r32) * D + ((e) >> 1) * 16 + hi * 8 + ((e) & 1) * 4)
    if constexpr (F32) { SLOAD_F((const float*)nxt.K, kbn); SBAR();
#pragma unroll
        for (int e = 0; e < 8; ++e) S.tq[e] = *(const f32x4*)QROW(e); }
    else { SLOAD_H(nxt.K, nxt.V, kbn); SBAR();
#pragma unroll
        for (int d0 = 0; d0 < 8; ++d0) S.qr[d0] = load8<TIn>(nxt.Q + (size_t)(wid * QBLK + r32) * D + d0 * 16 + hi * 8); }
    SBAR();
    finishSM(pA0, pA1, alA, l_reg, pa0, pa1, pa2, pa3); SBAR();
    if constexpr (F32) {
#pragma unroll
        for (int e = 8; e < 16; ++e) S.tq[e] = *(const f32x4*)QROW(e); SBAR(); }
#undef QROW
    pv_tile<0, SK>(o, vb0, pa0, pa1, pa2, pa3, ACT(even ? NT - 2 : NT - 1));
    if (even) { MASKT(pB0, pB1, NT - 1); partialSM(pB0, pB1, m_reg, mnB, alB); __syncthreads(); RESC(alB);
        finishSM(pB0, pB1, alB, l_reg, pa0, pa1, pa2, pa3); SBAR(); pv_tile<1, SK>(o, vb0, pa0, pa1, pa2, pa3, ACT(NT - 1)); }
    SBAR(); SEAM_K0();
    if (hi == 0) li_l[r32] = l_reg; asm volatile("s_waitcnt lgkmcnt(0)" ::: "memory");
    float rli[16];
#pragma unroll
    for (int r = 0; r < 16; ++r) rli[r] = __builtin_amdgcn_rcpf(li_l[crow(r, hi)]);
    TOut* Ow = cur.O + (size_t)(wid * QBLK) * OST;
#pragma unroll
    for (int r = 0; r < 16; ++r) { const int orow = crow(r, hi);
#pragma unroll
        for (int d0 = 0; d0 < 4; ++d0) { const float v = o[d0][r] * rli[r];
            if constexpr (same_t<TOut, float>::v) { Ow[(size_t)orow * OST + d0 * 32 + r32] = v; }
            else { const float vn = __shfl_xor(v, 1);
                   if ((r32 & 1) == 0) *(unsigned*)(Ow + (size_t)orow * OST + d0 * 32 + r32) = cvtpk(v, vn); } } }
    if constexpr (F32) {
#pragma unroll
        for (int d0 = 0; d0 < 8; ++d0) S.qr[d0] = pack8(S.tq[2 * d0], S.tq[2 * d0 + 1]); }
    __syncthreads();
#undef RESC
#undef KBASE
#undef CUMT
#undef ACT
#undef MASKT
#undef SEAM_K0
#undef HALF_STEP
}
#undef ROW
#undef VMW
#undef VMWN
#undef SLOAD_H
#undef SWRITE_HK
#undef SWRITE_HV
#undef SWRITE_H
#undef SLOAD_F
#undef SWRITE_KF
#undef SWRITE_VF

constexpr int ATT_LDS = CUM_OFF + SKV * 4;
__device__ __forceinline__ int row_window(const float* a, int t, float bound) {
    const float thr = a[t] - bound * INV_SCALE;
    int lo = 0, hi = t + 1;
    while (lo < hi) { const int mid = (lo + hi) >> 1; if (a[mid] < thr) lo = mid + 1; else hi = mid; }
    return t - lo + 1;
}
__device__ __forceinline__ void attn_phase(char* lds, const bf16* FQ, const bf16* FK, const bf16* FV, const float* FLOGF, const float* qg, const float* kg, bf16* MERGED) {
    constexpr int NQB = SQ / QB, NX = NQB / 2, TOTAL = NX * H;
    if (blockIdx.x < TOTAL) { const int L = blockIdx.x;
        const int h = L / NX, x = L % NX, y = NQB - 1 - x;
        __syncthreads();
        float* cum = (float*)(lds + CUM_OFF);
        int W;
        { const int tid = opaque_tid(), lane = tid & 63;
          { const float* src = FLOGF + (size_t)h * SKV + tid * 16; float p[16]; float run = 0.f;
#pragma unroll
            for (int q = 0; q < 4; ++q) { const f32x4 v = *(const f32x4*)(src + 4 * q);
#pragma unroll
                for (int e = 0; e < 4; ++e) { run += v[e]; p[4 * q + e] = run; } }
            float inc = run;
#pragma unroll
            for (int o = 1; o < 64; o <<= 1) { const float u = __shfl_up(inc, o); if (lane >= o) inc += u; }
            float* wt = (float*)(lds + 2 * SHM_V + 2 * SHM_K);
            if (lane == 63) wt[tid >> 6] = inc;
            __syncthreads();
            float off = inc - run;
            for (int w8 = 0; w8 < (tid >> 6); ++w8) off += wt[w8];
#pragma unroll
            for (int q = 0; q < 4; ++q) *(f32x4*)(cum + tid * 16 + 4 * q) = (f32x4){(p[4 * q] + off) * (-INV_SCALE), (p[4 * q + 1] + off) * (-INV_SCALE), (p[4 * q + 2] + off) * (-INV_SCALE), (p[4 * q + 3] + off) * (-INV_SCALE)};
            __syncthreads(); }
          float gq = fmaxf(fabsf(qg[h * D + lane]), fabsf(qg[h * D + 64 + lane])), gk = fmaxf(fabsf(kg[h * D + lane]), fabsf(kg[h * D + 64 + lane]));
#pragma unroll
          for (int o = 1; o < 64; o <<= 1) { gq = fmaxf(gq, __shfl_xor(gq, o)); gk = fmaxf(gk, __shfl_xor(gk, o)); }
          const float bound = 2.f * INV_SCALE * gq * gk + 48.f;
          __syncthreads();
          int w = row_window(cum, ((tid >> 8) ? y : x) * QB + (tid & 255), bound);
#pragma unroll
          for (int o = 1; o < 64; o <<= 1) { const int w2 = __shfl_xor(w, o); w = w2 > w ? w2 : w; }
          int* wm = (int*)(lds + 2 * SHM_V + 2 * SHM_K);
          if (lane == 0) wm[tid >> 6] = w;
          __syncthreads();
          w = wm[0];
#pragma unroll
          for (int i = 1; i < 8; ++i) w = wm[i] > w ? wm[i] : w;
          w = (w + KVBLK - 1) & ~(KVBLK - 1); if (w > SKV) w = SKV;
          W = __builtin_amdgcn_readfirstlane(w);
          __syncthreads(); }
        BlockRef<bf16, bf16> b0, b1;
        const size_t hb = (size_t)h * SKV * D;
        b0.Q = FQ + hb + (size_t)x * QB * D; b0.K = FK + hb; b0.V = FV + hb; b0.O = MERGED + (size_t)x * QB * OST + h * D; b0.P0 = x * QB;
        b1.Q = FQ + hb + (size_t)y * QB * D; b1.K = FK + hb; b1.V = FV + hb; b1.O = MERGED + (size_t)y * QB * OST + h * D; b1.P0 = y * QB;
        Seam<bf16> S;
        causal_swa_prime<bf16, bf16>(b0, W, lds, S);
        BlockRef<bf16, bf16> cur = b0; int pass = 0;
        for (;;) { const bool last = pass == 1; const BlockRef<bf16, bf16> nxt = last ? cur : b1;
            causal_swa_block<bf16, bf16>(cur, nxt, SKV, W, lds, S);
            if (last) break; cur = nxt; pass = 1; }
    }
}
}
__device__ __forceinline__ void p_hgrn_seq(const bf16_t* HQ, const bf16_t* HK, const bf16_t* HV, const float* HLF, float* HO) {
    const int tid = opaque_tid(), lane = tid & 63, wave = tid >> 6;
    for (int it = blockIdx.x; it < NHEAD * 16; it += gridDim.x) {
        const int h = it >> 4, vc = (it & 15) * 8 + wave;
        const size_t hb = (size_t)h * T_ * HDIM;
        float Sa = 0.f, Sb = 0.f;
        for (int t0 = 0; t0 < T_; t0 += 8) {
            float fa[8], fb[8], ka[8], kb[8], qa[8], qb[8], vv[8];
#pragma unroll
            for (int i = 0; i < 8; ++i) { const size_t r = hb + (size_t)(t0 + i) * HDIM;
                fa[i] = HLF[r + lane]; fb[i] = HLF[r + lane + 64];
                ka[i] = bf2f(HK[r + lane]); kb[i] = bf2f(HK[r + lane + 64]);
                qa[i] = bf2f(HQ[r + lane]); qb[i] = bf2f(HQ[r + lane + 64]);
                vv[i] = bf2f(HV[r + vc]); }
            float p[8];
#pragma unroll
            for (int i = 0; i < 8; ++i) { Sa = expf(fa[i]) * Sa + ka[i] * vv[i]; Sb = expf(fb[i]) * Sb + kb[i] * vv[i]; p[i] = qa[i] * Sa + qb[i] * Sb; }
#pragma unroll
            for (int i = 0; i < 8; ++i) p[i] = wave_sum(p[i]);
            if (lane < 8) { float o = p[0];
#pragma unroll
                for (int i = 1; i < 8; ++i) o = (lane == i) ? p[i] : o;
                HO[hb + (size_t)(t0 + lane) * HDIM + vc] = o; }
        }
    }
}
__device__ __forceinline__ void p_hgrn_post(const float* HO, const bf16_t* HG, const float* og, bf16_t* MERGED) {
    const int tid = opaque_tid(), lane = tid & 63, wave = tid >> 6;
    for (int i = blockIdx.x * 8 + wave; i < T_ * NHEAD; i += gridDim.x * 8) {
        const int h = i / T_, t = i % T_, c = 2 * lane;
        const size_t r = ((size_t)h * T_ + t) * HDIM + c;
        const f32x2 o = *(const f32x2*)(HO + r);
        const float rs = rsqrtf(wave_sum(o[0] * o[0] + o[1] * o[1]) * (1.f / HDIM) + EPS_);
        const unsigned g = *(const unsigned*)(HG + r);
        const float g0 = bf2f(g & 0xffffu), g1 = bf2f(g >> 16);
        *(unsigned*)(MERGED + (size_t)t * DM + FOXW + h * HDIM + c) = pk2(o[0] * rs * og[h * HDIM + c] * g0, o[1] * rs * og[h * HDIM + c + 1] * g1);
    }
}
__device__ __forceinline__ void p_post2(unsigned char* lds, const float* x, const bf16_t* MIXG, const float* mod, const float* ada_b, const float* g2, bf16_t* X1B, bf16_t* H, unsigned char* H8, float* SH, int* HS) {
    float* A2 = (float*)lds; float* B2 = A2 + DM;
    const int tid = opaque_tid(), lane = tid & 63, wave = tid >> 6;
    for (int i = tid; i < DM; i += 512) { A2[i] = g2[i] * (1.f + mod[4 * DM + i] + ada_b[4 * DM + i]); B2[i] = mod[3 * DM + i] + ada_b[3 * DM + i]; }
    __syncthreads();
    for (int t = blockIdx.x * 8 + wave; t < T_; t += gridDim.x * 8) {
        const f32x4* xr = (const f32x4*)(x + (size_t)t * DM) + lane; const u32x2* mr = (const u32x2*)(MIXG + (size_t)t * DM) + lane;
        u32x2* orow = (u32x2*)(X1B + (size_t)t * DM) + lane;
        f32x4 v[16]; float ss = 0.f;
#pragma unroll
        for (int j = 0; j < 16; ++j) { const u32x2 m = mr[64 * j]; v[j] = xr[64 * j] + (f32x4){bf2f(m.x & 0xffffu), bf2f(m.x >> 16), bf2f(m.y & 0xffffu), bf2f(m.y >> 16)}; orow[64 * j] = (u32x2){pk2(v[j][0], v[j][1]), pk2(v[j][2], v[j][3])};
            ss += (v[j][0] * v[j][0] + v[j][1] * v[j][1]) + (v[j][2] * v[j][2] + v[j][3] * v[j][3]);
            if ((j & 3) == 3) asm volatile("" ::: "memory"); }
        const float rstd = rsqrtf(wave_sum(ss) * (1.f / DM) + EPS_);
        u32x2* o8 = (u32x2*)(H + (size_t)t * DM) + lane;
#pragma unroll
        for (int j = 0; j < 16; ++j) { const f32x4 a = *(const f32x4*)(A2 + 4 * lane + 256 * j), b = *(const f32x4*)(B2 + 4 * lane + 256 * j);
            const f32x4 hh = v[j] * rstd * a + b; u32x2 o = {pk2(hh[0], hh[1]), pk2(hh[2], hh[3])}; o8[64 * j] = o; v[j] = hh;
            if ((j & 3) == 3) asm volatile("" ::: "memory"); }
        float mx = 0.f;
#pragma unroll
        for (int j = 0; j < 16; ++j) mx = fmaxf(fmaxf(mx, fmaxf(fabsf(v[j][0]), fabsf(v[j][1]))), fmaxf(fabsf(v[j][2]), fabsf(v[j][3])));
#pragma unroll
        for (int o = 1; o < 64; o <<= 1) mx = fmaxf(mx, __shfl_xor(mx, o));
        const float sc = fmaxf(mx, 1e-30f) * (1.f / 119.f), inv = 1.f / sc;
        unsigned* h8 = (unsigned*)(H8 + (size_t)t * DM) + lane;
        int hs = 0;
#pragma unroll
        for (int j = 0; j < 16; ++j) { const int c0 = (int)rintf(v[j][0] * inv), c1 = (int)rintf(v[j][1] * inv), c2 = (int)rintf(v[j][2] * inv), c3 = (int)rintf(v[j][3] * inv);
            hs += (c0 + c1) + (c2 + c3);
            h8[64 * j] = (unsigned)(c0 & 0xff) | ((unsigned)(c1 & 0xff) << 8) | ((unsigned)(c2 & 0xff) << 16) | ((unsigned)(c3 & 0xff) << 24); }
#pragma unroll
        for (int o = 1; o < 64; o <<= 1) hs += __shfl_xor(hs, o);
        if (lane == 0) { SH[t] = sc; HS[t] = hs; }
    }
}
namespace hg {
typedef short bf16x8 __attribute__((ext_vector_type(8)));
constexpr int CH = 64, NG = 16;
__device__ __forceinline__ int grp_start(int g) { return g < 5 ? 9 * g : g < 11 ? 45 + 8 * (g - 5) : 93 + 7 * (g - 11); }
__device__ __forceinline__ int grp_count(int g) { return g < 5 ? 9 : g < 11 ? 8 : 7; }
constexpr int PA = 272, PB = 144;
constexpr int L_AQ = 0, L_BK = L_AQ + 64 * PA, L_KDT = L_BK + 64 * PA, L_VT = L_KDT + 128 * PB, L_P = L_VT + 128 * PB, L_ST = L_P + 64 * PB,
              L_SEG = L_ST + 128 * PA, L_BL = L_SEG + 8 * 128 * 4, L_END = L_BL + 512, L_OB = 0, POB = 528;
static_assert(64 * POB <= L_KDT && L_END <= 131072, "hgrn LDS map");
__device__ __forceinline__ bf16x8 frag(const unsigned char* base, int row, int pitch, int kk, int lane) { return *(const bf16x8*)(base + row * pitch + (kk * 32 + 8 * (lane >> 4)) * 2); }

struct ChunkRegs { float b0[8], b1[8]; unsigned kq[8], kk[8], kv[8]; };
template <bool FULL>
__device__ __forceinline__ void load_chunk(ChunkRegs& R, const bf16_t* HQ, const bf16_t* HK, const bf16_t* HV, const float* HLF, size_t base, int tid) {
    const int c0 = 2 * (tid & 63), g8 = tid >> 6;
    const size_t e0 = base + (size_t)(8 * g8) * HDIM + c0;
#pragma unroll
    for (int i = 0; i < 8; ++i) { const f32x2 l = *(const f32x2*)(HLF + e0 + i * HDIM); R.b0[i] = l[0]; R.b1[i] = l[1];
        R.kk[i] = *(const unsigned*)(HK + e0 + i * HDIM); R.kv[i] = *(const unsigned*)(HV + e0 + i * HDIM); if (FULL) R.kq[i] = *(const unsigned*)(HQ + e0 + i * HDIM); }
}
template <bool FULL>
__device__ __forceinline__ f32x2 stage_chunk(unsigned char* lds, ChunkRegs& R, int tid) {
    const int c0 = 2 * (tid & 63), g8 = tid >> 6;
    float (&b0)[8] = R.b0; float (&b1)[8] = R.b1; unsigned (&kq)[8] = R.kq; unsigned (&kk)[8] = R.kk; unsigned (&kv)[8] = R.kv;
#pragma unroll
    for (int i = 1; i < 8; ++i) { b0[i] += b0[i - 1]; b1[i] += b1[i - 1]; }
    float* seg = (float*)(lds + L_SEG);
    *(f32x2*)(seg + g8 * 128 + c0) = (f32x2){b0[7], b1[7]};
    __syncthreads();
    float off0 = 0.f, off1 = 0.f, tot0 = 0.f, tot1 = 0.f;
#pragma unroll
    for (int g = 0; g < 8; ++g) { const f32x2 s = *(const f32x2*)(seg + g * 128 + c0); if (g < g8) { off0 += s[0]; off1 += s[1]; } tot0 += s[0]; tot1 += s[1]; }
    if (g8 == 0) *(f32x2*)((float*)(lds + L_BL) + c0) = (f32x2){tot0, tot1};
    u32x4 kd0, kd1, vt0, vt1;
#pragma unroll
    for (int i = 0; i < 8; ++i) {
        const float ba = b0[i] + off0, bb = b1[i] + off1;
        const float k0 = bf2f(kk[i] & 0xffffu), k1 = bf2f(kk[i] >> 16);
        if (FULL) {
            const float ea = __expf(ba), eb = __expf(bb), ia = __expf(fminf(-ba, 80.f)), ib = __expf(fminf(-bb, 80.f));
            const int t = 8 * g8 + i;
            *(unsigned*)(lds + L_AQ + t * PA + c0 * 2) = pk2(bf2f(kq[i] & 0xffffu) * ea, bf2f(kq[i] >> 16) * eb);
            *(unsigned*)(lds + L_BK + t * PA + c0 * 2) = pk2(k0 * ia, k1 * ib);
        }
        const unsigned da = f2bf(k0 * __expf(tot0 - ba)), db = f2bf(k1 * __expf(tot1 - bb));
        const unsigned va = kv[i] & 0xffffu, vb = kv[i] >> 16;
        if (i & 1) { kd0[i >> 1] |= da << 16; kd1[i >> 1] |= db << 16; vt0[i >> 1] |= va << 16; vt1[i >> 1] |= vb << 16; }
        else { kd0[i >> 1] = da; kd1[i >> 1] = db; vt0[i >> 1] = va; vt1[i >> 1] = vb; }
    }
    *(u32x4*)(lds + L_KDT + c0 * PB + 16 * g8) = kd0; *(u32x4*)(lds + L_KDT + (c0 + 1) * PB + 16 * g8) = kd1;
    *(u32x4*)(lds + L_VT + c0 * PB + 16 * g8) = vt0; *(u32x4*)(lds + L_VT + (c0 + 1) * PB + 16 * g8) = vt1;
    return (f32x2){tot0, tot1};
}
__device__ __forceinline__ void state_update(const unsigned char* lds, f32x4 (&st)[8], int w, int lane) {
    const f32x4 bl = *(const f32x4*)((const float*)(lds + L_BL) + 16 * w + 4 * (lane >> 4));
    const f32x4 dec = {__expf(bl[0]), __expf(bl[1]), __expf(bl[2]), __expf(bl[3])};
    const bf16x8 a0 = frag(lds + L_KDT, 16 * w + (lane & 15), PB, 0, lane), a1 = frag(lds + L_KDT, 16 * w + (lane & 15), PB, 1, lane);
#pragma unroll
    for (int nv = 0; nv < 8; ++nv) {
        st[nv] = st[nv] * dec;
        st[nv] = __builtin_amdgcn_mfma_f32_16x16x32_bf16(a0, frag(lds + L_VT, 16 * nv + (lane & 15), PB, 0, lane), st[nv], 0, 0, 0);
        st[nv] = __builtin_amdgcn_mfma_f32_16x16x32_bf16(a1, frag(lds + L_VT, 16 * nv + (lane & 15), PB, 1, lane), st[nv], 0, 0, 0);
    }
}
__device__ __forceinline__ void pass_a(unsigned char* lds, const bf16_t* HK, const bf16_t* HV, const float* HLF, float* LST, float* BSUM) {
    const int tid = opaque_tid(), lane = tid & 63, w = __builtin_amdgcn_readfirstlane(tid >> 6);
    for (int it = blockIdx.x; it < NHEAD * (NG - 1); it += gridDim.x) {
        const int h = it / (NG - 1), g = it % (NG - 1);
        f32x4 st[8];
#pragma unroll
        for (int nv = 0; nv < 8; ++nv) st[nv] = (f32x4){0.f, 0.f, 0.f, 0.f};
        f32x2 bs = {0.f, 0.f};
        ChunkRegs R;
        const int c0g = grp_start(g), ncg = grp_count(g);
        load_chunk<false>(R, nullptr, HK, HV, HLF, ((size_t)h * T_ + (size_t)c0g * CH) * HDIM, tid);
        for (int ci = 0; ci < ncg; ++ci) {
            __syncthreads();
            bs += stage_chunk<false>(lds, R, tid);
            if (ci + 1 < ncg) load_chunk<false>(R, nullptr, HK, HV, HLF, ((size_t)h * T_ + (size_t)(c0g + ci + 1) * CH) * HDIM, tid);
            __syncthreads();
            state_update(lds, st, w, lane);
        }
        float* Lp = LST + ((size_t)(h * NG + g) * 128) * 128;
#pragma unroll
        for (int nv = 0; nv < 8; ++nv) *(f32x4*)(Lp + ((size_t)nv * 512 + w * 64 + lane) * 4) = st[nv];
        if (tid < 64) *(f32x2*)(BSUM + (size_t)(h * NG + g) * 128 + 2 * tid) = bs;
    }
}
__device__ __forceinline__ void pass_b(unsigned char* lds, const bf16_t* HQ, const bf16_t* HK, const bf16_t* HV, const bf16_t* HG, const float* HLF, const float* LST, const float* BSUM, const float* og, bf16_t* MERGED) {
    const int tid = opaque_tid(), lane = tid & 63, w = __builtin_amdgcn_readfirstlane(tid >> 6);
    for (int it = blockIdx.x; it < NHEAD * NG; it += gridDim.x) {
        const int h = it / NG, g = it % NG;
        f32x4 st[8];
#pragma unroll
        for (int nv = 0; nv < 8; ++nv) st[nv] = (f32x4){0.f, 0.f, 0.f, 0.f};
        for (int j = 0; j < g; ++j) {
            const float* Lp = LST + ((size_t)(h * NG + j) * 128) * 128;
            const f32x4 bl = *(const f32x4*)(BSUM + (size_t)(h * NG + j) * 128 + 16 * w + 4 * (lane >> 4));
            const f32x4 dec = {__expf(bl[0]), __expf(bl[1]), __expf(bl[2]), __expf(bl[3])};
#pragma unroll
            for (int nv = 0; nv < 8; ++nv) st[nv] = st[nv] * dec + *(const f32x4*)(Lp + ((size_t)nv * 512 + w * 64 + lane) * 4);
        }
        __syncthreads();
#pragma unroll
        for (int nv = 0; nv < 8; ++nv) *(u32x2*)(lds + L_ST + (16 * nv + (lane & 15)) * PA + (16 * w + 4 * (lane >> 4)) * 2) = (u32x2){pk2(st[nv][0], st[nv][1]), pk2(st[nv][2], st[nv][3])};
        ChunkRegs R;
        const int c0g = grp_start(g), ncg = grp_count(g);
        load_chunk<true>(R, HQ, HK, HV, HLF, ((size_t)h * T_ + (size_t)c0g * CH) * HDIM, tid);
        f32x4 gn4[4];
#pragma unroll
        for (int q = 0; q < 4; ++q) gn4[q] = *(const f32x4*)(og + h * HDIM + 16 * (tid & 7) + 4 * q);
        for (int ci = 0; ci < ncg; ++ci) {
            const int t0 = (c0g + ci) * CH;
            const size_t base = ((size_t)h * T_ + t0) * HDIM;
            stage_chunk<true>(lds, R, tid);
            if (ci + 1 < ncg) load_chunk<true>(R, HQ, HK, HV, HLF, base + (size_t)CH * HDIM, tid);
            const u32x4 ga = *(const u32x4*)(HG + base + (size_t)(tid >> 3) * HDIM + 16 * (tid & 7)), gb = *(const u32x4*)(HG + base + (size_t)(tid >> 3) * HDIM + 16 * (tid & 7) + 8);
            __syncthreads();
#pragma unroll
            for (int ii = 0; ii < 2; ++ii) { const int i = 2 * w + ii, ms = i >> 2, nt = i & 3;
                f32x4 acc = {0.f, 0.f, 0.f, 0.f};
                if (ms <= nt) {
#pragma unroll
                    for (int kk = 0; kk < 4; ++kk) acc = __builtin_amdgcn_mfma_f32_16x16x32_bf16(frag(lds + L_BK, 16 * ms + (lane & 15), PA, kk, lane), frag(lds + L_AQ, 16 * nt + (lane & 15), PA, kk, lane), acc, 0, 0, 0);
                }
                const int t = 16 * nt + (lane & 15), s0 = 16 * ms + 4 * (lane >> 4);
#pragma unroll
                for (int r = 0; r < 4; ++r) if (s0 + r > t) acc[r] = 0.f;
                *(u32x2*)(lds + L_P + t * PB + s0 * 2) = (u32x2){pk2(acc[0], acc[1]), pk2(acc[2], acc[3])};
            }
            __syncthreads();
            f32x4 o[4];
            { const int mt = w >> 1;
              const bf16x8 p0 = frag(lds + L_P, 16 * mt + (lane & 15), PB, 0, lane), p1 = frag(lds + L_P, 16 * mt + (lane & 15), PB, 1, lane);
              bf16x8 aq[4];
#pragma unroll
              for (int kk = 0; kk < 4; ++kk) aq[kk] = frag(lds + L_AQ, 16 * mt + (lane & 15), PA, kk, lane);
#pragma unroll
              for (int j = 0; j < 4; ++j) { const int nv = 4 * (w & 1) + j; f32x4 acc = {0.f, 0.f, 0.f, 0.f};
                  acc = __builtin_amdgcn_mfma_f32_16x16x32_bf16(p0, frag(lds + L_VT, 16 * nv + (lane & 15), PB, 0, lane), acc, 0, 0, 0);
                  acc = __builtin_amdgcn_mfma_f32_16x16x32_bf16(p1, frag(lds + L_VT, 16 * nv + (lane & 15), PB, 1, lane), acc, 0, 0, 0);
#pragma unroll
                  for (int kk = 0; kk < 4; ++kk) acc = __builtin_amdgcn_mfma_f32_16x16x32_bf16(aq[kk], frag(lds + L_ST, 16 * nv + (lane & 15), PA, kk, lane), acc, 0, 0, 0);
                  o[j] = acc; } }
            state_update(lds, st, w, lane);
            __syncthreads();
            { const int mt = w >> 1;
#pragma unroll
              for (int j = 0; j < 4; ++j)
#pragma unroll
                  for (int r = 0; r < 4; ++r) *(float*)(lds + L_OB + (16 * mt + 4 * (lane >> 4) + r) * POB + (16 * (4 * (w & 1) + j) + (lane & 15)) * 4) = o[j][r]; }
#pragma unroll
            for (int nv = 0; nv < 8; ++nv) *(u32x2*)(lds + L_ST + (16 * nv + (lane & 15)) * PA + (16 * w + 4 * (lane >> 4)) * 2) = (u32x2){pk2(st[nv][0], st[nv][1]), pk2(st[nv][2], st[nv][3])};
            __syncthreads();
            { const int t = tid >> 3, v0 = 16 * (tid & 7);
              f32x4 x[4]; float ss = 0.f;
#pragma unroll
              for (int q = 0; q < 4; ++q) { x[q] = *(const f32x4*)(lds + L_OB + t * POB + (v0 + 4 * q) * 4); ss += (x[q][0] * x[q][0] + x[q][1] * x[q][1]) + (x[q][2] * x[q][2] + x[q][3] * x[q][3]); }
              ss += __shfl_xor(ss, 1); ss += __shfl_xor(ss, 2); ss += __shfl_xor(ss, 4);
              const float rs = rsqrtf(ss * (1.f / HDIM) + EPS_);
              const unsigned gw[8] = {ga[0], ga[1], ga[2], ga[3], gb[0], gb[1], gb[2], gb[3]};
              unsigned ow[8];
#pragma unroll
              for (int q = 0; q < 4; ++q) { const f32x4 gn = gn4[q];
                  ow[2 * q] = pk2(x[q][0] * rs * gn[0] * bf2f(gw[2 * q] & 0xffffu), x[q][1] * rs * gn[1] * bf2f(gw[2 * q] >> 16));
                  ow[2 * q + 1] = pk2(x[q][2] * rs * gn[2] * bf2f(gw[2 * q + 1] & 0xffffu), x[q][3] * rs * gn[3] * bf2f(gw[2 * q + 1] >> 16)); }
              bf16_t* dst = MERGED + (size_t)(t0 + t) * DM + FOXW + h * HDIM + v0;
              *(u32x4*)dst = (u32x4){ow[0], ow[1], ow[2], ow[3]}; *(u32x4*)(dst + 8) = (u32x4){ow[4], ow[5], ow[6], ow[7]}; }
            __syncthreads();
        }
    }
}
}
__device__ __forceinline__ void p_scores(unsigned char* lds, const float* QP, const float* keys, float* SC) {
    float* Ks = (float*)lds;
    float* Qs = Ks + 128 * 132;
    const int tid = opaque_tid(), n = tid & 127, tq = tid >> 7;
    for (int it = blockIdx.x; it < 16 * (T_ / 64); it += gridDim.x) {
        const int hp = it % 16, t0 = (it / 16) * 64;
        __syncthreads();
        for (int i = tid; i < 128 * 32; i += 512) { const int r = i >> 5, c4 = i & 31; *(f32x4*)(Ks + r * 132 + 4 * c4) = *(const f32x4*)(keys + ((size_t)hp * 128 + r) * 128 + 4 * c4); }
        for (int i = tid; i < 64 * 32; i += 512) { const int r = i >> 5, c4 = i & 31; *(f32x4*)(Qs + r * 128 + 4 * c4) = *(const f32x4*)(QP + (size_t)(t0 + r) * PEER_QW + hp * 128 + 4 * c4); }
        __syncthreads();
        float acc[16];
#pragma unroll
        for (int j = 0; j < 16; ++j) acc[j] = 0.f;
        for (int d = 0; d < 128; d += 4) {
            const f32x4 kv = *(const f32x4*)(Ks + n * 132 + d);
#pragma unroll
            for (int j = 0; j < 16; ++j) { const f32x4 q = *(const f32x4*)(Qs + (tq * 16 + j) * 128 + d); acc[j] += (q[0] * kv[0] + q[1] * kv[1]) + (q[2] * kv[2] + q[3] * kv[3]); }
        }
#pragma unroll
        for (int j = 0; j < 16; ++j) SC[((size_t)(t0 + tq * 16 + j) * 16 + hp) * 128 + n] = acc[j];
    }
}
__device__ __forceinline__ unsigned fkey(float f) { const unsigned u = __builtin_bit_cast(unsigned, f); return (u & 0x80000000u) ? ~u : (u | 0x80000000u); }
__device__ __forceinline__ float fkey_inv(unsigned k) { const unsigned u = (k & 0x80000000u) ? (k & 0x7fffffffu) : ~k; return __builtin_bit_cast(float, u); }
__device__ __forceinline__ unsigned long long wave_max_u64(unsigned long long v) {
#pragma unroll
    for (int o = 1; o < 64; o <<= 1) { const unsigned lo = __shfl_xor((unsigned)v, o), hi = __shfl_xor((unsigned)(v >> 32), o); const unsigned long long w = ((unsigned long long)hi << 32) | lo; v = w > v ? w : v; }
    return v;
}
__device__ __forceinline__ void p_topk(const float* SC, int* PIDX, float* PGATE) {
    const int tid = opaque_tid(), lane = tid & 63, wave = tid >> 6;
    for (int i = blockIdx.x * 8 + wave; i < T_ * PEER_H; i += gridDim.x * 8) {
        const int t = i / PEER_H, h = i % PEER_H;
        float ts[2]; int ti[2];
#pragma unroll
        for (int p = 0; p < 2; ++p) {
            const float* s = SC + ((size_t)t * 16 + h * 2 + p) * 128;
            unsigned long long a = ((unsigned long long)fkey(s[lane]) << 32) | (unsigned)(127 - lane), b = ((unsigned long long)fkey(s[lane + 64]) << 32) | (unsigned)(127 - (lane + 64));
            float ms = 0.f; int mi = 0;
            for (int j = 0; j < 16; ++j) {
                const unsigned long long m = wave_max_u64(a > b ? a : b);
                if (a == m) a = 0ull; if (b == m) b = 0ull;
                if (lane == j) { ms = fkey_inv((unsigned)(m >> 32)); mi = 127 - (int)(m & 0xffffffffu); }
            }
            ts[p] = ms; ti[p] = mi;
        }
        unsigned long long cd[4];
#pragma unroll
        for (int c = 0; c < 4; ++c) { const int id = lane * 4 + c, ia = id >> 4, ib = id & 15;
            const float sa = __shfl(ts[0], ia), sb = __shfl(ts[1], ib); const int ea = __shfl(ti[0], ia), eb = __shfl(ti[1], ib);
            cd[c] = ((unsigned long long)fkey(sa + sb) << 32) | (unsigned)(0xffff - (ea * 128 + eb)); }
        float bs = 0.f; int be = 0;
        for (int j = 0; j < 16; ++j) {
            unsigned long long m = cd[0] > cd[1] ? cd[0] : cd[1]; const unsigned long long m2 = cd[2] > cd[3] ? cd[2] : cd[3]; m = m > m2 ? m : m2;
            m = wave_max_u64(m);
#pragma unroll
            for (int c = 0; c < 4; ++c) if (cd[c] == m) cd[c] = 0ull;
            if (lane == j) { bs = fkey_inv((unsigned)(m >> 32)); be = 0xffff - (int)(m & 0xffffffffu); }
        }
        const float mx = __shfl(bs, 0); float e = lane < 16 ? expf(bs - mx) : 0.f; const float den = wave_sum(e);
        if (lane < 16) { PIDX[(size_t)t * 128 + h * 16 + lane] = be; PGATE[(size_t)t * 128 + h * 16 + lane] = e / den; }
    }
}
__device__ __forceinline__ void p_expert_u(unsigned char* lds, const unsigned char* H8, const unsigned char* U4, const unsigned* PIDX, int* PD) {
    const int tid = opaque_tid(), lane = tid & 63, wave = tid >> 6, g = lane >> 4, n = lane & 15;
    const int xs = blockIdx.x & 7, tw = (blockIdx.x >> 3) * 8 + wave;
    int* eL = (int*)(lds + wave * 2048);
    const unsigned char* ub = U4 + (size_t)xs * PEER_NE * SLB + 16 * n;
    const unsigned char* hb = H8 + 512 * xs + 16 * n;
    unsigned ne = PIDX[(size_t)tw * 64 + lane];
    *(u32x2*)(eL + 2 * lane) = (u32x2){ne & 0xffffu, ne >> 16};
    ne = PIDX[(size_t)(tw + 256) * 64 + lane];
    u32x4 hlo_n = *(const u32x4*)(hb + (size_t)tw * DM), hhi_n = *(const u32x4*)(hb + (size_t)tw * DM + 256);
    u32x4 W[16]; int E[16];
#pragma unroll
    for (int s = 0; s < 16; ++s) { W[s] = *(const u32x4*)(ub + (size_t)eL[4 * s + g] * SLB); E[s] = eL[4 * (16 + s) + g]; }
#pragma unroll 1
    for (int k = 0; k < T_ / 256; ++k) {
        const int t = tw + 256 * k, cur = (k & 1) * 128, nxt = 128 - cur;
        *(u32x2*)(eL + nxt + 2 * lane) = (u32x2){ne & 0xffffu, ne >> 16};
        { const int t2 = tw + 256 * (k + 2 < T_ / 256 ? k + 2 : T_ / 256 - 1); ne = PIDX[(size_t)t2 * 64 + lane]; }
        u32x4 HA, HB;
#pragma unroll
        for (int c = 0; c < 4; ++c) {
            const unsigned l = hlo_n[c], h = hhi_n[c];
            HB[c] = (l & 0x0F0F0F0Fu) | ((h & 0x0F0F0F0Fu) << 4);
            HA[c] = ((((l >> 4) & 0x0F0F0F0Fu) + ((l >> 3) & 0x01010101u)) & 0x0F0F0F0Fu) | (((((h >> 4) & 0x0F0F0F0Fu) + ((h >> 3) & 0x01010101u)) & 0x0F0F0F0Fu) << 4);
        }
        { const int t1 = tw + 256 * (k + 1 < T_ / 256 ? k + 1 : T_ / 256 - 1); hlo_n = *(const u32x4*)(hb + (size_t)t1 * DM); hhi_n = *(const u32x4*)(hb + (size_t)t1 * DM + 256); }
        int* pd = PD + ((size_t)xs * T_ + t) * 128 + 4 * n + g;
#pragma unroll 1
        for (int hf = 0; hf < 2; ++hf) {
            int p[16];
#pragma unroll
            for (int i = 0; i < 16; ++i) {
                const u32x4 w = W[i]; int da = 0, db = 0;
#pragma unroll
                for (int c = 0; c < 4; ++c) { da = __builtin_amdgcn_sdot8((int)HA[c], (int)w[c], da, false); db = __builtin_amdgcn_sdot8((int)HB[c], (int)w[c], db, false); }
                p[i] = 16 * da + db;
                W[i] = *(const u32x4*)(ub + (size_t)E[i] * SLB);
                E[i] = eL[nxt + 4 * (16 * hf + i) + g];
            }
            int q8[8], q4[4], q2[2];
            { const bool hi = n & 8;
#pragma unroll
              for (int j = 0; j < 8; ++j) q8[j] = (hi ? p[j + 8] : p[j]) + __shfl_xor(hi ? p[j] : p[j + 8], 8); }
            { const bool hi = n & 4;
#pragma unroll
              for (int j = 0; j < 4; ++j) q4[j] = (hi ? q8[j + 4] : q8[j]) + __shfl_xor(hi ? q8[j] : q8[j + 4], 4); }
            { const bool hi = n & 2;
#pragma unroll
              for (int j = 0; j < 2; ++j) q2[j] = (hi ? q4[j + 2] : q4[j]) + __shfl_xor(hi ? q4[j] : q4[j + 2], 2); }
            { const bool hi = n & 1; pd[64 * hf] = (hi ? q2[1] : q2[0]) + __shfl_xor(hi ? q2[0] : q2[1], 1); }
        }
    }
}
__device__ __forceinline__ void p_expert_a(const float* SH, const int* HS, const float* SU, const float* SV, const unsigned short* PIDX, const float* PGATE, const int* PD, signed char* AQ, float* AF, int* AS) {
    const int tid = opaque_tid(), lane = tid & 63, wave = tid >> 6;
    for (int t = blockIdx.x * 8 + wave; t < T_; t += gridDim.x * 8) {
        const int hsum = HS[t]; const float sht = SH[t] * 0.5f;
        float av[2];
#pragma unroll
        for (int hh = 0; hh < 2; ++hh) {
            const int slot = lane + 64 * hh, e = PIDX[(size_t)t * 128 + slot];
            int ds = 0;
#pragma unroll
            for (int x = 0; x < 8; ++x) ds += PD[((size_t)x * T_ + t) * 128 + slot];
            const float d = (float)(2 * ds + hsum) * (SU[e] * sht);
            av[hh] = PGATE[(size_t)t * 128 + slot] * SV[e] * 0.5f * d * (1.f + erff(d * 0.70710678118654752f));
        }
        float amax = fmaxf(fabsf(av[0]), fabsf(av[1]));
#pragma unroll
        for (int o = 1; o < 64; o <<= 1) amax = fmaxf(amax, __shfl_xor(amax, o));
        amax = fmaxf(amax, 1e-37f);
        const float qsc = 127.f / amax;
        const int q0 = (int)rintf(av[0] * qsc), q1 = (int)rintf(av[1] * qsc);
        int qs = q0 + q1;
#pragma unroll
        for (int o = 1; o < 64; o <<= 1) qs += __shfl_xor(qs, o);
        AQ[(size_t)t * 128 + lane] = (signed char)q0; AQ[(size_t)t * 128 + 64 + lane] = (signed char)q1;
        if (lane == 0) { AF[t] = amax * (0.5f / 127.f); AS[t] = qs; }
    }
}
__device__ __forceinline__ void p_expert_v(unsigned char* lds, const unsigned char* V4, const unsigned* PIDX, const unsigned* AQ, const float* AF, const int* AS, const bf16_t* X1B, const float* mod, const float* ada_b, float* OUT) {
    const int tid = opaque_tid(), lane = tid & 63, wave = tid >> 6, g = lane >> 4, n = lane & 15;
    const int xs = blockIdx.x & 7, tw = (blockIdx.x >> 3) * 8 + wave;
    int* eL = (int*)(lds + wave * 2048);
    signed char* qL = (signed char*)(lds + wave * 2048 + 1024);
    const unsigned char* vb = V4 + (size_t)xs * PEER_NE * SLB + 16 * n;
    const int colb = 512 * xs + 16 * n + 4 * g;
    const f32x4 g2lo = *(const f32x4*)(mod + 5 * DM + colb) + *(const f32x4*)(ada_b + 5 * DM + colb), g2hi = *(const f32x4*)(mod + 5 * DM + colb + 256) + *(const f32x4*)(ada_b + 5 * DM + colb + 256);
    const int m0 = (n >> 2) == 0 ? -1 : 0, m1 = (n >> 2) == 1 ? -1 : 0, m2 = (n >> 2) == 2 ? -1 : 0, m3 = (n >> 2) == 3 ? -1 : 0;
    unsigned ne = PIDX[(size_t)tw * 64 + lane];
    *(u32x2*)(eL + 2 * lane) = (u32x2){ne & 0xffffu, ne >> 16};
    ne = PIDX[(size_t)(tw + 256) * 64 + lane];
    unsigned nq = AQ[(size_t)tw * 32 + (lane & 31)]; float nfa = AF[tw]; int nqs = AS[tw];
    u32x4 W[16]; int E[16];
#pragma unroll
    for (int s = 0; s < 16; ++s) { W[s] = *(const u32x4*)(vb + (size_t)eL[4 * s + g] * SLB); E[s] = eL[4 * (16 + s) + g]; }
#pragma unroll 1
    for (int k = 0; k < T_ / 256; ++k) {
        const int t = tw + 256 * k, cur = (k & 1) * 128, nxt = 128 - cur;
        *(u32x2*)(eL + nxt + 2 * lane) = (u32x2){ne & 0xffffu, ne >> 16};
        { const int t2 = tw + 256 * (k + 2 < T_ / 256 ? k + 2 : T_ / 256 - 1); ne = PIDX[(size_t)t2 * 64 + lane]; }
        if (lane < 32) ((unsigned*)qL)[lane] = nq;
        const float fa = nfa; const int qs = nqs;
        { const int t1 = tw + 256 * (k + 1 < T_ / 256 ? k + 1 : T_ / 256 - 1); nq = AQ[(size_t)t1 * 32 + (lane & 31)]; nfa = AF[t1]; nqs = AS[t1]; }
        f32x4* olo = (f32x4*)(OUT + (size_t)t * DM + colb); f32x4* ohi = (f32x4*)(OUT + (size_t)t * DM + colb + 256);
        const u32x2 blo = __builtin_nontemporal_load((const u32x2*)(X1B + (size_t)t * DM + colb)), bhi = __builtin_nontemporal_load((const u32x2*)(X1B + (size_t)t * DM + colb + 256));
        pg8::i32x4 acc[4];
#pragma unroll
        for (int i = 0; i < 4; ++i) acc[i] = (pg8::i32x4){0, 0, 0, 0};
#pragma unroll 1
        for (int it = 0; it < 2; ++it) {
            unsigned qa[16];
#pragma unroll
            for (int s = 0; s < 16; ++s) qa[s] = ((unsigned)(int)qL[4 * (16 * it + s) + g] & 0xffu) << (8 * (n & 3));
#pragma unroll
            for (int s = 0; s < 16; ++s) {
                const int i = 16 * it + s; const u32x4 w = W[s];
                const pg8::i32x4 A_ = {(int)qa[s] & m0, (int)qa[s] & m1, (int)qa[s] & m2, (int)qa[s] & m3};
                const u32x4 hi_ = w & 0xF0F0F0F0u;
                acc[2 * (s & 1)] = __builtin_amdgcn_mfma_i32_16x16x64_i8(A_, __builtin_bit_cast(pg8::i32x4, w), acc[2 * (s & 1)], 0, 0, 0);
                acc[2 * (s & 1) + 1] = __builtin_amdgcn_mfma_i32_16x16x64_i8(A_, __builtin_bit_cast(pg8::i32x4, hi_), acc[2 * (s & 1) + 1], 0, 0, 0);
                W[s] = *(const u32x4*)(vb + (size_t)E[s] * SLB);
                E[s] = eL[nxt + 4 * i + g];
            }
        }
        const pg8::i32x4 sh16 = acc[1] + acc[3], slo = acc[0] + acc[2] - sh16;
        const f32x4 xlo = {bf2f(blo.x & 0xffffu), bf2f(blo.x >> 16), bf2f(blo.y & 0xffffu), bf2f(blo.y >> 16)}, xhi = {bf2f(bhi.x & 0xffffu), bf2f(bhi.x >> 16), bf2f(bhi.y & 0xffffu), bf2f(bhi.y >> 16)};
        __builtin_nontemporal_store(xlo + g2lo * (f32x4){fa * (float)(2 * slo[0] - 15 * qs), fa * (float)(2 * slo[1] - 15 * qs), fa * (float)(2 * slo[2] - 15 * qs), fa * (float)(2 * slo[3] - 15 * qs)}, olo);
        __builtin_nontemporal_store(xhi + g2hi * (f32x4){fa * (float)((sh16[0] >> 3) + qs), fa * (float)((sh16[1] >> 3) + qs), fa * (float)((sh16[2] >> 3) + qs), fa * (float)((sh16[3] >> 3) + qs)}, ohi);
    }
}
namespace route {
typedef short bf16x8 __attribute__((ext_vector_type(8)));
constexpr int PK_ = 272, PQ_ = 528, PS_ = 1056;
constexpr int L_KB = 0, L_QT = L_KB + 2 * 128 * PK_, L_SC = L_QT + 32 * PQ_, L_WL = L_SC + 32 * PS_, L_END = L_WL + 8 * 1024;
static_assert(L_END <= 131072, "route LDS map");
__device__ __forceinline__ unsigned fkey(float f) { const unsigned u = __builtin_bit_cast(unsigned, f); return (u & 0x80000000u) ? ~u : (u | 0x80000000u); }
__device__ __forceinline__ float fkey_inv(unsigned k) { const unsigned u = (k & 0x80000000u) ? (k & 0x7fffffffu) : ~k; return __builtin_bit_cast(float, u); }
#define ROW_DPP(x_, ctrl_, bc_) __builtin_amdgcn_update_dpp(0, (x_), (ctrl_), 0xf, 0xf, (bc_))
__device__ __forceinline__ int row_sum(int c) {
    c += ROW_DPP(c, 0x128, false); c += ROW_DPP(c, 0x124, false); c += ROW_DPP(c, 0x122, false); c += ROW_DPP(c, 0x121, false); return c; }
__device__ __forceinline__ float row_sumf(float c) {
    c += __builtin_bit_cast(float, ROW_DPP(__builtin_bit_cast(int, c), 0x128, false)); c += __builtin_bit_cast(float, ROW_DPP(__builtin_bit_cast(int, c), 0x124, false));
    c += __builtin_bit_cast(float, ROW_DPP(__builtin_bit_cast(int, c), 0x122, false)); c += __builtin_bit_cast(float, ROW_DPP(__builtin_bit_cast(int, c), 0x121, false));
    return c; }
__device__ __forceinline__ int row_scan(int c) {
    c += ROW_DPP(c, 0x111, true); c += ROW_DPP(c, 0x112, true); c += ROW_DPP(c, 0x114, true); c += ROW_DPP(c, 0x118, true); return c; }
__device__ __forceinline__ unsigned row_maxu(unsigned c) { unsigned o;
    o = (unsigned)ROW_DPP((int)c, 0x128, false); c = o > c ? o : c; o = (unsigned)ROW_DPP((int)c, 0x124, false); c = o > c ? o : c;
    o = (unsigned)ROW_DPP((int)c, 0x122, false); c = o > c ? o : c; o = (unsigned)ROW_DPP((int)c, 0x121, false); c = o > c ? o : c; return c; }
__device__ __forceinline__ unsigned row_minu(unsigned c) { unsigned o;
    o = (unsigned)ROW_DPP((int)c, 0x128, false); c = o < c ? o : c; o = (unsigned)ROW_DPP((int)c, 0x124, false); c = o < c ? o : c;
    o = (unsigned)ROW_DPP((int)c, 0x122, false); c = o < c ? o : c; o = (unsigned)ROW_DPP((int)c, 0x121, false); c = o < c ? o : c; return c; }
template <int NV> __device__ __forceinline__ unsigned select16_row(unsigned (&key)[NV], unsigned& base) {
    unsigned lm = key[0];
#pragma unroll
    for (int v = 1; v < NV; ++v) lm = key[v] > lm ? key[v] : lm;
    const unsigned hi = row_maxu(lm), lo = row_minu(lm), b1 = (lo ? lo : 1u) - 1u, range = hi - b1;
    base = b1;
#pragma unroll
    for (int v = 0; v < NV; ++v) key[v] = (key[v] > b1 ? key[v] : b1) - b1;
    const int hb = 31 - __builtin_clz(range);
    unsigned prefix = 0u; bool done = false;
    int start = __builtin_amdgcn_readlane(hb, 0);
    { const int s1 = __builtin_amdgcn_readlane(hb, 16), s2 = __builtin_amdgcn_readlane(hb, 32), s3 = __builtin_amdgcn_readlane(hb, 48);
      start = s1 > start ? s1 : start; start = s2 > start ? s2 : start; start = s3 > start ? s3 : start; }
    for (int bit = start; bit >= 0; --bit) {
        const unsigned cand = prefix | (1u << bit); int c = 0;
#pragma unroll
        for (int v = 0; v < NV; ++v) c += (key[v] >= cand) ? 1 : 0;
        c = row_sum(c);
        const bool take = !done && c >= 16;
        prefix = take ? cand : prefix;
        done = done || (take && c == 16);
        if ((bit & 1) == 0 && __ballot(!done) == 0ull) break;
    }
    return prefix;
}
__device__ __forceinline__ void route_phase(unsigned char* lds, const bf16_t* QPB, const float* keys, unsigned short* PIDX, float* PGATE) {
    const int tid = opaque_tid(), lane = tid & 63, w = __builtin_amdgcn_readfirstlane(tid >> 6);
    const int h = blockIdx.x & 7;
    __syncthreads();
    for (int i = tid; i < 2 * 128 * 32; i += 512) { const int r = i >> 5, c4 = i & 31;
        const f32x4 k4 = *(const f32x4*)(keys + ((size_t)h * 256 + r) * 128 + 4 * c4);
        *(u32x2*)(lds + L_KB + r * PK_ + c4 * 8) = (u32x2){pk2(k4[0], k4[1]), pk2(k4[2], k4[3])}; }
    for (int tile = (blockIdx.x >> 3); tile < T_ / 32; tile += (gridDim.x >> 3)) {
        const int t0 = tile * 32;
        __syncthreads();
        { const int r = tid >> 4, c = tid & 15;
          const u32x4* src = (const u32x4*)(QPB + (size_t)(t0 + r) * PEER_QW + h * 256 + 16 * c);
          const u32x4 a = src[0], b = src[1];
          *(u32x4*)(lds + L_QT + r * PQ_ + c * 32) = a; *(u32x4*)(lds + L_QT + r * PQ_ + c * 32 + 16) = b; }
        __syncthreads();
#pragma unroll
        for (int p = 0; p < 2; ++p) {
            bf16x8 kb[4];
#pragma unroll
            for (int kk = 0; kk < 4; ++kk) kb[kk] = *(const bf16x8*)(lds + L_KB + (p * 128 + 16 * w + (lane & 15)) * PK_ + (kk * 32 + 8 * (lane >> 4)) * 2);
#pragma unroll
            for (int mt = 0; mt < 2; ++mt) { f32x4 acc = {0.f, 0.f, 0.f, 0.f};
#pragma unroll
                for (int kk = 0; kk < 4; ++kk) acc = __builtin_amdgcn_mfma_f32_16x16x32_bf16(*(const bf16x8*)(lds + L_QT + (16 * mt + (lane & 15)) * PQ_ + (p * 128 + kk * 32 + 8 * (lane >> 4)) * 2), kb[kk], acc, 0, 0, 0);
#pragma unroll
                for (int r = 0; r < 4; ++r) *(float*)(lds + L_SC + (16 * mt + 4 * (lane >> 4) + r) * PS_ + (p * 132 + 16 * w + (lane & 15)) * 4) = acc[r]; }
        }
        __syncthreads();
        unsigned char* wl = lds + L_WL + w * 1024 + (lane >> 4) * 256;
        const int li = lane & 15, t = t0 + 4 * w + (lane >> 4);
#pragma unroll
        for (int p = 0; p < 2; ++p) {
            const float* s = (const float*)(lds + L_SC + (4 * w + (lane >> 4)) * PS_ + p * 132 * 4);
            float sv[8]; unsigned key[8];
#pragma unroll
            for (int v = 0; v < 8; ++v) { sv[v] = s[li + 16 * v]; key[v] = fkey(sv[v]); }
            unsigned base_; const unsigned thr = select16_row<8>(key, base_); (void)base_;
            int cl = 0;
#pragma unroll
            for (int v = 0; v < 8; ++v) cl += (key[v] >= thr) ? 1 : 0;
            int pos = row_scan(cl) - cl;
#pragma unroll
            for (int v = 0; v < 8; ++v) if (key[v] >= thr) { if (pos < 16) *(u32x2*)(wl + p * 128 + pos * 8) = (u32x2){__builtin_bit_cast(unsigned, sv[v]), (unsigned)(li + 16 * v)}; ++pos; }
        }
        asm volatile("s_waitcnt lgkmcnt(0)" ::: "memory");
        {
            const u32x2 wa = *(const u32x2*)(wl + li * 8);
            float cs[16]; unsigned ck[16]; int ce[16];
#pragma unroll
            for (int v = 0; v < 16; ++v) { const u32x2 wb = *(const u32x2*)(wl + 128 + v * 8);
                cs[v] = __builtin_bit_cast(float, wa.x) + __builtin_bit_cast(float, wb.x); ck[v] = fkey(cs[v]); ce[v] = (int)(wa.y * 128u + wb.y); }
            unsigned base_; const unsigned thr = select16_row<16>(ck, base_);
            const unsigned thr0 = thr + base_;
            const float tf = (thr0 >= 0x00800000u && thr0 <= 0xFF7FFFFFu) ? fkey_inv(thr0) : 0.f;
            int cl = 0;
#pragma unroll
            for (int v = 0; v < 16; ++v) cl += (ck[v] >= thr) ? 1 : 0;
            int pos = row_scan(cl) - cl;
            float e[16]; int ps[16]; float es = 0.f;
#pragma unroll
            for (int v = 0; v < 16; ++v) { const bool in = ck[v] >= thr && pos < 16; e[v] = in ? __expf(cs[v] - tf) : 0.f; ps[v] = in ? pos : -1; if (ck[v] >= thr) ++pos; es += e[v]; }
            es = row_sumf(es);
            const float inv = 1.f / es;
#pragma unroll
            for (int v = 0; v < 16; ++v) if (ps[v] >= 0) { PIDX[(size_t)t * 128 + h * 16 + ps[v]] = (unsigned short)ce[v]; PGATE[(size_t)t * 128 + h * 16 + ps[v]] = e[v] * inv; }
        }
        asm volatile("s_waitcnt lgkmcnt(0)" ::: "memory");
    }
}
}
constexpr int LDS_SCRATCH = 147456, LDS_BYTES = LDS_SCRATCH + 256 + 8192;
struct Params { const float* in[17]; float* out; unsigned char* ws; };
__global__ void __launch_bounds__(512, 2) mega_fwd(Params P) {
    extern __shared__ __attribute__((aligned(16))) unsigned char lds[];
    volatile LAS unsigned* MISC = (volatile LAS unsigned*)((LAS unsigned char*)lds + LDS_SCRATCH);
    if (threadIdx.x < 64) MISC[threadIdx.x] = 0u;
    __syncthreads();
    typedef const __attribute__((address_space(4))) Params* KArgs;
#define KA() ({ KArgs _p = (KArgs)__builtin_amdgcn_kernarg_segment_ptr(); asm volatile("" : "+s"(_p)); _p; })
#define WSP(off) (KA()->ws + (off))
    XcdBarrier bar = xcd_barrier_post((unsigned*)WSP(WS_CTL), MISC + 8);
    p_convert(lds, KA()->in[6], KA()->in[12], KA()->in[13], nullptr, (bf16_t*)WSP(WS_WOUTT), (bf16_t*)WSP(WS_WQT), (float*)WSP(WS_WFT));
    __syncthreads();
    p_adaln(lds, KA()->in[1], KA()->in[2], (float*)WSP(CTL_MOD));
    p_colmax<DM>(KA()->in[12], (float*)WSP(WS_WOUTT + 17 * MiB));
    p_colmax<NIN>(KA()->in[6], (float*)WSP(WS_WINT + 64 * MiB));
    xcd_barrier(bar);
    p_quant_w<NIN, NPROJ, true>(lds, KA()->in[6], (float*)WSP(WS_WINT + 64 * MiB), WSP(WS_WINT), (float*)WSP(WS_WINT + 60 * MiB));
    __syncthreads();
    p_quant_w<DM, DM, false>(lds, KA()->in[12], (float*)WSP(WS_WOUTT + 17 * MiB), WSP(WS_WOUTT), (float*)WSP(WS_WOUTT + 16 * MiB));
    __syncthreads();
    p_norm1(lds, KA()->in[0], (float*)WSP(CTL_MOD), KA()->in[3], KA()->in[4], (float*)WSP(WS_WFT), KA()->in[7], WSP(WS_H), (float*)WSP(WS_WFT + 512 * 1024), (float*)WSP(WS_FLOGF));
    xcd_barrier(bar);
    { pg8::Gemm g{(bf16_t*)WSP(WS_H), (bf16_t*)WSP(WS_WINT), T_, NPROJ, DM / 2}; pg8::StaticOrder S; S.init(T_, NPROJ, (int)gridDim.x, (int)blockIdx.x);
      pg8::EpiInProjT<true> E{(bf16_t*)WSP(WS_FQ), (bf16_t*)WSP(WS_FK), (bf16_t*)WSP(WS_FV), (bf16_t*)WSP(WS_HQ), (bf16_t*)WSP(WS_HK), (bf16_t*)WSP(WS_HV), (bf16_t*)WSP(WS_HG), (float*)WSP(WS_HLF), KA()->in[8], KA()->in[9], KA()->in[10],
                              (float*)WSP(WS_WFT + 512 * 1024), (float*)WSP(WS_WINT + 60 * MiB), (PG8_LAS float*)((LAS unsigned char*)lds + LDS_SCRATCH + 256)};
      pg8::gemm_phase<pg8::EpiInProjT<true>, pg8::StaticOrder, false>((PG8_LAS unsigned char*)lds, g, S, E, nullptr); }
    xcd_barrier(bar);
    fox::attn_phase((char*)lds, (const fox::bf16*)(bf16_t*)WSP(WS_FQ), (const fox::bf16*)(bf16_t*)WSP(WS_FK), (const fox::bf16*)(bf16_t*)WSP(WS_FV), (float*)WSP(WS_FLOGF), KA()->in[8], KA()->in[9], (fox::bf16*)(bf16_t*)WSP(WS_MERGED));
    __syncthreads();
    hg::pass_a(lds, (bf16_t*)WSP(WS_HK), (bf16_t*)WSP(WS_HV), (float*)WSP(WS_HLF), (float*)WSP(WS_HO), (float*)WSP(WS_HO + 32 * MiB));
    __syncthreads();
    p_convert_uv4(lds, (unsigned*)WSP(WS_CTL + 32768), KA()->in[15], KA()->in[16], WSP(WS_UBF), (float*)WSP(WS_UBF + 64 * MiB), WSP(WS_VBF), (float*)WSP(WS_VBF + 64 * MiB));
    xcd_barrier(bar);
    hg::pass_b(lds, (bf16_t*)WSP(WS_HQ), (bf16_t*)WSP(WS_HK), (bf16_t*)WSP(WS_HV), (bf16_t*)WSP(WS_HG), (float*)WSP(WS_HLF), (float*)WSP(WS_HO), (float*)WSP(WS_HO + 32 * MiB), KA()->in[11], (bf16_t*)WSP(WS_MERGED));
    xcd_barrier(bar);
    p_quant_merged((bf16_t*)WSP(WS_MERGED), WSP(WS_FQ), (float*)WSP(WS_FK));
    xcd_barrier(bar);
    { pg8::Gemm g{(bf16_t*)WSP(WS_FQ), (bf16_t*)WSP(WS_WOUTT), T_, DM, DM / 2}; pg8::StaticOrder S; S.init(T_, DM, (int)gridDim.x, (int)blockIdx.x);
      pg8::EpiMixBf16T<true> E{(bf16_t*)WSP(WS_PROJ), (float*)WSP(CTL_MOD), KA()->in[3], (float*)WSP(WS_FK), (float*)WSP(WS_WOUTT + 16 * MiB)};
      pg8::gemm_phase<pg8::EpiMixBf16T<true>, pg8::StaticOrder, false>((PG8_LAS unsigned char*)lds, g, S, E, nullptr); }
    xcd_barrier(bar);
    p_post2(lds, KA()->in[0], (bf16_t*)WSP(WS_PROJ), (float*)WSP(CTL_MOD), KA()->in[3], KA()->in[5], (bf16_t*)WSP(WS_MERGED), (bf16_t*)WSP(WS_H), WSP(WS_PROJ + 256 * MiB), (float*)WSP(WS_PROJ + 320 * MiB), (int*)WSP(WS_PROJ + 320 * MiB + 65536));
    xcd_barrier(bar);
    { pg8::Gemm g{(bf16_t*)WSP(WS_H), (bf16_t*)WSP(WS_WQT), T_, PEER_QW, DM}; pg8::StaticOrder S; S.init(T_, PEER_QW, (int)gridDim.x, (int)blockIdx.x); pg8::EpiBf16<0> E{(bf16_t*)WSP(WS_QP), PEER_QW, nullptr, 0, 0};
      pg8::gemm_phase<pg8::EpiBf16<0>, pg8::StaticOrder, false>((PG8_LAS unsigned char*)lds, g, S, E, nullptr); }
    xcd_barrier(bar);
    route::route_phase(lds, (bf16_t*)WSP(WS_QP), KA()->in[14], (unsigned short*)WSP(WS_PIDX), (float*)WSP(WS_PGATE));
    xcd_barrier(bar);
    p_expert_u(lds, WSP(WS_PROJ + 256 * MiB), WSP(WS_UBF), (unsigned*)WSP(WS_PIDX), (int*)WSP(WS_FQ));
    xcd_barrier(bar);
    p_expert_a((float*)WSP(WS_PROJ + 320 * MiB), (int*)WSP(WS_PROJ + 320 * MiB + 65536), (float*)WSP(WS_UBF + 64 * MiB), (float*)WSP(WS_VBF + 64 * MiB), (unsigned short*)WSP(WS_PIDX), (float*)WSP(WS_PGATE), (int*)WSP(WS_FQ),
               (signed char*)WSP(WS_FK), (float*)WSP(WS_FK + 2 * MiB), (int*)WSP(WS_FK + 3 * MiB));
    xcd_barrier(bar);
    p_expert_v(lds, WSP(WS_VBF), (unsigned*)WSP(WS_PIDX), (unsigned*)WSP(WS_FK), (float*)WSP(WS_FK + 2 * MiB), (int*)WSP(WS_FK + 3 * MiB), (bf16_t*)WSP(WS_MERGED), (float*)WSP(CTL_MOD), KA()->in[3], KA()->out);
}

extern "C" void kernel_launch(void* const* d_in, const int* in_sizes, int n_in, void* d_out, int out_size, void* d_ws, size_t ws_size, hipStream_t stream) {
    static int grid = 0;
    if (!grid) {
        if (n_in != 17 || in_sizes[0] != T_ * DM || out_size != T_ * DM || ws_size < WS_END) { fprintf(stderr, "kernel_launch: unexpected shapes (n_in %d, in0 %d, out %d, ws %zu < %zu)\n", n_in, n_in > 0 ? in_sizes[0] : -1, out_size, ws_size, (size_t)WS_END); grid = -1; return; }
        int dev = 0, cus = 0, per_cu = 0; (void)hipGetDevice(&dev); (void)hipDeviceGetAttribute(&cus, hipDeviceAttributeMultiprocessorCount, dev);
        if (hipFuncSetAttribute((const void*)mega_fwd, hipFuncAttributeMaxDynamicSharedMemorySize, LDS_BYTES) != hipSuccess) { fprintf(stderr, "kernel_launch: hipFuncSetAttribute failed\n"); grid = -1; return; }
        (void)hipOccupancyMaxActiveBlocksPerMultiprocessor(&per_cu, mega_fwd, 512, LDS_BYTES);
        if (cus != 256 || per_cu < 1) { fprintf(stderr, "kernel_launch: built for 256 CUs with one resident workgroup each (got %d CUs, %d per CU)\n", cus, per_cu); grid = -1; return; }
        grid = cus;
    }
    if (grid < 0) return;
    Params P{};
    for (int i = 0; i < 17; ++i) P.in[i] = (const float*)d_in[i];
    P.out = (float*)d_out; P.ws = (unsigned char*)d_ws;
    (void)hipMemsetAsync((unsigned char*)d_ws + WS_CTL, 0, CTL_ZERO_BYTES, stream);
    hipLaunchKernelGGL(mega_fwd, dim3(grid), dim3(512), LDS_BYTES, stream, P);
}
```

```cpp
#include <hip/hip_runtime.h>
#include <hip/hip_bf16.h>
#include <cstdio>
#include <cstdint>
#include <type_traits>

constexpr int T_ = 8192, DM = 4096, NIN = 14352, NPROJ = 14336, FOXW = 2048, HGW = 2048, NHEAD = 16, HDIM = 128;
constexpr int PEER_H = 8, PEER_K = 128, PEER_TOP = 16, PEER_QW = 2048, PEER_NE = 16384;
constexpr float EPS_ = 1e-6f;

constexpr size_t MiB = 1u << 20;
constexpr size_t WS_CTL = 0, CTL_ZERO_BYTES = 256 * 1024;
constexpr size_t CTL_CMAX = 163840;
constexpr size_t CTL_MOD = 65536;
constexpr size_t WS_WINT = 2 * MiB;
constexpr size_t WS_WOUTT = WS_WINT + 112 * MiB;
constexpr size_t WS_WQT = WS_WOUTT + 32 * MiB;
constexpr size_t WS_WFT = WS_WQT + 16 * MiB;
constexpr size_t WS_UBF = WS_WFT + 1 * MiB;
constexpr size_t WS_VBF = WS_UBF + 128 * MiB;
constexpr size_t WS_H = WS_VBF + 128 * MiB;
constexpr size_t WS_FLOGF = WS_H + 64 * MiB;
constexpr size_t WS_FCUM = WS_FLOGF + 512 * 1024;
constexpr size_t WS_FQ = WS_FLOGF + 1 * MiB;
constexpr size_t WS_FK = WS_FQ + 32 * MiB;
constexpr size_t WS_FV = WS_FK + 32 * MiB;
constexpr size_t WS_HQ = WS_FV + 32 * MiB;
constexpr size_t WS_HK = WS_HQ + 32 * MiB;
constexpr size_t WS_HV = WS_HK + 32 * MiB;
constexpr size_t WS_HG = WS_HV + 32 * MiB;
constexpr size_t WS_HLF = WS_HG + 32 * MiB;
constexpr size_t WS_HO = WS_HLF + 64 * MiB;
constexpr size_t WS_MERGED = WS_HO + 64 * MiB;
constexpr size_t WS_QP = WS_MERGED + 64 * MiB;
constexpr size_t WS_SC = WS_QP + 64 * MiB;
constexpr size_t WS_PIDX = WS_SC + 64 * MiB;
constexpr size_t WS_PGATE = WS_PIDX + 4 * MiB;
constexpr size_t WS_PROJ = WS_PGATE + 4 * MiB;
constexpr size_t WS_PMOD = WS_WINT + 72 * MiB;
constexpr size_t WS_END = WS_PROJ + 448 * MiB;

typedef unsigned short bf16_t;
typedef float f32x4 __attribute__((ext_vector_type(4)));
typedef float f32x2 __attribute__((ext_vector_type(2)));
typedef unsigned u32x4 __attribute__((ext_vector_type(4)));
typedef unsigned u32x2 __attribute__((ext_vector_type(2)));
#define LAS __attribute__((address_space(3)))

__device__ __forceinline__ unsigned f2bf(float f) { unsigned u = __builtin_bit_cast(unsigned, f); return (u + 0x7fffu + ((u >> 16) & 1u)) >> 16; }
__device__ __forceinline__ unsigned pk2(float lo, float hi) { return f2bf(lo) | (f2bf(hi) << 16); }
__device__ __forceinline__ float bf2f(unsigned b) { return __builtin_bit_cast(float, b << 16); }
__device__ __forceinline__ float wave_sum(float v) {
#pragma unroll
    for (int o = 1; o < 64; o <<= 1) v += __shfl_xor(v, o);
    return v;
}
__device__ __forceinline__ float silu_f(float x) { return x / (1.f + __expf(-x)); }
__device__ __forceinline__ float sigmoid_f(float x) { return 1.f / (1.f + __expf(-x)); }
__device__ __forceinline__ int opaque_tid() { int t = threadIdx.x; asm volatile("" : "+v"(t)); return t; }
#define XB_TMO      128
#define XB_XCNT(j)  (256  + 64 * (j))
#define XB_XSUB(j)  (1280 + 64 * (j))
#define XB_XGEN(j)  (2304 + 64 * (j))
#define XB_TOP      3328
#define XB_TOPGEN   3392
#define XCD_BAR_WORDS 3456
#define XB_SPIN_CAP (1u << 18)

__device__ __forceinline__ unsigned xb_ld(unsigned* p)              { return __hip_atomic_load(p, __ATOMIC_RELAXED, __HIP_MEMORY_SCOPE_AGENT); }
__device__ __forceinline__ unsigned xb_add(unsigned* p, unsigned v) { return __hip_atomic_fetch_add(p, v, __ATOMIC_RELAXED, __HIP_MEMORY_SCOPE_AGENT); }
__device__ __forceinline__ unsigned xb_xcc_id() { return (unsigned)__builtin_amdgcn_s_getreg((3 << 11) | 20) & 0xFu; }
#define XB_SPIN(cond, bar) do { unsigned _sp = 0; while (cond) { __builtin_amdgcn_s_sleep(1); \
    if ((++_sp & 255u) == 0u) { if (xb_ld(&(bar)[XB_TMO])) break; if (_sp > XB_SPIN_CAP) { atomicAdd(&(bar)[XB_TMO], 1u); break; } } } } while (0)

struct XcdBarrier {
    unsigned* bar; unsigned x;
    volatile LAS unsigned* st;
};

__device__ __forceinline__ XcdBarrier xcd_barrier_post(unsigned* bar, volatile LAS unsigned* st) {
    XcdBarrier b; b.bar = bar; b.x = xb_xcc_id(); b.st = st;
    if (threadIdx.x == 0) (void)xb_add(&bar[XB_XCNT(b.x)], 1u);
    return b;
}
__device__ __forceinline__ void xcd_barrier_complete(unsigned* bar, unsigned x, unsigned& nloc, unsigned& nx) {
    const unsigned G = gridDim.x * gridDim.y * gridDim.z;
    unsigned sum, cnt, mine, sp = 0u;
    for (;;) {
        sum = 0u; cnt = 0u; mine = 0u;
#pragma unroll
        for (unsigned j = 0; j < 16; ++j) { const unsigned c = xb_ld(&bar[XB_XCNT(j)]); sum += c; cnt += (c > 0u) ? 1u : 0u; mine = (j == x) ? c : mine; }
        if (sum == G) break;
        __builtin_amdgcn_s_sleep(1);
        if ((++sp & 255u) == 0u) { if (xb_ld(&bar[XB_TMO])) break; if (sp > XB_SPIN_CAP) { atomicAdd(&bar[XB_TMO], 1u); break; } }
    }
    nloc = mine > 0u ? mine : 1u; nx = cnt > 0u ? cnt : 1u;
}

__device__ __forceinline__ void xcd_barrier(const XcdBarrier& b) {
    asm volatile("s_waitcnt vmcnt(0)" ::: "memory");
    __syncthreads();
    if (threadIdx.x == 0) {
        unsigned* bar = b.bar;
        __builtin_amdgcn_s_waitcnt(0);
        unsigned nloc = b.st[0], nx = b.st[1];
        if (nloc == 0u) { xcd_barrier_complete(bar, b.x, nloc, nx); b.st[0] = nloc; b.st[1] = nx; }
        const unsigned old = xb_add(&bar[XB_XSUB(b.x)], 1u);
        const unsigned gen = old / nloc;
        if (old + 1u == (gen + 1u) * nloc) {
            __builtin_amdgcn_fence(__ATOMIC_RELEASE, "agent");
            asm volatile("s_waitcnt vmcnt(0)" ::: "memory");
            const unsigned og = xb_add(&bar[XB_TOP], 1u);
            const unsigned tg = og / nx;
            if (og + 1u == (tg + 1u) * nx) xb_add(&bar[XB_TOPGEN], 1u);
            else XB_SPIN(xb_ld(&bar[XB_TOPGEN]) == tg, bar);
            __builtin_amdgcn_fence(__ATOMIC_ACQUIRE, "agent");
            xb_add(&bar[XB_XGEN(b.x)], 1u);
            asm volatile("s_waitcnt vmcnt(0)" ::: "memory");
        } else {
            XB_SPIN(xb_ld(&bar[XB_XGEN(b.x)]) == gen, bar);
            __builtin_amdgcn_fence(__ATOMIC_ACQUIRE, "agent");
            asm volatile("s_waitcnt vmcnt(0)" ::: "memory");
        }
    }
    __syncthreads();
}
namespace pg8 {
#define PG8_LAS __attribute__((address_space(3)))
typedef unsigned short bf16_t;
typedef short bf16x8 __attribute__((ext_vector_type(8)));
typedef float f32x4 __attribute__((ext_vector_type(4)));
typedef unsigned u32x4 __attribute__((ext_vector_type(4)));
typedef int i32x4 __attribute__((ext_vector_type(4)));
constexpr int BM = 256, BK = 64, HALF = 128, HTB = HALF * BK * 2  , STAGE_BYTES = 8 * HTB, NXCD = 8, WGM = 8;

__host__ __device__ __forceinline__ int lds_byte(int r, int c) { const int st = (r >> 4) * 2 + (c >> 5), rr = r & 15, cc = c & 31, ob = rr * 64 + cc * 2; return st * 1024 + (ob ^ (((ob >> 9) & 1) << 5)); }
__host__ __device__ __forceinline__ void stage_rc(int b, int& R, int& C) { const int st = b / 1024, sb = b % 1024, swz = sb ^ (((sb >> 9) & 1) << 5); R = (st >> 1) * 16 + swz / 64; C = (st & 1) * 32 + (swz % 64) / 2; }
__host__ __device__ __forceinline__ int perm32(int rho) { const int n = rho >> 4, i = rho & 15; return 8 * (i >> 2) + 4 * n + (i & 3); }

struct Unit { int pm, pn; };
struct Gemm { const bf16_t* A; const bf16_t* Bt; int M, N, K; };

struct StaticOrder {
    int nM, nN, nwg, G, c;
    __host__ __device__ void init(int M, int N, int G_, int c_) { nM = M / BM; nN = N / BM; nwg = nM * nN; G = G_; c = c_; }
    __host__ __device__ bool next(int i, Unit& u) const {
        const long L = (long)i * G + c; if (L >= nwg) return false;
        int wgid = (int)L; { const int q = nwg / NXCD, r = nwg % NXCD, xcd = wgid % NXCD, off = wgid / NXCD; wgid = (xcd < r ? xcd * (q + 1) : r * (q + 1) + (xcd - r) * q) + off; }
        const int nig = WGM * nN, gid = wgid / nig, fm = gid * WGM, gsz = (nM - fm) < WGM ? (nM - fm) : WGM;
        u.pm = fm + ((wgid % nig) % gsz); u.pn = (wgid % nig) / gsz; return true;
    }
    __device__ __forceinline__ void a_ready(const Unit&) const {}
    __device__ __forceinline__ void done(const Unit&) const {}
};
__device__ __forceinline__ unsigned cvt_pk_bf16(float lo, float hi) { unsigned r; asm volatile("v_cvt_pk_bf16_f32 %0, %1, %2" : "=v"(r) : "v"(lo), "v"(hi)); return r; }
typedef float f32x2 __attribute__((ext_vector_type(2)));
__device__ __forceinline__ f32x2 gelu_pk(f32x2 v) {
    const f32x2 av = __builtin_elementwise_abs(v), d = av * 0.2316418882f + 1.0f;
    f32x2 t; t.x = __builtin_amdgcn_rcpf(d.x); t.y = __builtin_amdgcn_rcpf(d.y);
    f32x2 q = t * 0.5307027145f + (-0.7265760135f); q = q * t + 0.7107068705f; q = q * t + (-0.142248368f); q = q * t + 0.127414796f; q = q * t;
    const f32x2 s = (v * v) * (-0.72134752044f);
    f32x2 e; e.x = __builtin_amdgcn_exp2f(s.x); e.y = __builtin_amdgcn_exp2f(s.y);
    const f32x2 m = v * (q * e), r = v - m;
    f32x2 o; o.x = v.x < 0.f ? m.x : r.x; o.y = v.y < 0.f ? m.y : r.y; return o;
}

struct EpiF32 {
    static constexpr bool PERM = false, AFTER_DRAIN = false, I8 = false; typedef f32x4 acc_t;
    float* C; int ldc; const float* bias;
    __device__ __forceinline__ void operator()(const f32x4 (&acc)[2][2][4][2], const Unit& u, int wr, int wc, int fr, int fq) const {
        const int row0 = u.pm * BM + wr * 64 + fr, col0 = u.pn * BM + wc * 32 + 4 * fq;
        f32x4 bv[2][2];
#pragma unroll
        for (int bj = 0; bj < 2; ++bj)
#pragma unroll
            for (int n = 0; n < 2; ++n) bv[bj][n] = bias ? *(const f32x4*)(bias + col0 + bj * HALF + n * 16) : (f32x4){0.f, 0.f, 0.f, 0.f};
#pragma unroll
        for (int ai = 0; ai < 2; ++ai)
#pragma unroll
            for (int m = 0; m < 4; ++m) { float* rowp = C + (size_t)(row0 + ai * HALF + m * 16) * ldc + col0;
#pragma unroll
                for (int bj = 0; bj < 2; ++bj)
#pragma unroll
                    for (int n = 0; n < 2; ++n) *(f32x4*)(rowp + bj * HALF + n * 16) = acc[ai][bj][m][n] + bv[bj][n]; }
    }
};
template <int ACT  > struct EpiBf16 {
    static constexpr bool PERM = true, AFTER_DRAIN = false, I8 = false; typedef f32x4 acc_t;
    bf16_t* O; int ldc; const float* bias; int split_cols; size_t split_stride;
    __device__ __forceinline__ void operator()(const f32x4 (&acc)[2][2][4][2], const Unit& u, int wr, int wc, int fr, int fq) const {
        const int row0 = u.pm * BM + wr * 64 + fr; int colt = u.pn * BM; bf16_t* base = O;
        if (split_cols) { const int t = colt / split_cols; base += (size_t)t * split_stride; colt -= t * split_cols; }
        const int col0 = colt + wc * 32 + 8 * fq, bcol0 = u.pn * BM + wc * 32 + 8 * fq;
        f32x4 bv[2][2];
#pragma unroll
        for (int bj = 0; bj < 2; ++bj)
#pragma unroll
            for (int n = 0; n < 2; ++n) bv[bj][n] = bias ? *(const f32x4*)(bias + bcol0 + bj * HALF + 4 * n) : (f32x4){0.f, 0.f, 0.f, 0.f};
#pragma unroll
        for (int ai = 0; ai < 2; ++ai)
#pragma unroll
            for (int m = 0; m < 4; ++m) { bf16_t* rowp = base + (size_t)(row0 + ai * HALF + m * 16) * ldc + col0;
#pragma unroll
                for (int bj = 0; bj < 2; ++bj) { f32x4 v0 = acc[ai][bj][m][0] + bv[bj][0], v1 = acc[ai][bj][m][1] + bv[bj][1];
                    if (ACT == 1) { f32x2 a = gelu_pk((f32x2){v0[0], v0[1]}), b = gelu_pk((f32x2){v0[2], v0[3]}), c = gelu_pk((f32x2){v1[0], v1[1]}), d = gelu_pk((f32x2){v1[2], v1[3]});
                        v0 = (f32x4){a.x, a.y, b.x, b.y}; v1 = (f32x4){c.x, c.y, d.x, d.y}; }
                    if (ACT == 2) {
#pragma unroll
                        for (int j = 0; j < 4; ++j) { v0[j] = 0.5f * v0[j] * (1.0f + erff(v0[j] * 0.70710678f)); v1[j] = 0.5f * v1[j] * (1.0f + erff(v1[j] * 0.70710678f)); } }
                    u32x4 w; w.x = cvt_pk_bf16(v0[0], v0[1]); w.y = cvt_pk_bf16(v0[2], v0[3]); w.z = cvt_pk_bf16(v1[0], v1[1]); w.w = cvt_pk_bf16(v1[2], v1[3]);
                    *(u32x4*)(rowp + bj * HALF) = w; } }
    }
};

template <class Epi, class Sched, bool STAMP = false>
__device__ __forceinline__ void gemm_phase(PG8_LAS unsigned char* lds, const Gemm g, const Sched& S, const Epi& E, unsigned long long* stamps) {
    const int tid = opaque_tid(), wid = __builtin_amdgcn_readfirstlane(tid >> 6), lane = tid & 63, wr = wid >> 2, wc = wid & 3, fr = lane & 15, fq = lane >> 4;
    const int K = g.K, nt = K / BK;
    int ts_lo = 0, ts_hi = 0, nts = 0; const unsigned long long rt_entry = STAMP ? (unsigned long long)wall_clock64() : 0ull;
#define PG8_STAMP() do { if (STAMP && wid == 0 && nts < 64) { const unsigned long long _c = (unsigned long long)clock64(); \
        ts_lo = (lane == nts) ? (int)(unsigned)_c : ts_lo; ts_hi = (lane == nts) ? (int)(unsigned)(_c >> 32) : ts_hi; ++nts; } } while (0)
    PG8_STAMP();
    unsigned voffA[2], voffB[2];
#pragma unroll
    for (int i = 0; i < 2; ++i) { int R, C; stage_rc(tid * 16 + i * 8192, R, C); const int Rb = Epi::PERM ? ((R & ~31) + perm32(R & 31)) : R;
        voffA[i] = (unsigned)(R * K + C) * 2u; voffB[i] = (unsigned)(Rb * K + C) * 2u; }
    const size_t kstep = (size_t)(BK * 2);
    const size_t hstep = (size_t)HALF * K * 2;
    const size_t tstep = 2 * hstep;
    const unsigned ldsw = (unsigned)wid * 1024u;
    const int aoff = lds_byte(wr * 64 + fr, fq * 8), boff = lds_byte(wc * 32 + fr, fq * 8);
#define PG8_SA(b, h) (((b) * 2 + (h)) * HTB)
#define PG8_SB(b, h) ((4 + (b) * 2 + (h)) * HTB)
#define PG8_STAGE(bufoff, gbase, voff) do { _Pragma("unroll") for (int _i = 0; _i < 2; ++_i) \
        __builtin_amdgcn_global_load_lds((const unsigned*)((const char*)(gbase) + (voff)[_i]), (PG8_LAS unsigned*)(lds + (bufoff) + ldsw + _i * 8192), 16, 0, 0); } while (0)
#define PG8_LDA(dst, b, h) do { _Pragma("unroll") for (int m = 0; m < 4; ++m) _Pragma("unroll") for (int k = 0; k < 2; ++k) dst[m][k] = *(const PG8_LAS bf16x8*)(lds + PG8_SA(b, h) + aoff + m * 2048 + k * 1024); } while (0)
#define PG8_LDB(dst, b, h) do { _Pragma("unroll") for (int n = 0; n < 2; ++n) _Pragma("unroll") for (int k = 0; k < 2; ++k) dst[n][k] = *(const PG8_LAS bf16x8*)(lds + PG8_SB(b, h) + boff + n * 2048 + k * 1024); } while (0)
#define PG8_MMA(ai, bj, At, Bt) do { __builtin_amdgcn_s_setprio(1); _Pragma("unroll") for (int m = 0; m < 4; ++m) _Pragma("unroll") for (int n = 0; n < 2; ++n) _Pragma("unroll") for (int k = 0; k < 2; ++k) \
        { if constexpr (Epi::I8) acc[ai][bj][m][n] = __builtin_amdgcn_mfma_i32_16x16x64_i8(__builtin_bit_cast(i32x4, Bt[n][k]), __builtin_bit_cast(i32x4, At[m][k]), acc[ai][bj][m][n], 0, 0, 0); \
          else acc[ai][bj][m][n] = __builtin_amdgcn_mfma_f32_16x16x32_bf16(Bt[n][k], At[m][k], acc[ai][bj][m][n], 0, 0, 0); } __builtin_amdgcn_s_setprio(0); } while (0)
#define PG8_WAIT_V(n) asm volatile("s_waitcnt vmcnt(" #n ")" ::: "memory")
#define PG8_WAIT_L(n) asm volatile("s_waitcnt lgkmcnt(" #n ")" ::: "memory")
#define PG8_BAR __builtin_amdgcn_s_barrier()
#define PG8_SCHED __builtin_amdgcn_sched_barrier(0)
    Unit cur, nxt; int ui = 0;
    if (!S.next(0, cur)) return;
    typedef typename Epi::acc_t acc_t;
    acc_t acc[2][2][4][2];
#pragma unroll
    for (int a = 0; a < 2; ++a)
#pragma unroll
        for (int b = 0; b < 2; ++b)
#pragma unroll
            for (int m = 0; m < 4; ++m)
#pragma unroll
                for (int n = 0; n < 2; ++n) acc[a][b][m][n] = (acc_t){0, 0, 0, 0};
    bf16x8 At[4][2], B0[2][2], B1[2][2];
    const char* cA = (const char*)g.A + (size_t)cur.pm * tstep; const char* cB = (const char*)g.Bt + (size_t)cur.pn * tstep;
    S.a_ready(cur);
    PG8_STAGE(PG8_SB(0, 0), cB, voffB); PG8_STAGE(PG8_SA(0, 0), cA, voffA); PG8_STAGE(PG8_SB(0, 1), cB + hstep, voffB); PG8_STAGE(PG8_SA(0, 1), cA + hstep, voffA);
    if (wr == 1) PG8_BAR;
    PG8_WAIT_V(4); PG8_BAR;
    PG8_STAGE(PG8_SB(1, 0), cB + kstep, voffB); PG8_STAGE(PG8_SA(1, 0), cA + kstep, voffA); PG8_STAGE(PG8_SB(1, 1), cB + hstep + kstep, voffB);
    PG8_WAIT_V(6); PG8_BAR;
    PG8_STAMP();
    for (;;) {
        const bool has_next = S.next(ui + 1, nxt);
        const char* nA = has_next ? (const char*)g.A + (size_t)nxt.pm * tstep : cA; const char* nB = has_next ? (const char*)g.Bt + (size_t)nxt.pn * tstep : cB;
        for (int t = 0; t < nt; t += 2) {
            const bool last = (t == nt - 2);
            const char* a1 = cA + (size_t)(t + 1) * kstep;
            const char* a2 = last ? nA : cA + (size_t)(t + 2) * kstep; const char* b2 = last ? nB : cB + (size_t)(t + 2) * kstep;
            const char* a3 = a2 + kstep; const char* b3 = b2 + kstep;
            if (last && has_next) S.a_ready(nxt);
            PG8_LDB(B0, 0, 0); PG8_SCHED; PG8_LDA(At, 0, 0); PG8_STAGE(PG8_SA(1, 1), a1 + hstep, voffA);
            PG8_WAIT_L(8); PG8_BAR; PG8_WAIT_L(0); PG8_MMA(0, 0, At, B0); PG8_BAR; PG8_SCHED;
            PG8_LDB(B1, 0, 1); PG8_STAGE(PG8_SB(0, 0), b2, voffB);
            PG8_BAR; PG8_WAIT_L(0); PG8_MMA(0, 1, At, B1); PG8_BAR;
            PG8_LDA(At, 0, 1); PG8_STAGE(PG8_SA(0, 0), a2, voffA);
            PG8_BAR; PG8_WAIT_L(0); PG8_MMA(1, 0, At, B0); PG8_BAR; PG8_SCHED;
            PG8_STAGE(PG8_SB(0, 1), b2 + hstep, voffB);
            PG8_WAIT_V(6); PG8_BAR; PG8_MMA(1, 1, At, B1); PG8_BAR;
            PG8_LDB(B0, 1, 0); PG8_SCHED; PG8_LDA(At, 1, 0); PG8_STAGE(PG8_SA(0, 1), a2 + hstep, voffA);
            PG8_WAIT_L(8); PG8_BAR; PG8_WAIT_L(0); PG8_MMA(0, 0, At, B0); PG8_BAR; PG8_SCHED;
            PG8_LDB(B1, 1, 1); PG8_STAGE(PG8_SB(1, 0), b3, voffB);
            PG8_BAR; PG8_WAIT_L(0); PG8_MMA(0, 1, At, B1); PG8_BAR;
            PG8_LDA(At, 1, 1); PG8_STAGE(PG8_SA(1, 0), a3, voffA);
            PG8_BAR; PG8_WAIT_L(0); PG8_MMA(1, 0, At, B0); PG8_BAR; PG8_SCHED;
            PG8_STAGE(PG8_SB(1, 1), b3 + hstep, voffB);
            PG8_WAIT_V(6); PG8_BAR; PG8_MMA(1, 1, At, B1); PG8_BAR;
        }
        PG8_STAMP();
        if constexpr (!Epi::AFTER_DRAIN) { if (wr == 0) PG8_BAR; E(acc, cur, wr, wc, fr, fq); S.done(cur); }
        PG8_STAMP();
        if (!has_next) break;
        if constexpr (!Epi::AFTER_DRAIN) { if (wr == 1) PG8_BAR; }
#pragma unroll
        for (int a = 0; a < 2; ++a)
#pragma unroll
            for (int b = 0; b < 2; ++b)
#pragma unroll
                for (int m = 0; m < 4; ++m)
#pragma unroll
                    for (int n = 0; n < 2; ++n) acc[a][b][m][n] = (acc_t){0, 0, 0, 0};
        cur = nxt; cA = nA; cB = nB; ++ui;
    }
    PG8_WAIT_V(0);
    if constexpr (Epi::AFTER_DRAIN) { if (wr == 0) PG8_BAR; }
    PG8_BAR;
    if constexpr (Epi::AFTER_DRAIN) { E.fused(acc, cur, wr, wc, fr, fq, lds, wid, lane); S.done(cur); }
    PG8_STAMP();
    if (STAMP && wid == 0) { stamps[lane] = lane < nts ? (((unsigned long long)(unsigned)ts_hi << 32) | (unsigned)ts_lo) : 0ull;
        if (lane == 62) stamps[62] = rt_entry; if (lane == 63) stamps[63] = (unsigned long long)wall_clock64(); }
#undef PG8_STAMP
#undef PG8_SA
#undef PG8_SB
#undef PG8_STAGE
#undef PG8_LDA
#undef PG8_LDB
#undef PG8_MMA
#undef PG8_WAIT_V
#undef PG8_WAIT_L
#undef PG8_BAR
#undef PG8_SCHED
}
}
namespace pg8 {
template <bool I8_> struct EpiInProjT {
    static constexpr bool PERM = true, AFTER_DRAIN = false, I8 = I8_; typedef typename std::conditional<I8_, i32x4, f32x4>::type acc_t;
    bf16_t *FQ, *FK, *FV, *HQ, *HK, *HV, *HG; float* HLF;
    const float *qg, *kg, *lbw;
    const float *SA, *SB;
    PG8_LAS float* tab;
    __device__ __forceinline__ void operator()(const acc_t (&accq)[2][2][4][2], const Unit& u, int wr, int wc, int fr, int fq) const {
        float sa[2][4]; f32x4 sb[2][2];
        if constexpr (I8_) {
#pragma unroll
            for (int ai = 0; ai < 2; ++ai)
#pragma unroll
                for (int m = 0; m < 4; ++m) sa[ai][m] = SA[u.pm * BM + ai * HALF + m * 16 + wr * 64 + fr];
#pragma unroll
            for (int bj = 0; bj < 2; ++bj)
#pragma unroll
                for (int n = 0; n < 2; ++n) sb[bj][n] = *(const f32x4*)(SB + u.pn * BM + bj * HALF + wc * 32 + 8 * fq + 4 * n);
        }
#define ACCV(ai, bj, m, n) (I8_ ? __builtin_convertvector(accq[ai][bj][m][n], f32x4) * (sb[bj][n] * sa[ai][m]) : __builtin_bit_cast(f32x4, accq[ai][bj][m][n]))
        const int ty = u.pn >> 3, hp = (u.pn & 7) * 2, rl0 = wr * 64 + fr, cih = wc * 32 + 8 * fq;
        const size_t row0 = (size_t)u.pm * BM + rl0;
        if (ty < 2) {
#pragma unroll
            for (int ai = 0; ai < 2; ++ai)
#pragma unroll
                for (int m = 0; m < 4; ++m)
#pragma unroll
                    for (int bj = 0; bj < 2; ++bj) { const f32x4 a = ACCV(ai, bj, m, 0), b = ACCV(ai, bj, m, 1);
                        float s = ((a[0] * a[0] + a[1] * a[1]) + (a[2] * a[2] + a[3] * a[3])) + ((b[0] * b[0] + b[1] * b[1]) + (b[2] * b[2] + b[3] * b[3]));
                        s += __shfl_xor(s, 16); s += __shfl_xor(s, 32);
                        if (fq == 0) tab[((ai * HALF + m * 16 + rl0) * 2 + bj) * 4 + wc] = s; }
            asm volatile("s_waitcnt lgkmcnt(0)" ::: "memory"); __builtin_amdgcn_s_barrier(); asm volatile("" ::: "memory");
            const float* gn = (ty == 0 ? qg : kg) + hp * HDIM + cih; bf16_t* dst = (ty == 0 ? FQ : FK);
            f32x4 g[2][2];
#pragma unroll
            for (int bj = 0; bj < 2; ++bj) { g[bj][0] = *(const f32x4*)(gn + bj * HDIM); g[bj][1] = *(const f32x4*)(gn + bj * HDIM + 4); }
#pragma unroll
            for (int ai = 0; ai < 2; ++ai)
#pragma unroll
                for (int m = 0; m < 4; ++m)
#pragma unroll
                    for (int bj = 0; bj < 2; ++bj) { const f32x4 p = *(const PG8_LAS f32x4*)(tab + ((ai * HALF + m * 16 + rl0) * 2 + bj) * 4);
                        const float rs = __builtin_amdgcn_rsqf(((p[0] + p[1]) + (p[2] + p[3])) * (1.f / HDIM) + EPS_);
                        const f32x4 a = ACCV(ai, bj, m, 0) * rs * g[bj][0], b = ACCV(ai, bj, m, 1) * rs * g[bj][1];
                        u32x4 w = {cvt_pk_bf16(a[0], a[1]), cvt_pk_bf16(a[2], a[3]), cvt_pk_bf16(b[0], b[1]), cvt_pk_bf16(b[2], b[3])};
                        *(u32x4*)(dst + ((size_t)(hp + bj) * T_ + row0 + ai * HALF + m * 16) * HDIM + cih) = w; }
        } else if (ty == 4) {
            float lb[2][8];
#pragma unroll
            for (int bj = 0; bj < 2; ++bj) { const float* l = lbw + (hp + bj) * HDIM + cih;
#pragma unroll
                for (int i = 0; i < 8; ++i) lb[bj][i] = 1.f / (1.f + __expf(l[HGW + i] - l[i])); }
#pragma unroll
            for (int ai = 0; ai < 2; ++ai)
#pragma unroll
                for (int m = 0; m < 4; ++m)
#pragma unroll
                    for (int bj = 0; bj < 2; ++bj) { float f[8];
                        const f32x4 v0_ = ACCV(ai, bj, m, 0), v1_ = ACCV(ai, bj, m, 1);
#pragma unroll
                        for (int i = 0; i < 8; ++i) { const float xx = (i < 4 ? v0_ : v1_)[i & 3]; f[i] = lb[bj][i] + (1.f - lb[bj][i]) * __builtin_amdgcn_rcpf(1.f + __expf(-xx)); }
                        const size_t o = ((size_t)(hp + bj) * T_ + row0 + ai * HALF + m * 16) * HDIM + cih;
                        *(f32x4*)(HLF + o) = (f32x4){__logf(f[0]), __logf(f[1]), __logf(f[2]), __logf(f[3])}; *(f32x4*)(HLF + o + 4) = (f32x4){__logf(f[4]), __logf(f[5]), __logf(f[6]), __logf(f[7])};
                        u32x4 w = {cvt_pk_bf16(1.f - f[0], 1.f - f[1]), cvt_pk_bf16(1.f - f[2], 1.f - f[3]), cvt_pk_bf16(1.f - f[4], 1.f - f[5]), cvt_pk_bf16(1.f - f[6], 1.f - f[7])};
                        *(u32x4*)(HK + o) = w; }
        } else {
            bf16_t* dst = ty == 2 ? FV : ty == 3 ? HQ : ty == 5 ? HV : HG;
            const bool act = (ty == 3) || (ty == 6); const float sc = ty == 3 ? 0.08838834764831845f : 1.f;
#pragma unroll
            for (int ai = 0; ai < 2; ++ai)
#pragma unroll
                for (int m = 0; m < 4; ++m)
#pragma unroll
                    for (int bj = 0; bj < 2; ++bj) { float f[8];
                        const f32x4 v0_ = ACCV(ai, bj, m, 0), v1_ = ACCV(ai, bj, m, 1);
#pragma unroll
                        for (int i = 0; i < 8; ++i) { const float xx = (i < 4 ? v0_ : v1_)[i & 3]; f[i] = act ? xx * sc * __builtin_amdgcn_rcpf(1.f + __expf(-xx)) : xx; }
                        u32x4 w = {cvt_pk_bf16(f[0], f[1]), cvt_pk_bf16(f[2], f[3]), cvt_pk_bf16(f[4], f[5]), cvt_pk_bf16(f[6], f[7])};
                        *(u32x4*)(dst + ((size_t)(hp + bj) * T_ + row0 + ai * HALF + m * 16) * HDIM + cih) = w; }
        }
    }
#undef ACCV
};
typedef EpiInProjT<false> EpiInProj;
}
namespace pg8 {
template <bool I8_> struct EpiOutProjT {
    static constexpr bool PERM = false, AFTER_DRAIN = false, I8 = I8_; typedef typename std::conditional<I8_, i32x4, f32x4>::type acc_t;
    const float* x; const float* mod; const float* ada_b; float* OUT; float* PSSQ; const float *SA, *SB;
    __device__ __forceinline__ void operator()(const acc_t (&acc)[2][2][4][2], const Unit& u, int wr, int wc, int fr, int fq) const {
        const int row0 = u.pm * BM + wr * 64 + fr, col0 = u.pn * BM + wc * 32 + 4 * fq;
        f32x4 gt[2][2];
#pragma unroll
        for (int bj = 0; bj < 2; ++bj)
#pragma unroll
            for (int n = 0; n < 2; ++n) { gt[bj][n] = *(const f32x4*)(mod + 2 * DM + col0 + bj * HALF + n * 16) + *(const f32x4*)(ada_b + 2 * DM + col0 + bj * HALF + n * 16);
                if constexpr (I8_) gt[bj][n] = gt[bj][n] * *(const f32x4*)(SB + col0 + bj * HALF + n * 16); }
#pragma unroll
        for (int ai = 0; ai < 2; ++ai)
#pragma unroll
            for (int m = 0; m < 4; ++m) { const size_t ro = (size_t)(row0 + ai * HALF + m * 16) * DM + col0; float s = 0.f;
                float rsc = 1.f; if constexpr (I8_) rsc = SA[row0 + ai * HALF + m * 16];
#pragma unroll
                for (int bj = 0; bj < 2; ++bj)
#pragma unroll
                    for (int n = 0; n < 2; ++n) { f32x4 av; if constexpr (I8_) av = __builtin_convertvector(acc[ai][bj][m][n], f32x4) * rsc; else av = __builtin_bit_cast(f32x4, acc[ai][bj][m][n]);
                        const f32x4 v = *(const f32x4*)(x + ro + bj * HALF + n * 16) + gt[bj][n] * av;
                        *(f32x4*)(OUT + ro + bj * HALF + n * 16) = v; s += (v[0] * v[0] + v[1] * v[1]) + (v[2] * v[2] + v[3] * v[3]); }
                s += __shfl_xor(s, 16); s += __shfl_xor(s, 32);
                if (fq == 0) PSSQ[(size_t)(row0 + ai * HALF + m * 16) * 64 + u.pn * 4 + wc] = s; }
    }
};
}
namespace pg8 {
template <bool I8_> struct EpiMixBf16T {
    static constexpr bool PERM = true, AFTER_DRAIN = false, I8 = I8_; typedef typename std::conditional<I8_, i32x4, f32x4>::type acc_t;
    bf16_t* O; const float* mod; const float* ada_b;
    const float *SA, *SB;
    __device__ __forceinline__ void operator()(const acc_t (&accq)[2][2][4][2], const Unit& u, int wr, int wc, int fr, int fq) const {
        const int row0 = u.pm * BM + wr * 64 + fr, col0 = u.pn * BM + wc * 32 + 8 * fq;
        f32x4 gt[2][2];
#pragma unroll
        for (int bj = 0; bj < 2; ++bj)
#pragma unroll
            for (int n = 0; n < 2; ++n) { gt[bj][n] = *(const f32x4*)(mod + 2 * DM + col0 + bj * HALF + 4 * n) + *(const f32x4*)(ada_b + 2 * DM + col0 + bj * HALF + 4 * n);
                if constexpr (I8_) gt[bj][n] = gt[bj][n] * *(const f32x4*)(SB + col0 + bj * HALF + 4 * n); }
#pragma unroll
        for (int ai = 0; ai < 2; ++ai)
#pragma unroll
            for (int m = 0; m < 4; ++m) { bf16_t* rowp = O + (size_t)(row0 + ai * HALF + m * 16) * DM + col0;
                float sa = 1.f; if constexpr (I8_) sa = SA[row0 + ai * HALF + m * 16];
#pragma unroll
                for (int bj = 0; bj < 2; ++bj) {
                    f32x4 v0, v1;
                    if constexpr (I8_) { v0 = __builtin_convertvector(accq[ai][bj][m][0], f32x4) * (gt[bj][0] * sa); v1 = __builtin_convertvector(accq[ai][bj][m][1], f32x4) * (gt[bj][1] * sa); }
                    else { v0 = __builtin_bit_cast(f32x4, accq[ai][bj][m][0]) * gt[bj][0]; v1 = __builtin_bit_cast(f32x4, accq[ai][bj][m][1]) * gt[bj][1]; }
                    u32x4 w = {cvt_pk_bf16(v0[0], v0[1]), cvt_pk_bf16(v0[2], v0[3]), cvt_pk_bf16(v1[0], v1[1]), cvt_pk_bf16(v1[2], v1[3])};
                    *(u32x4*)(rowp + bj * HALF) = w; } }
    }
};
}
__device__ __forceinline__ void transpose_item(const float* W, int ld, int c0, bf16_t* WT, int K, int r0, int nblk, LAS float* scr, int item, int lane) {
    const int kb = item / nblk, nb = item % nblk, k0 = 64 * kb, n0 = 32 * nb;
#pragma unroll 8
    for (int i = 0; i < 32; ++i) { const int kk = 2 * i + (lane >> 5); scr[kk * 33 + (lane & 31)] = W[(size_t)(k0 + kk) * ld + c0 + n0 + (lane & 31)]; }
    asm volatile("s_waitcnt lgkmcnt(0)" ::: "memory");
    const int c = lane & 7;
#pragma unroll
    for (int j = 0; j < 4; ++j) { const int n = (lane >> 3) + 8 * j; const LAS float* s = scr + (8 * c) * 33 + n;
        u32x4 o; o.x = pk2(s[0 * 33], s[1 * 33]); o.y = pk2(s[2 * 33], s[3 * 33]); o.z = pk2(s[4 * 33], s[5 * 33]); o.w = pk2(s[6 * 33], s[7 * 33]);
        *(u32x4*)(WT + (size_t)(r0 + n0 + n) * K + k0 + 8 * c) = o; }
    asm volatile("s_waitcnt lgkmcnt(0)" ::: "memory");
}
__device__ __forceinline__ void p_convert(unsigned char* lds, const float* w_in, const float* w_out, const float* w_q,
                                                    bf16_t* WinT, bf16_t* WoutT, bf16_t* WqT, float* WFT) {
    const int tid = opaque_tid(), lane = tid & 63, wave = tid >> 6;
    constexpr int TP = 272, I_O = 0  , NIT = I_O + 8 * 32, PER = NIT / 256;
    static_assert(NIT % 256 == 0, "items must divide evenly over 256 workgroups");
    unsigned char* tile = lds;
    f32x4 x[16];
#define CV_ITEM(it_, src_, ld_, dst_, n0_, k0_) const bool isq_ = (it_) >= I_O; const int j_ = isq_ ? (it_) - I_O : (it_); const float* src_ = isq_ ? w_q : w_out; const int ld_ = isq_ ? PEER_QW : DM; \
        bf16_t* dst_ = isq_ ? WqT : WoutT; const int n0_ = 256 * (j_ >> 5), k0_ = 128 * (j_ & 31)
    { CV_ITEM(blockIdx.x * PER, src, ld, dst, n0, k0); (void)dst;
#pragma unroll
      for (int r = 0; r < 16; ++r) x[r] = *(const f32x4*)(src + (size_t)(k0 + 16 * wave + r) * ld + n0 + 4 * lane); }
#pragma unroll 1
    for (int i = 0; i < PER; ++i) {
        CV_ITEM(blockIdx.x * PER + i, src, ld, dst, n0, k0); (void)src; (void)ld;
        u32x4 P[4][2];
#pragma unroll
        for (int b4 = 0; b4 < 4; ++b4)
#pragma unroll
            for (int d = 0; d < 8; ++d) P[b4][d >> 2][d & 3] = pk2(x[2 * d][b4], x[2 * d + 1][b4]);
        if (i + 1 < PER) { CV_ITEM(blockIdx.x * PER + i + 1, src1, ld1, dst1, n1, k1); (void)dst1;
#pragma unroll
            for (int r = 0; r < 16; ++r) x[r] = *(const f32x4*)(src1 + (size_t)(k1 + 16 * wave + r) * ld1 + n1 + 4 * lane); }
#pragma unroll
        for (int b4 = 0; b4 < 4; ++b4) { *(u32x4*)(tile + (4 * lane + b4) * TP + 32 * wave) = P[b4][0]; *(u32x4*)(tile + (4 * lane + b4) * TP + 32 * wave + 16) = P[b4][1]; }
        __syncthreads();
#pragma unroll
        for (int ps = 0; ps < 8; ++ps) { const int n = 32 * ps + (tid >> 4), pc = tid & 15;
            *(u32x4*)((unsigned char*)(dst + (size_t)(n0 + n) * DM + k0) + 16 * pc) = *(const u32x4*)(tile + n * TP + 16 * pc); }
        __syncthreads();
    }
#undef CV_ITEM
    const size_t gt = (size_t)blockIdx.x * 512 + tid, NGT = (size_t)gridDim.x * 512;
    for (size_t i = gt; i < (size_t)16 * DM; i += NGT) { const int h = (int)(i / DM), k = (int)(i % DM); WFT[i] = w_in[(size_t)k * NIN + 6144 + h]; }
}
__device__ __forceinline__ void p_adaln(unsigned char* lds, const float* c, const float* ada_w, float* mod) {
    float* cact = (float*)lds;
    float* part = cact + DM;
    const int tid = opaque_tid();
    for (int i = tid; i < DM; i += 512) cact[i] = silu_f(c[i]);
    __syncthreads();
    const int g = tid / 24, q = tid % 24;
    for (int cb = blockIdx.x; cb < 6 * DM / 96; cb += gridDim.x) {
        f32x4 acc = {0.f, 0.f, 0.f, 0.f};
        if (g < 21) {
            const float* wp = ada_w + (size_t)cb * 96 + 4 * q;
#pragma unroll 8
            for (int k = g; k < DM; k += 21) { const f32x4 w = *(const f32x4*)(wp + (size_t)k * (6 * DM)); acc += w * cact[k]; }
            *(f32x4*)(part + g * 96 + 4 * q) = acc;
        }
        __syncthreads();
        if (tid < 96) { float s = 0.f;
#pragma unroll
            for (int j = 0; j < 21; ++j) s += part[j * 96 + tid];
            mod[cb * 96 + tid] = s; }
        __syncthreads();
    }
}
__device__ __forceinline__ float dot2_bf16(unsigned a, unsigned b, float c) { typedef __bf16 bf2_ __attribute__((ext_vector_type(2))); return __builtin_amdgcn_fdot2_f32_bf16(__builtin_bit_cast(bf2_, a), __builtin_bit_cast(bf2_, b), c, false); }
__device__ __forceinline__ void p_norm1(unsigned char* lds, const float* x, const float* mod, const float* ada_b, const float* g1, const float* WFT, const float* fbias, unsigned char* H1Q, float* SA, float* FLOGF) {
    unsigned short* A1h = (unsigned short*)lds; unsigned short* B1h = A1h + DM; unsigned short* WFh = B1h + DM;
    const int tid = opaque_tid(), lane = tid & 63, wave = tid >> 6;
    for (int i = tid; i < DM; i += 512) { A1h[i] = (unsigned short)f2bf(g1[i] * (1.f + mod[DM + i] + ada_b[DM + i])); B1h[i] = (unsigned short)f2bf(mod[i] + ada_b[i]); }
    for (int i = tid; i < 16 * DM / 4; i += 512) { const f32x4 w = *(const f32x4*)(WFT + 4 * i); *(u32x2*)(WFh + 4 * i) = (u32x2){pk2(w[0], w[1]), pk2(w[2], w[3])}; }
    __syncthreads();
#define UNPK4(p_) ((f32x4){bf2f((p_).x & 0xffffu), bf2f((p_).x >> 16), bf2f((p_).y & 0xffffu), bf2f((p_).y >> 16)})
    for (int t0 = (blockIdx.x * 8 + wave) * 2; t0 < T_; t0 += gridDim.x * 16) {
        u32x2 hp[2][16];
#pragma unroll
        for (int tk = 0; tk < 2; ++tk) {
            const f32x4* xr = (const f32x4*)(x + (size_t)(t0 + tk) * DM) + lane;
            f32x4 v[16]; float ss = 0.f;
#pragma unroll
            for (int j = 0; j < 16; ++j) { v[j] = xr[64 * j]; ss += (v[j][0] * v[j][0] + v[j][1] * v[j][1]) + (v[j][2] * v[j][2] + v[j][3] * v[j][3]); }
            const float rstd = rsqrtf(wave_sum(ss) * (1.f / DM) + EPS_);
            float mx = 0.f;
#pragma unroll
            for (int j = 0; j < 16; ++j) { const u32x2 ap = *(const u32x2*)(A1h + 4 * lane + 256 * j), bp = *(const u32x2*)(B1h + 4 * lane + 256 * j);
                const f32x4 hh = v[j] * rstd * UNPK4(ap) + UNPK4(bp); hp[tk][j] = (u32x2){pk2(hh[0], hh[1]), pk2(hh[2], hh[3])}; v[j] = hh;
                mx = fmaxf(fmaxf(mx, fmaxf(fabsf(hh[0]), fabsf(hh[1]))), fmaxf(fabsf(hh[2]), fabsf(hh[3]))); }
#pragma unroll
            for (int o = 1; o < 64; o <<= 1) mx = fmaxf(mx, __shfl_xor(mx, o));
            const float sc = fmaxf(mx, 1e-30f) * (1.f / 127.f), inv = 1.f / sc;
            unsigned* q8 = (unsigned*)(H1Q + (size_t)(t0 + tk) * DM) + lane;
#pragma unroll
            for (int j = 0; j < 16; ++j) { const int b0 = (int)rintf(v[j][0] * inv) & 0xff, b1 = (int)rintf(v[j][1] * inv) & 0xff, b2 = (int)rintf(v[j][2] * inv) & 0xff, b3 = (int)rintf(v[j][3] * inv) & 0xff;
                q8[64 * j] = (unsigned)b0 | ((unsigned)b1 << 8) | ((unsigned)b2 << 16) | ((unsigned)b3 << 24); }
            if (lane == 0) SA[t0 + tk] = sc;
            asm volatile("" ::: "memory");
        }
        float dd0[16], dd1[16];
#pragma unroll
        for (int h = 0; h < 16; ++h) { float d0 = 0.f, d1 = 0.f;
#pragma unroll
            for (int j = 0; j < 16; ++j) { const u32x2 wp = *(const u32x2*)(WFh + h * DM + 4 * lane + 256 * j);
                d0 = dot2_bf16(hp[0][j].x, wp.x, d0); d0 = dot2_bf16(hp[0][j].y, wp.y, d0); d1 = dot2_bf16(hp[1][j].x, wp.x, d1); d1 = dot2_bf16(hp[1][j].y, wp.y, d1); }
            dd0[h] = d0; dd1[h] = d1; }
        float r16[16], r8[8], r4[4], r2[2], r1;
        { const bool hi = lane & 32;
#pragma unroll
          for (int j = 0; j < 16; ++j) r16[j] = (hi ? dd1[j] : dd0[j]) + __shfl_xor(hi ? dd0[j] : dd1[j], 32); }
        { const bool hi = lane & 16;
#pragma unroll
          for (int j = 0; j < 8; ++j) r8[j] = (hi ? r16[j + 8] : r16[j]) + __shfl_xor(hi ? r16[j] : r16[j + 8], 16); }
        { const bool hi = lane & 8;
#pragma unroll
          for (int j = 0; j < 4; ++j) r4[j] = (hi ? r8[j + 4] : r8[j]) + __shfl_xor(hi ? r8[j] : r8[j + 4], 8); }
        { const bool hi = lane & 4;
#pragma unroll
          for (int j = 0; j < 2; ++j) r2[j] = (hi ? r4[j + 2] : r4[j]) + __shfl_xor(hi ? r4[j] : r4[j + 2], 4); }
        { const bool hi = lane & 2; r1 = (hi ? r2[1] : r2[0]) + __shfl_xor(hi ? r2[0] : r2[1], 2); }
        r1 += __shfl_xor(r1, 1);
        if ((lane & 1) == 0) { const int h = (lane >> 1) & 15; const float z = r1 + fbias[h]; FLOGF[(size_t)h * T_ + t0 + (lane >> 5)] = fminf(z, 0.f) - log1pf(__expf(-fabsf(z))); }
    }
#undef UNPK4
}
__device__ __forceinline__ void p_post1(unsigned char* lds, const float* PROJ, const float* qg, const float* kg, const float* lbw,
                                                  bf16_t* FQ, bf16_t* FK, bf16_t* FV, bf16_t* HQ, bf16_t* HK, bf16_t* HV, bf16_t* HG, float* HLF) {
    const int tid = opaque_tid(), lane = tid & 63, wave = tid >> 6;
    for (int t = blockIdx.x * 8 + wave; t < T_; t += gridDim.x * 8) {
        const float* row = PROJ + (size_t)t * NPROJ;
        for (int s = 0; s < 112; ++s) {
            const int ty = s >> 4, h = s & 15, c = 2 * lane;
            const f32x2 p = *(const f32x2*)(row + s * 128 + c);
            const size_t o = ((size_t)h * T_ + t) * HDIM + c;
            if (ty < 2) {
                const float rs = rsqrtf(wave_sum(p[0] * p[0] + p[1] * p[1]) * (1.f / HDIM) + EPS_);
                const float* g = (ty == 0 ? qg : kg) + h * HDIM + c;
                *(unsigned*)((ty == 0 ? FQ : FK) + o) = pk2(p[0] * rs * g[0], p[1] * rs * g[1]);
            } else if (ty == 2) { *(unsigned*)(FV + o) = pk2(p[0], p[1]); }
            else if (ty == 3) { *(unsigned*)(HQ + o) = pk2(silu_f(p[0]) * 0.08838834764831845f, silu_f(p[1]) * 0.08838834764831845f); }
            else if (ty == 4) {
                const int j = h * HDIM + c;
                const float lb0 = 1.f / (1.f + __expf(lbw[HGW + j] - lbw[j])), lb1 = 1.f / (1.f + __expf(lbw[HGW + j + 1] - lbw[j + 1]));
                const float f0 = lb0 + (1.f - lb0) * sigmoid_f(p[0]), f1 = lb1 + (1.f - lb1) * sigmoid_f(p[1]);
                *(f32x2*)(HLF + o) = (f32x2){__logf(f0), __logf(f1)};
                *(unsigned*)(HK + o) = pk2(1.f - f0, 1.f - f1);
            } else if (ty == 5) { *(unsigned*)(HV + o) = pk2(p[0], p[1]); }
            else { *(unsigned*)(HG + o) = pk2(silu_f(p[0]), silu_f(p[1])); }
        }
    }
}
__device__ __forceinline__ void p_scan(unsigned char* lds, const float* FLOGF, float* FCUM) {
    float* part = (float*)lds;
    const int tid = opaque_tid();
    for (int h = blockIdx.x; h < NHEAD; h += gridDim.x) {
        const float* src = FLOGF + (size_t)h * T_ + tid * 16; float v[16]; float s = 0.f;
#pragma unroll
        for (int i = 0; i < 16; ++i) { s += src[i]; v[i] = s; }
        part[tid] = s; __syncthreads();
        if (tid == 0) { float run = 0.f; for (int i = 0; i < 512; ++i) { const float p = part[i]; part[i] = run; run += p; } }
        __syncthreads();
        const float off = part[tid]; float* dst = FCUM + (size_t)h * T_ + tid * 16;
#pragma unroll
        for (int i = 0; i < 16; ++i) dst[i] = v[i] + off;
        __syncthreads();
    }
}
constexpr int SLB = 256;
__device__ __forceinline__ void p_convert_uv4(unsigned char* lds, unsigned* qhead, const float* u, const float* v, unsigned char* U4, float* SU, unsigned char* V4, float* SV) {
    const int tid = opaque_tid(), lane = tid & 63, wave = tid >> 6;
    volatile unsigned* slot = (volatile unsigned*)lds;
    for (;;) {
        __syncthreads();
        if (tid == 0) *slot = __hip_atomic_fetch_add(qhead, 1u, __ATOMIC_RELAXED, __HIP_MEMORY_SCOPE_AGENT);
        __syncthreads();
        const unsigned chunk = *slot;
        if (chunk >= 2u * PEER_NE / 8u) break;
        { const int r = (int)chunk * 8 + wave;
        const bool isv = r >= PEER_NE; const int e = isv ? r - PEER_NE : r;
        const float* src = (isv ? v : u) + (size_t)e * DM;
        f32x4 x[16]; float mx = 0.f, ss = 0.f;
#pragma unroll
        for (int i = 0; i < 16; ++i) {
            x[i] = *(const f32x4*)(src + 4 * lane + 256 * i);
            ss += (x[i][0] * x[i][0] + x[i][1] * x[i][1]) + (x[i][2] * x[i][2] + x[i][3] * x[i][3]);
            mx = fmaxf(fmaxf(mx, fmaxf(fabsf(x[i][0]), fabsf(x[i][1]))), fmaxf(fabsf(x[i][2]), fabsf(x[i][3]))); }
#pragma unroll
        for (int o = 1; o < 64; o <<= 1) { mx = fmaxf(mx, __shfl_xor(mx, o)); ss += __shfl_xor(ss, o); }
        const float sc = fmaxf(fminf(0.3352f * sqrtf(ss * (1.f / DM)), mx * (1.f / 7.5f)), 1e-30f), inv = 1.f / sc;
        unsigned qd[16];
#pragma unroll
        for (int i = 0; i < 16; ++i) { qd[i] = 0u;
#pragma unroll
            for (int b4 = 0; b4 < 4; ++b4) qd[i] |= (unsigned)(int)fminf(fmaxf(floorf(x[i][b4] * inv) + 8.f, 0.f), 15.f) << (8 * b4);
            if (!isv || (i & 1)) qd[i] ^= 0x08080808u; }
        unsigned* dst = (unsigned*)((isv ? V4 : U4) + (size_t)e * SLB) + lane;
#pragma unroll
        for (int xs = 0; xs < 8; ++xs) dst[(size_t)xs * PEER_NE * (SLB / 4)] = qd[2 * xs] | (qd[2 * xs + 1] << 4);
        if (lane == 0) (isv ? SV : SU)[e] = sc; }
    }
}
template <int LD> __device__ __forceinline__ void p_colmax(const float* W, float* PM) {
    const int tid = opaque_tid();
    constexpr int NCH = (LD + 2047) / 2048;
    for (int it = blockIdx.x; it < 64 * NCH; it += gridDim.x) {
        const int ch = it % NCH, ks = it / NCH, col = ch * 2048 + tid * 4;
        if (col < LD) {
            f32x4 mx = {0.f, 0.f, 0.f, 0.f};
#pragma unroll 16
            for (int k = 0; k < 64; ++k) { const f32x4 w = *(const f32x4*)(W + (size_t)(ks * 64 + k) * LD + col); mx = (f32x4){fmaxf(mx[0], fabsf(w[0])), fmaxf(mx[1], fabsf(w[1])), fmaxf(mx[2], fabsf(w[2])), fmaxf(mx[3], fabsf(w[3]))}; }
            *(f32x4*)(PM + (size_t)ks * LD + col) = mx;
        }
    }
}
template <int LD, int NOUT, bool GAP16> __device__ __forceinline__ void p_quant_w(unsigned char* lds, const float* W, const float* PM, unsigned char* WT8, float* SB) {
    const int tid = opaque_tid(), lane = tid & 63, wave = tid >> 6;
    constexpr int TP = 144, NIT = (NOUT / 256) * (DM / 128), PER = NIT / 256;
    static_assert(NIT % 256 == 0, "items must divide evenly over 256 workgroups");
    unsigned char* tile = lds;
    float* redm = (float*)(lds + 256 * TP);
    float* scl = redm + 512;
    int gcur = -1; f32x4 inv = {0.f, 0.f, 0.f, 0.f};
    f32x4 x[16];
    { const int it = blockIdx.x * PER, g = it / (DM / 128), kt = it % (DM / 128), n0 = 256 * g, c0 = (GAP16 && n0 >= 6144) ? n0 + 16 : n0;
#pragma unroll
      for (int r = 0; r < 16; ++r) x[r] = *(const f32x4*)(W + (size_t)(128 * kt + 16 * wave + r) * LD + c0 + 4 * lane); }
#pragma unroll 1
    for (int i = 0; i < PER; ++i) {
        const int it = blockIdx.x * PER + i, g = it / (DM / 128), kt = it % (DM / 128), n0 = 256 * g, c0 = (GAP16 && n0 >= 6144) ? n0 + 16 : n0, k0 = 128 * kt;
        if (g != gcur) {
            gcur = g;
            { const int c = tid & 255, hf = tid >> 8; float m = 0.f;
#pragma unroll 8
              for (int p = 0; p < 32; ++p) m = fmaxf(m, PM[(size_t)(32 * hf + p) * LD + c0 + c]);
              redm[hf * 256 + c] = m; }
            __syncthreads();
            if (tid < 256) { const float sc = fmaxf(fmaxf(redm[tid], redm[256 + tid]), 1e-30f) * (1.f / 127.f); scl[tid] = 1.f / sc; if (kt == 0) SB[n0 + tid] = sc; }
            __syncthreads();
            inv = *(const f32x4*)(scl + 4 * lane);
        }
        u32x4 P[4];
#pragma unroll
        for (int b4 = 0; b4 < 4; ++b4)
#pragma unroll
            for (int d = 0; d < 4; ++d) { unsigned v = 0u;
#pragma unroll
                for (int e2 = 0; e2 < 4; ++e2) v |= ((unsigned)((int)fminf(fmaxf(rintf(x[4 * d + e2][b4] * inv[b4]), -127.f), 127.f) & 0xff)) << (8 * e2);
                P[b4][d] = v; }
        if (i + 1 < PER) { const int it1 = it + 1, g1 = it1 / (DM / 128), kt1 = it1 % (DM / 128), n1 = 256 * g1, c1 = (GAP16 && n1 >= 6144) ? n1 + 16 : n1;
#pragma unroll
            for (int r = 0; r < 16; ++r) x[r] = *(const f32x4*)(W + (size_t)(128 * kt1 + 16 * wave + r) * LD + c1 + 4 * lane); }
#pragma unroll
        for (int b4 = 0; b4 < 4; ++b4) *(u32x4*)(tile + (4 * lane + b4) * TP + 16 * wave) = P[b4];
        __syncthreads();
#pragma unroll
        for (int ps = 0; ps < 4; ++ps) { const int n = 64 * ps + (tid >> 3), pc = tid & 7;
            *(u32x4*)(WT8 + (size_t)(n0 + n) * DM + k0 + 16 * pc) = *(const u32x4*)(tile + n * TP + 16 * pc); }
        __syncthreads();
    }
}
__device__ __forceinline__ void p_quant_merged(const bf16_t* MERGED, unsigned char* M8, float* SM) {
    const int tid = opaque_tid(), lane = tid & 63, wave = tid >> 6;
    for (int t = blockIdx.x * 8 + wave; t < T_; t += gridDim.x * 8) {
        const u32x4* src = (const u32x4*)(MERGED + (size_t)t * DM + 16 * lane);
        u32x4 w[4][2]; float mx = 0.f;
#pragma unroll
        for (int j = 0; j < 4; ++j) { w[j][0] = src[128 * j]; w[j][1] = src[128 * j + 1];
#pragma unroll
            for (int h = 0; h < 2; ++h)
#pragma unroll
                for (int c = 0; c < 4; ++c) mx = fmaxf(mx, fmaxf(fabsf(bf2f(w[j][h][c] & 0xffffu)), fabsf(bf2f(w[j][h][c] >> 16)))); }
#pragma unroll
        for (int o = 1; o < 64; o <<= 1) mx = fmaxf(mx, __shfl_xor(mx, o));
        const float sc = fmaxf(mx, 1e-30f) * (1.f / 127.f), inv = 1.f / sc;
#pragma unroll
        for (int j = 0; j < 4; ++j) { u32x4 o;
#pragma unroll
            for (int q = 0; q < 4; ++q) { const unsigned a = w[j][q >> 1][2 * (q & 1)], b = w[j][q >> 1][2 * (q & 1) + 1];
                o[q] = ((unsigned)((int)rintf(bf2f(a & 0xffffu) * inv) & 0xff)) | (((unsigned)((int)rintf(bf2f(a >> 16) * inv) & 0xff)) << 8) |
                       (((unsigned)((int)rintf(bf2f(b & 0xffffu) * inv) & 0xff)) << 16) | (((unsigned)((int)rintf(bf2f(b >> 16) * inv) & 0xff)) << 24); }
            *(u32x4*)(M8 + (size_t)t * DM + 16 * lane + 1024 * j) = o; }
        if (lane == 0) SM[t] = sc;
    }
}
namespace fox {
constexpr int B = 1, H = NHEAD, HKV = NHEAD, SQ = T_, SKV = T_, D = HDIM, QOFF = 0, WINDOW = SKV;
constexpr float THR = 8.f;
constexpr bool WSKIP = false;
constexpr float SCALE = 0.08838834764831845f;
constexpr float INV_SCALE = 11.313708498984761f;
constexpr int NW = 8, QBLK = 32, KVBLK = 64, QB = NW * QBLK;
constexpr int SHM_V = KVBLK * D * 2, SHM_K = KVBLK * D * 2;
constexpr int LDS_BYTES = 2 * SHM_V + 2 * SHM_K + NW * 64 * 4;
constexpr int CUM_OFF = LDS_BYTES;
constexpr int OST = 4096;
static_assert(D == 128 && SQ % QB == 0 && SKV % KVBLK == 0 && H % HKV == 0 && QOFF >= 0 && QOFF + SQ <= SKV && WINDOW >= 1, "geometry");

using bf16 = __hip_bfloat16;
typedef short bf16x8 __attribute__((ext_vector_type(8)));
typedef short s16x4 __attribute__((ext_vector_type(4)));
typedef float f32x16 __attribute__((ext_vector_type(16)));
typedef float f32x4 __attribute__((ext_vector_type(4)));
typedef unsigned u32x4 __attribute__((ext_vector_type(4)));
template <class A, class Bt> struct same_t { static constexpr bool v = false; };
template <class A> struct same_t<A, A> { static constexpr bool v = true; };

#define KSWZ(row, colB) ((row) * 256 + ((colB) ^ (((row) & 7) << 4)))
#define SBAR() __builtin_amdgcn_sched_barrier(0)
__device__ __forceinline__ int v_st(int k, int c) { const int kk = (k & ~0xC) | ((k & 4) << 1) | ((k & 8) >> 1); return ((kk >> 3) * 4 + (c >> 5)) * 512 + ((kk & 7) * 32 + (c & 31)) * 2; }
__device__ __forceinline__ int v_rd_base(int lane) { return ((lane & 3) << 3) | (((lane >> 2) & 3) << 6) | (((lane >> 4) & 1) << 5) | (((lane >> 5) & 1) << 8); }
constexpr int v_rd_off(int d0, int ks, int half) { return d0 * 512 + ks * 4096 + half * 2048; }
__device__ __forceinline__ int crow(int r, int hi) { return (r & 3) + 8 * (r >> 2) + 4 * hi; }
__device__ __forceinline__ unsigned cvtpk(float lo, float hi) {
    unsigned r; asm volatile("v_cvt_pk_bf16_f32 %0, %1, %2" : "=v"(r) : "v"(lo), "v"(hi)); return r;
}
__device__ __forceinline__ bf16x8 pack8(f32x4 a, f32x4 b) {
    u32x4 w = {cvtpk(a[0], a[1]), cvtpk(a[2], a[3]), cvtpk(b[0], b[1]), cvtpk(b[2], b[3])};
    return *reinterpret_cast<bf16x8*>(&w);
}
template <class T> __device__ __forceinline__ bf16x8 load8(const T* p) {
    if constexpr (same_t<T, float>::v) { return pack8(*(const f32x4*)p, *(const f32x4*)(p + 4)); }
    else { return *reinterpret_cast<const bf16x8*>(p); }
}
__device__ __forceinline__ void mask_tile(f32x16& p0, f32x16& p1, int dq, unsigned W) {
    const float NEG = -__builtin_inff();
#pragma unroll
    for (int r = 0; r < 16; ++r) {
        const int c = (r & 3) + 8 * (r >> 2);
        if ((unsigned)(dq - c) >= W) p0[r] = NEG;
        if ((unsigned)(dq - c - 32) >= W) p1[r] = NEG;
    }
}
__device__ __forceinline__ void partialSM(f32x16& p0, f32x16& p1, float& m_reg, float& mn, float& alpha) {
    float pmax = p0[0]; for (int r = 1; r < 16; ++r) pmax = fmaxf(pmax, p0[r]); for (int r = 0; r < 16; ++r) pmax = fmaxf(pmax, p1[r]);
    { auto rr = __builtin_amdgcn_permlane32_swap(__float_as_uint(pmax), __float_as_uint(pmax), false, false);
      pmax = fmaxf(__uint_as_float(rr[0]), __uint_as_float(rr[1])); }
    constexpr float C2 = 1.4426950408889634f * SCALE;
    if (__builtin_expect(__all((pmax - m_reg) * SCALE <= THR), 1)) { mn = m_reg; alpha = 1.f; }
    else { mn = fmaxf(m_reg, pmax); alpha = __builtin_amdgcn_exp2f((m_reg - mn) * C2); m_reg = mn; }
    const float mnL = -mn * C2;
    for (int r = 0; r < 16; ++r) p0[r] = fmaf(p0[r], C2, mnL); for (int r = 0; r < 16; ++r) p1[r] = fmaf(p1[r], C2, mnL);
    for (int r = 0; r < 16; ++r) p0[r] = __builtin_amdgcn_exp2f(p0[r]);
}
__device__ __forceinline__ void finishSM(f32x16& p0, f32x16& p1, float alpha, float& l_reg, bf16x8& pa0, bf16x8& pa1, bf16x8& pa2, bf16x8& pa3) {
    for (int r = 0; r < 16; ++r) p1[r] = __builtin_amdgcn_exp2f(p1[r]);
    float ps = 0; for (int r = 0; r < 16; ++r) ps += p0[r]; for (int r = 0; r < 16; ++r) ps += p1[r];
    { auto rr = __builtin_amdgcn_permlane32_swap(__float_as_uint(ps), __float_as_uint(ps), false, false);
      ps = __uint_as_float(rr[0]) + __uint_as_float(rr[1]); }
    l_reg = l_reg * alpha + ps;
#define PK4(P, B_, OUT) do { unsigned a0 = cvtpk(P[B_+0], P[B_+1]), a1 = cvtpk(P[B_+2], P[B_+3]);                          \
        unsigned b0 = cvtpk(P[B_+4], P[B_+5]), b1 = cvtpk(P[B_+6], P[B_+7]);                                             \
        auto r0 = __builtin_amdgcn_permlane32_swap(a0, b0, false, false); auto r1 = __builtin_amdgcn_permlane32_swap(a1, b1, false, false); \
        u32x4 w = {r0[0], r1[0], r0[1], r1[1]}; OUT = *reinterpret_cast<bf16x8*>(&w); } while (0)
    PK4(p0, 0, pa0); PK4(p0, 8, pa1); PK4(p1, 0, pa2); PK4(p1, 8, pa3);
#undef PK4
}
template <int KB, bool SK>
__device__ __forceinline__ void qkt(f32x16& p0, f32x16& p1, const char* K_lds, int r32, int hi, const bf16x8* qr, bool act, const float* cb) {
    if (SK && !act) { const float NEG = -__builtin_inff();
#pragma unroll
        for (int r = 0; r < 16; ++r) { p0[r] = NEG; p1[r] = NEG; } return; }
#pragma unroll
    for (int g = 0; g < 4; ++g) { const f32x4 c0 = *(const f32x4*)(cb + 8 * g), c1 = *(const f32x4*)(cb + 32 + 8 * g);
#pragma unroll
        for (int e = 0; e < 4; ++e) { p0[4 * g + e] = c0[e]; p1[4 * g + e] = c1[e]; } }
    const char* kb[4];
#pragma unroll
    for (int dd = 0; dd < 4; ++dd) kb[dd] = K_lds + KB * SHM_K + KSWZ(r32, (dd * 16 + hi * 8) * 2);
#pragma unroll
    for (int d0 = 0; d0 < 8; ++d0) { const char* a = kb[d0 & 3] + (d0 >> 2) * 128;
        bf16x8 b0 = *reinterpret_cast<const bf16x8*>(a);
        bf16x8 b1 = *reinterpret_cast<const bf16x8*>(a + 32 * 256);
        p0 = __builtin_amdgcn_mfma_f32_32x32x16_bf16(b0, qr[d0], p0, 0, 0, 0);
        p1 = __builtin_amdgcn_mfma_f32_32x32x16_bf16(b1, qr[d0], p1, 0, 0, 0); }
}
template <int VB, bool SK>
__device__ __forceinline__ void pv_tile(f32x16* o, int vb0, bf16x8 pa0, bf16x8 pa1, bf16x8 pa2, bf16x8 pa3, bool act) {
    if (SK && !act) return;
#define TRRD(dst, off) asm volatile("ds_read_b64_tr_b16 %0, %1 offset:%2" : "=&v"(dst) : "v"(vb0), "i"(off) : "memory")
#define PV_D0(d0) do { s16x4 l0, l1, l2, l3, h0, h1, h2, h3; constexpr int b_ = VB * SHM_V + v_rd_off(d0, 0, 0);     \
        TRRD(l0, b_); TRRD(h0, b_ + 2048); TRRD(l1, b_ + 4096); TRRD(h1, b_ + 6144); TRRD(l2, b_ + 8192); TRRD(h2, b_ + 10240); TRRD(l3, b_ + 12288); TRRD(h3, b_ + 14336); \
        asm volatile("s_waitcnt lgkmcnt(0)" ::: "memory"); SBAR();                 \
        o[d0] = __builtin_amdgcn_mfma_f32_32x32x16_bf16(pa0, (bf16x8){l0[0], l0[1], l0[2], l0[3], h0[0], h0[1], h0[2], h0[3]}, o[d0], 0, 0, 0);   \
        o[d0] = __builtin_amdgcn_mfma_f32_32x32x16_bf16(pa1, (bf16x8){l1[0], l1[1], l1[2], l1[3], h1[0], h1[1], h1[2], h1[3]}, o[d0], 0, 0, 0);   \
        o[d0] = __builtin_amdgcn_mfma_f32_32x32x16_bf16(pa2, (bf16x8){l2[0], l2[1], l2[2], l2[3], h2[0], h2[1], h2[2], h2[3]}, o[d0], 0, 0, 0);   \
        o[d0] = __builtin_amdgcn_mfma_f32_32x32x16_bf16(pa3, (bf16x8){l3[0], l3[1], l3[2], l3[3], h3[0], h3[1], h3[2], h3[3]}, o[d0], 0, 0, 0); } while (0)
    PV_D0(0); PV_D0(1); PV_D0(2); PV_D0(3);
#undef PV_D0
#undef TRRD
}

template <class TIn, class TOut> struct BlockRef { const TIn* Q; const TIn* K; const TIn* V; TOut* O; int P0; };
template <class TIn> struct Seam {
    bf16x8 qr[8];
    bf16x8 st_v0, st_v1, st_k0, st_k1; f32x4 sf0, sf1, sf2, sf3;
    f32x4 tq[16];
};
__device__ __forceinline__ int swa_jlo(int P0, int W) { const int lowk = P0 - W + 1; return lowk > 0 ? lowk / KVBLK : 0; }
#define ROW(p, k0, rr) ((p) + (size_t)((k0) + (rr)) * D + sc)
#define VMW() asm volatile("s_waitcnt vmcnt(0)" ::: "memory")
#define VMWN(n) asm volatile("s_waitcnt vmcnt(%0)" :: "i"(n) : "memory")
#define SLOAD_H(Kp, Vp, k0) do { S.st_v0 = load8<TIn>(ROW(Vp, k0, sr)); S.st_v1 = load8<TIn>(ROW(Vp, k0, 32 + sr));              \
                         S.st_k0 = load8<TIn>(ROW(Kp, k0, sr)); S.st_k1 = load8<TIn>(ROW(Kp, k0, 32 + sr)); } while (0)
#define SWRITE_HK(bf) do { *(bf16x8*)(K_lds + (bf) * SHM_K + kws) = S.st_k0; *(bf16x8*)(K_lds + (bf) * SHM_K + kws + 32 * 256) = S.st_k1; } while (0)
#define SWRITE_HV(bf) do { *(bf16x8*)(V_lds + (bf) * SHM_V + vst0) = S.st_v0; *(bf16x8*)(V_lds + (bf) * SHM_V + vst1) = S.st_v1; } while (0)
#define SWRITE_H(bf) do { SWRITE_HV(bf); SWRITE_HK(bf); } while (0)
#define SLOAD_F(p, k0) do { S.sf0 = *(const f32x4*)ROW(p, k0, sr); S.sf1 = *(const f32x4*)(ROW(p, k0, sr) + 4);                \
                            S.sf2 = *(const f32x4*)ROW(p, k0, 32 + sr); S.sf3 = *(const f32x4*)(ROW(p, k0, 32 + sr) + 4); } while (0)
#define SWRITE_KF(bf) do { *(bf16x8*)(K_lds + (bf) * SHM_K + kws) = pack8(S.sf0, S.sf1); *(bf16x8*)(K_lds + (bf) * SHM_K + kws + 32 * 256) = pack8(S.sf2, S.sf3); } while (0)
#define SWRITE_VF(bf) do { *(bf16x8*)(V_lds + (bf) * SHM_V + vst0) = pack8(S.sf0, S.sf1); *(bf16x8*)(V_lds + (bf) * SHM_V + vst1) = pack8(S.sf2, S.sf3); } while (0)
template <class TIn, class TOut>
__device__ __forceinline__ void causal_swa_prime(const BlockRef<TIn, TOut>& cur, int W, char* lds, Seam<TIn>& S) {
    constexpr bool F32 = same_t<TIn, float>::v;
    const int tid = opaque_tid(), wid = __builtin_amdgcn_readfirstlane(tid >> 6), lane = tid & 63, r32 = lane & 31, hi = lane >> 5;
    const int sr = tid >> 4, sc = (tid & 15) * 8, kws = KSWZ(sr, sc * 2); char* K_lds = lds + 2 * SHM_V;
    const int kb0 = swa_jlo(cur.P0, W) * KVBLK;
    for (int d0 = 0; d0 < 8; ++d0) S.qr[d0] = load8<TIn>(cur.Q + (size_t)(wid * QBLK + r32) * D + d0 * 16 + hi * 8);
    if constexpr (F32) { SLOAD_F((const float*)cur.K, kb0); VMW(); SWRITE_KF(0); SBAR(); SLOAD_F((const float*)cur.V, kb0); }
    else { SLOAD_H(cur.K, cur.V, kb0); VMW(); SWRITE_HK(0); }
    __syncthreads();
}
template <class TIn, class TOut>
__device__ __forceinline__ void causal_swa_block(const BlockRef<TIn, TOut>& cur, const BlockRef<TIn, TOut>& nxt, int skv, int W, char* lds, Seam<TIn>& S) {
    constexpr bool F32 = same_t<TIn, float>::v;
    const int tid = opaque_tid(), wid = __builtin_amdgcn_readfirstlane(tid >> 6), lane = tid & 63, r32 = lane & 31, hi = lane >> 5;
    const int j_lo = swa_jlo(cur.P0, W);
    int j_hi = (cur.P0 + QB - 1) / KVBLK + 1; if (j_hi > skv / KVBLK) j_hi = skv / KVBLK;
    const int NT = j_hi - j_lo;
    const int kbn = swa_jlo(nxt.P0, W) * KVBLK;
    const int qlo = cur.P0 + wid * QBLK, qm = qlo + r32 - 4 * hi;
    char* V_lds = lds; char* K_lds = lds + 2 * SHM_V;
    float* ws = (float*)(lds + 2 * SHM_V + 2 * SHM_K) + wid * 64; float* li_l = ws, * al_l = ws + 32;
    const float* cum = (const float*)(lds + CUM_OFF);
    float m_reg = -1e30f, l_reg = 0; f32x16 o[4] = {};
    const int sr = tid >> 4, sc = (tid & 15) * 8, vst0 = v_st(sr, sc), vst1 = v_st(32 + sr, sc), kws = KSWZ(sr, sc * 2);
    const int vb0 = (int)(uintptr_t)V_lds + v_rd_base(lane);
    const TIn* Kh = cur.K; const TIn* Vh = cur.V;
#define RESC(a) do { if (__any((a) < 1.f)) { if (hi == 0) al_l[r32] = (a); asm volatile("s_waitcnt lgkmcnt(0)" ::: "memory");              \
                     for (int d_ = 0; d_ < 4; ++d_) for (int r = 0; r < 16; ++r) o[d_][r] *= al_l[crow(r, hi)]; } } while (0)
#define KBASE(t) ((j_lo + (t)) * KVBLK)
#define CUMT(t) (cum + KBASE(t) + 4 * hi)
#define ACT(t) (KBASE(t) <= qlo + QBLK - 1 && KBASE(t) + KVBLK - 1 >= qlo - W + 1)
#define MASKT(P0_, P1_, t) do { const int kb_ = KBASE(t); if ((!SK || ACT(t)) && (kb_ + KVBLK - 1 > qlo || kb_ <= qlo + QBLK - 1 - W)) mask_tile(P0_, P1_, qm - kb_, (unsigned)W); } while (0)
    constexpr int NQL = F32 ? 16 : 8;
    constexpr bool SK = WSKIP && !F32;
#define SEAM_K0() do { VMWN(NQL); if constexpr (F32) { SWRITE_KF(0); SBAR(); SLOAD_F((const float*)nxt.V, kbn); } else { SWRITE_HK(0); } SBAR(); } while (0)
    f32x16 pA0, pA1, pB0, pB1; float mnA, mnB, alA, alB; bf16x8 pa0, pa1, pa2, pa3;
    if constexpr (F32) { VMW(); SWRITE_VF(0); SBAR(); } else { SWRITE_HV(0); SBAR(); }
    if (NT > 1) { if constexpr (F32) SLOAD_F((const float*)Kh, KBASE(1)); else SLOAD_H(Kh, Vh, KBASE(1)); }
    SBAR(); qkt<0, SK>(pA0, pA1, K_lds, r32, hi, S.qr, ACT(0), CUMT(0));
    if constexpr (F32) { if (NT > 1) { VMW(); SWRITE_KF(1); SBAR(); SLOAD_F((const float*)Vh, KBASE(1)); } }
    MASKT(pA0, pA1, 0); partialSM(pA0, pA1, m_reg, mnA, alA);
    if (NT > 1) { VMW(); if constexpr (F32) { SWRITE_VF(1); SBAR(); if (NT > 2) SLOAD_F((const float*)Kh, KBASE(2)); } else SWRITE_H(1); }
    __syncthreads();
#define HALF_STEP(PX0, PX1, mnX, alX, PY0, PY1, alY, t, KB, VB, SB) do {                                                      \
        SBAR(); qkt<KB, SK>(PX0, PX1, K_lds, r32, hi, S.qr, ACT(t), CUMT(t));                                             \
        finishSM(PY0, PY1, alY, l_reg, pa0, pa1, pa2, pa3); SBAR();                                                           \
        if ((t) + 1 < NT) { if constexpr (F32) { VMW(); SWRITE_KF(SB); SBAR(); SLOAD_F((const float*)Vh, KBASE((t) + 1)); }  \
                            else { SLOAD_H(Kh, Vh, KBASE((t) + 1)); } SBAR(); }                                               \
        pv_tile<VB, SK>(o, vb0, pa0, pa1, pa2, pa3, ACT((t) - 1)); MASKT(PX0, PX1, (t)); partialSM(PX0, PX1, m_reg, mnX, alX);                                        \
        __syncthreads();                                                                                                      \
        if ((t) + 1 < NT) { VMW(); if constexpr (F32) { SWRITE_VF(SB); SBAR(); if ((t) + 2 < NT) SLOAD_F((const float*)Kh, KBASE((t) + 2)); } \
                            else { SWRITE_H(SB); } }                                                                          \
        RESC(alX); __syncthreads(); } while (0)
    for (int t = 1; t + 1 < NT; t += 2) {
        HALF_STEP(pB0, pB1, mnB, alB, pA0, pA1, alA, t, 1, 0, 0);
        HALF_STEP(pA0, pA1, mnA, alA, pB0, pB1, alB, t + 1, 0, 1, 1);
    }
    const bool even = (NT & 1) == 0;
    if (even) { SBAR(); qkt<1, SK>(pB0, pB1, K_lds, r32, hi, S.qr, ACT(NT - 1), CUMT(NT - 1)); SBAR(); }
#define QROW(e) (nxt.Q + (size_t)(wid * QBLK + r32) * D + ((e) >> 1) * 16 + hi * 8 + ((e) & 1) * 4)
    if constexpr (F32) { SLOAD_F((const float*)nxt.K, kbn); SBAR();
#pragma unroll
        for (int e = 0; e < 8; ++e) S.tq[e] = *(const f32x4*)QROW(e); }
    else { SLOAD_H(nxt.K, nxt.V, kbn); SBAR();
#pragma unroll
        for (int d0 = 0; d0 < 8; ++d0) S.qr[d0] = load8<TIn>(nxt.Q + (size_t)(wid * QBLK + r32) * D + d0 * 16 + hi * 8); }
    SBAR();
    finishSM(pA0, pA1, alA, l_reg, pa0, pa1, pa2, pa3); SBAR();
    if constexpr (F32) {
#pragma unroll
        for (int e = 8; e < 16; ++e) S.tq[e] = *(const f32x4*)QROW(e); SBAR(); }
#undef QROW
    pv_tile<0, SK>(o, vb0, pa0, pa1, pa2, pa3, ACT(even ? NT - 2 : NT - 1));
    if (even) { MASKT(pB0, pB1, NT - 1); partialSM(pB0, pB1, m_reg, mnB, alB); __syncthreads(); RESC(alB);
        finishSM(pB0, pB1, alB, l_reg, pa0, pa1, pa2, pa3); SBAR(); pv_tile<1, SK>(o, vb0, pa0, pa1, pa2, pa3, ACT(NT - 1)); }
    SBAR(); SEAM_K0();
    if (hi == 0) li_l[r32] = l_reg; asm volatile("s_waitcnt lgkmcnt(0)" ::: "memory");
    float rli[16];
#pragma unroll
    for (int r = 0; r < 16; ++r) rli[r] = __builtin_amdgcn_rcpf(li_l[crow(r, hi)]);
    TOut* Ow = cur.O + (size_t)(wid * QBLK) * OST;
#pragma unroll
    for (int r = 0; r < 16; ++r) { const int orow = crow(r, hi);
#pragma unroll
        for (int d0 = 0; d0 < 4; ++d0) { const float v = o[d0][r] * rli[r];
            if constexpr (same_t<TOut, float>::v) { Ow[(size_t)orow * OST + d0 * 32 + r32] = v; }
            else { const float vn = __shfl_xor(v, 1);
                   if ((r32 & 1) == 0) *(unsigned*)(Ow + (size_t)orow * OST + d0 * 32 + r32) = cvtpk(v, vn); } } }
    if constexpr (F32) {
#pragma unroll
        for (int d0 = 0; d0 < 8; ++d0) S.qr[d0] = pack8(S.tq[2 * d0], S.tq[2 * d0 + 1]); }
    __syncthreads();
#undef RESC
#undef KBASE
#undef CUMT
#undef ACT
#undef MASKT
#undef SEAM_K0
#undef HALF_STEP
}
#undef ROW
#undef VMW
#undef VMWN
#undef SLOAD_H
#undef SWRITE_HK
#undef SWRITE_HV
#undef SWRITE_H
#undef SLOAD_F
#undef SWRITE_KF
#undef SWRITE_VF

constexpr int ATT_LDS = CUM_OFF + SKV * 4;
__device__ __forceinline__ int row_window(const float* a, int t, float bound) {
    const float thr = a[t] - bound * INV_SCALE;
    int lo = 0, hi = t + 1;
    while (lo < hi) { const int mid = (lo + hi) >> 1; if (a[mid] < thr) lo = mid + 1; else hi = mid; }
    return t - lo + 1;
}
__device__ __forceinline__ void attn_phase(char* lds, const bf16* FQ, const bf16* FK, const bf16* FV, const float* FLOGF, const float* qg, const float* kg, bf16* MERGED) {
    constexpr int NQB = SQ / QB, NX = NQB / 2, TOTAL = NX * H;
    if (blockIdx.x < TOTAL) { const int L = blockIdx.x;
        const int h = L / NX, x = L % NX, y = NQB - 1 - x;
        __syncthreads();
        float* cum = (float*)(lds + CUM_OFF);
        int W;
        { const int tid = opaque_tid(), lane = tid & 63;
          { const float* src = FLOGF + (size_t)h * SKV + tid * 16; float p[16]; float run = 0.f;
#pragma unroll
            for (int q = 0; q < 4; ++q) { const f32x4 v = *(const f32x4*)(src + 4 * q);
#pragma unroll
                for (int e = 0; e < 4; ++e) { run += v[e]; p[4 * q + e] = run; } }
            float inc = run;
#pragma unroll
            for (int o = 1; o < 64; o <<= 1) { const float u = __shfl_up(inc, o); if (lane >= o) inc += u; }
            float* wt = (float*)(lds + 2 * SHM_V + 2 * SHM_K);
            if (lane == 63) wt[tid >> 6] = inc;
            __syncthreads();
            float off = inc - run;
            for (int w8 = 0; w8 < (tid >> 6); ++w8) off += wt[w8];
#pragma unroll
            for (int q = 0; q < 4; ++q) *(f32x4*)(cum + tid * 16 + 4 * q) = (f32x4){(p[4 * q] + off) * (-INV_SCALE), (p[4 * q + 1] + off) * (-INV_SCALE), (p[4 * q + 2] + off) * (-INV_SCALE), (p[4 * q + 3] + off) * (-INV_SCALE)};
            __syncthreads(); }
          float gq = fmaxf(fabsf(qg[h * D + lane]), fabsf(qg[h * D + 64 + lane])), gk = fmaxf(fabsf(kg[h * D + lane]), fabsf(kg[h * D + 64 + lane]));
#pragma unroll
          for (int o = 1; o < 64; o <<= 1) { gq = fmaxf(gq, __shfl_xor(gq, o)); gk = fmaxf(gk, __shfl_xor(gk, o)); }
          const float bound = 2.f * INV_SCALE * gq * gk + 48.f;
          __syncthreads();
          int w = row_window(cum, ((tid >> 8) ? y : x) * QB + (tid & 255), bound);
#pragma unroll
          for (int o = 1; o < 64; o <<= 1) { const int w2 = __shfl_xor(w, o); w = w2 > w ? w2 : w; }
          int* wm = (int*)(lds + 2 * SHM_V + 2 * SHM_K);
          if (lane == 0) wm[tid >> 6] = w;
          __syncthreads();
          w = wm[0];
#pragma unroll
          for (int i = 1; i < 8; ++i) w = wm[i] > w ? wm[i] : w;
          w = (w + KVBLK - 1) & ~(KVBLK - 1); if (w > SKV) w = SKV;
          W = __builtin_amdgcn_readfirstlane(w);
          __syncthreads(); }
        BlockRef<bf16, bf16> b0, b1;
        const size_t hb = (size_t)h * SKV * D;
        b0.Q = FQ + hb + (size_t)x * QB * D; b0.K = FK + hb; b0.V = FV + hb; b0.O = MERGED + (size_t)x * QB * OST + h * D; b0.P0 = x * QB;
        b1.Q = FQ + hb + (size_t)y * QB * D; b1.K = FK + hb; b1.V = FV + hb; b1.O = MERGED + (size_t)y * QB * OST + h * D; b1.P0 = y * QB;
        Seam<bf16> S;
        causal_swa_prime<bf16, bf16>(b0, W, lds, S);
        BlockRef<bf16, bf16> cur = b0; int pass = 0;
        for (;;) { const bool last = pass == 1; const BlockRef<bf16, bf16> nxt = last ? cur : b1;
            causal_swa_block<bf16, bf16>(cur, nxt, SKV, W, lds, S);
            if (last) break; cur = nxt; pass = 1; }
    }
}
}
__device__ __forceinline__ void p_hgrn_seq(const bf16_t* HQ, const bf16_t* HK, const bf16_t* HV, const float* HLF, float* HO) {
    const int tid = opaque_tid(), lane = tid & 63, wave = tid >> 6;
    for (int it = blockIdx.x; it < NHEAD * 16; it += gridDim.x) {
        const int h = it >> 4, vc = (it & 15) * 8 + wave;
        const size_t hb = (size_t)h * T_ * HDIM;
        float Sa = 0.f, Sb = 0.f;
        for (int t0 = 0; t0 < T_; t0 += 8) {
            float fa[8], fb[8], ka[8], kb[8], qa[8], qb[8], vv[8];
#pragma unroll
            for (int i = 0; i < 8; ++i) { const size_t r = hb + (size_t)(t0 + i) * HDIM;
                fa[i] = HLF[r + lane]; fb[i] = HLF[r + lane + 64];
                ka[i] = bf2f(HK[r + lane]); kb[i] = bf2f(HK[r + lane + 64]);
                qa[i] = bf2f(HQ[r + lane]); qb[i] = bf2f(HQ[r + lane + 64]);
                vv[i] = bf2f(HV[r + vc]); }
            float p[8];
#pragma unroll
            for (int i = 0; i < 8; ++i) { Sa = expf(fa[i]) * Sa + ka[i] * vv[i]; Sb = expf(fb[i]) * Sb + kb[i] * vv[i]; p[i] = qa[i] * Sa + qb[i] * Sb; }
#pragma unroll
            for (int i = 0; i < 8; ++i) p[i] = wave_sum(p[i]);
            if (lane < 8) { float o = p[0];
#pragma unroll
                for (int i = 1; i < 8; ++i) o = (lane == i) ? p[i] : o;
                HO[hb + (size_t)(t0 + lane) * HDIM + vc] = o; }
        }
    }
}
__device__ __forceinline__ void p_hgrn_post(const float* HO, const bf16_t* HG, const float* og, bf16_t* MERGED) {
    const int tid = opaque_tid(), lane = tid & 63, wave = tid >> 6;
    for (int i = blockIdx.x * 8 + wave; i < T_ * NHEAD; i += gridDim.x * 8) {
        const int h = i / T_, t = i % T_, c = 2 * lane;
        const size_t r = ((size_t)h * T_ + t) * HDIM + c;
        const f32x2 o = *(const f32x2*)(HO + r);
        const float rs = rsqrtf(wave_sum(o[0] * o[0] + o[1] * o[1]) * (1.f / HDIM) + EPS_);
        const unsigned g = *(const unsigned*)(HG + r);
        const float g0 = bf2f(g & 0xffffu), g1 = bf2f(g >> 16);
        *(unsigned*)(MERGED + (size_t)t * DM + FOXW + h * HDIM + c) = pk2(o[0] * rs * og[h * HDIM + c] * g0, o[1] * rs * og[h * HDIM + c + 1] * g1);
    }
}
__device__ __forceinline__ void p_post2(unsigned char* lds, const float* x, const bf16_t* MIXG, const float* mod, const float* ada_b, const float* g2, bf16_t* X1B, bf16_t* H, unsigned char* H8, float* SH, int* HS) {
    float* A2 = (float*)lds; float* B2 = A2 + DM;
    const int tid = opaque_tid(), lane = tid & 63, wave = tid >> 6;
    for (int i = tid; i < DM; i += 512) { A2[i] = g2[i] * (1.f + mod[4 * DM + i] + ada_b[4 * DM + i]); B2[i] = mod[3 * DM + i] + ada_b[3 * DM + i]; }
    __syncthreads();
    for (int t = blockIdx.x * 8 + wave; t < T_; t += gridDim.x * 8) {
        const f32x4* xr = (const f32x4*)(x + (size_t)t * DM) + lane; const u32x2* mr = (const u32x2*)(MIXG + (size_t)t * DM) + lane;
        u32x2* orow = (u32x2*)(X1B + (size_t)t * DM) + lane;
        f32x4 v[16]; float ss = 0.f;
#pragma unroll
        for (int j = 0; j < 16; ++j) { const u32x2 m = mr[64 * j]; v[j] = xr[64 * j] + (f32x4){bf2f(m.x & 0xffffu), bf2f(m.x >> 16), bf2f(m.y & 0xffffu), bf2f(m.y >> 16)}; orow[64 * j] = (u32x2){pk2(v[j][0], v[j][1]), pk2(v[j][2], v[j][3])};
            ss += (v[j][0] * v[j][0] + v[j][1] * v[j][1]) + (v[j][2] * v[j][2] + v[j][3] * v[j][3]);
            if ((j & 3) == 3) asm volatile("" ::: "memory"); }
        const float rstd = rsqrtf(wave_sum(ss) * (1.f / DM) + EPS_);
        u32x2* o8 = (u32x2*)(H + (size_t)t * DM) + lane;
#pragma unroll
        for (int j = 0; j < 16; ++j) { const f32x4 a = *(const f32x4*)(A2 + 4 * lane + 256 * j), b = *(const f32x4*)(B2 + 4 * lane + 256 * j);
            const f32x4 hh = v[j] * rstd * a + b; u32x2 o = {pk2(hh[0], hh[1]), pk2(hh[2], hh[3])}; o8[64 * j] = o; v[j] = hh;
            if ((j & 3) == 3) asm volatile("" ::: "memory"); }
        float mx = 0.f;
#pragma unroll
        for (int j = 0; j < 16; ++j) mx = fmaxf(fmaxf(mx, fmaxf(fabsf(v[j][0]), fabsf(v[j][1]))), fmaxf(fabsf(v[j][2]), fabsf(v[j][3])));
#pragma unroll
        for (int o = 1; o < 64; o <<= 1) mx = fmaxf(mx, __shfl_xor(mx, o));
        const float sc = fmaxf(mx, 1e-30f) * (1.f / 119.f), inv = 1.f / sc;
        unsigned* h8 = (unsigned*)(H8 + (size_t)t * DM) + lane;
        int hs = 0;
#pragma unroll
        for (int j = 0; j < 16; ++j) { const int c0 = (int)rintf(v[j][0] * inv), c1 = (int)rintf(v[j][1] * inv), c2 = (int)rintf(v[j][2] * inv), c3 = (int)rintf(v[j][3] * inv);
            hs += (c0 + c1) + (c2 + c3);
            h8[64 * j] = (unsigned)(c0 & 0xff) | ((unsigned)(c1 & 0xff) << 8) | ((unsigned)(c2 & 0xff) << 16) | ((unsigned)(c3 & 0xff) << 24); }
#pragma unroll
        for (int o = 1; o < 64; o <<= 1) hs += __shfl_xor(hs, o);
        if (lane == 0) { SH[t] = sc; HS[t] = hs; }
    }
}
namespace hg {
typedef short bf16x8 __attribute__((ext_vector_type(8)));
constexpr int CH = 64, NG = 16;
__device__ __forceinline__ int grp_start(int g) { return g < 5 ? 9 * g : g < 11 ? 45 + 8 * (g - 5) : 93 + 7 * (g - 11); }
__device__ __forceinline__ int grp_count(int g) { return g < 5 ? 9 : g < 11 ? 8 : 7; }
constexpr int PA = 272, PB = 144;
constexpr int L_AQ = 0, L_BK = L_AQ + 64 * PA, L_KDT = L_BK + 64 * PA, L_VT = L_KDT + 128 * PB, L_P = L_VT + 128 * PB, L_ST = L_P + 64 * PB,
              L_SEG = L_ST + 128 * PA, L_BL = L_SEG + 8 * 128 * 4, L_END = L_BL + 512, L_OB = 0, POB = 528;
static_assert(64 * POB <= L_KDT && L_END <= 131072, "hgrn LDS map");
__device__ __forceinline__ bf16x8 frag(const unsigned char* base, int row, int pitch, int kk, int lane) { return *(const bf16x8*)(base + row * pitch + (kk * 32 + 8 * (lane >> 4)) * 2); }

struct ChunkRegs { float b0[8], b1[8]; unsigned kq[8], kk[8], kv[8]; };
template <bool FULL>
__device__ __forceinline__ void load_chunk(ChunkRegs& R, const bf16_t* HQ, const bf16_t* HK, const bf16_t* HV, const float* HLF, size_t base, int tid) {
    const int c0 = 2 * (tid & 63), g8 = tid >> 6;
    const size_t e0 = base + (size_t)(8 * g8) * HDIM + c0;
#pragma unroll
    for (int i = 0; i < 8; ++i) { const f32x2 l = *(const f32x2*)(HLF + e0 + i * HDIM); R.b0[i] = l[0]; R.b1[i] = l[1];
        R.kk[i] = *(const unsigned*)(HK + e0 + i * HDIM); R.kv[i] = *(const unsigned*)(HV + e0 + i * HDIM); if (FULL) R.kq[i] = *(const unsigned*)(HQ + e0 + i * HDIM); }
}
template <bool FULL>
__device__ __forceinline__ f32x2 stage_chunk(unsigned char* lds, ChunkRegs& R, int tid) {
    const int c0 = 2 * (tid & 63), g8 = tid >> 6;
    float (&b0)[8] = R.b0; float (&b1)[8] = R.b1; unsigned (&kq)[8] = R.kq; unsigned (&kk)[8] = R.kk; unsigned (&kv)[8] = R.kv;
#pragma unroll
    for (int i = 1; i < 8; ++i) { b0[i] += b0[i - 1]; b1[i] += b1[i - 1]; }
    float* seg = (float*)(lds + L_SEG);
    *(f32x2*)(seg + g8 * 128 + c0) = (f32x2){b0[7], b1[7]};
    __syncthreads();
    float off0 = 0.f, off1 = 0.f, tot0 = 0.f, tot1 = 0.f;
#pragma unroll
    for (int g = 0; g < 8; ++g) { const f32x2 s = *(const f32x2*)(seg + g * 128 + c0); if (g < g8) { off0 += s[0]; off1 += s[1]; } tot0 += s[0]; tot1 += s[1]; }
    if (g8 == 0) *(f32x2*)((float*)(lds + L_BL) + c0) = (f32x2){tot0, tot1};
    u32x4 kd0, kd1, vt0, vt1;
#pragma unroll
    for (int i = 0; i < 8; ++i) {
        const float ba = b0[i] + off0, bb = b1[i] + off1;
        const float k0 = bf2f(kk[i] & 0xffffu), k1 = bf2f(kk[i] >> 16);
        if (FULL) {
            const float ea = __expf(ba), eb = __expf(bb), ia = __expf(fminf(-ba, 80.f)), ib = __expf(fminf(-bb, 80.f));
            const int t = 8 * g8 + i;
            *(unsigned*)(lds + L_AQ + t * PA + c0 * 2) = pk2(bf2f(kq[i] & 0xffffu) * ea, bf2f(kq[i] >> 16) * eb);
            *(unsigned*)(lds + L_BK + t * PA + c0 * 2) = pk2(k0 * ia, k1 * ib);
        }
        const unsigned da = f2bf(k0 * __expf(tot0 - ba)), db = f2bf(k1 * __expf(tot1 - bb));
        const unsigned va = kv[i] & 0xffffu, vb = kv[i] >> 16;
        if (i & 1) { kd0[i >> 1] |= da << 16; kd1[i >> 1] |= db << 16; vt0[i >> 1] |= va << 16; vt1[i >> 1] |= vb << 16; }
        else { kd0[i >> 1] = da; kd1[i >> 1] = db; vt0[i >> 1] = va; vt1[i >> 1] = vb; }
    }
    *(u32x4*)(lds + L_KDT + c0 * PB + 16 * g8) = kd0; *(u32x4*)(lds + L_KDT + (c0 + 1) * PB + 16 * g8) = kd1;
    *(u32x4*)(lds + L_VT + c0 * PB + 16 * g8) = vt0; *(u32x4*)(lds + L_VT + (c0 + 1) * PB + 16 * g8) = vt1;
    return (f32x2){tot0, tot1};
}
__device__ __forceinline__ void state_update(const unsigned char* lds, f32x4 (&st)[8], int w, int lane) {
    const f32x4 bl = *(const f32x4*)((const float*)(lds + L_BL) + 16 * w + 4 * (lane >> 4));
    const f32x4 dec = {__expf(bl[0]), __expf(bl[1]), __expf(bl[2]), __expf(bl[3])};
    const bf16x8 a0 = frag(lds + L_KDT, 16 * w + (lane & 15), PB, 0, lane), a1 = frag(lds + L_KDT, 16 * w + (lane & 15), PB, 1, lane);
#pragma unroll
    for (int nv = 0; nv < 8; ++nv) {
        st[nv] = st[nv] * dec;
        st[nv] = __builtin_amdgcn_mfma_f32_16x16x32_bf16(a0, frag(lds + L_VT, 16 * nv + (lane & 15), PB, 0, lane), st[nv], 0, 0, 0);
        st[nv] = __builtin_amdgcn_mfma_f32_16x16x32_bf16(a1, frag(lds + L_VT, 16 * nv + (lane & 15), PB, 1, lane), st[nv], 0, 0, 0);
    }
}
__device__ __forceinline__ void pass_a(unsigned char* lds, const bf16_t* HK, const bf16_t* HV, const float* HLF, float* LST, float* BSUM) {
    const int tid = opaque_tid(), lane = tid & 63, w = __builtin_amdgcn_readfirstlane(tid >> 6);
    for (int it = blockIdx.x; it < NHEAD * (NG - 1); it += gridDim.x) {
        const int h = it / (NG - 1), g = it % (NG - 1);
        f32x4 st[8];
#pragma unroll
        for (int nv = 0; nv < 8; ++nv) st[nv] = (f32x4){0.f, 0.f, 0.f, 0.f};
        f32x2 bs = {0.f, 0.f};
        ChunkRegs R;
        const int c0g = grp_start(g), ncg = grp_count(g);
        load_chunk<false>(R, nullptr, HK, HV, HLF, ((size_t)h * T_ + (size_t)c0g * CH) * HDIM, tid);
        for (int ci = 0; ci < ncg; ++ci) {
            __syncthreads();
            bs += stage_chunk<false>(lds, R, tid);
            if (ci + 1 < ncg) load_chunk<false>(R, nullptr, HK, HV, HLF, ((size_t)h * T_ + (size_t)(c0g + ci + 1) * CH) * HDIM, tid);
            __syncthreads();
            state_update(lds, st, w, lane);
        }
        float* Lp = LST + ((size_t)(h * NG + g) * 128) * 128;
#pragma unroll
        for (int nv = 0; nv < 8; ++nv) *(f32x4*)(Lp + ((size_t)nv * 512 + w * 64 + lane) * 4) = st[nv];
        if (tid < 64) *(f32x2*)(BSUM + (size_t)(h * NG + g) * 128 + 2 * tid) = bs;
    }
}
__device__ __forceinline__ void pass_b(unsigned char* lds, const bf16_t* HQ, const bf16_t* HK, const bf16_t* HV, const bf16_t* HG, const float* HLF, const float* LST, const float* BSUM, const float* og, bf16_t* MERGED) {
    const int tid = opaque_tid(), lane = tid & 63, w = __builtin_amdgcn_readfirstlane(tid >> 6);
    for (int it = blockIdx.x; it < NHEAD * NG; it += gridDim.x) {
        const int h = it / NG, g = it % NG;
        f32x4 st[8];
#pragma unroll
        for (int nv = 0; nv < 8; ++nv) st[nv] = (f32x4){0.f, 0.f, 0.f, 0.f};
        for (int j = 0; j < g; ++j) {
            const float* Lp = LST + ((size_t)(h * NG + j) * 128) * 128;
            const f32x4 bl = *(const f32x4*)(BSUM + (size_t)(h * NG + j) * 128 + 16 * w + 4 * (lane >> 4));
            const f32x4 dec = {__expf(bl[0]), __expf(bl[1]), __expf(bl[2]), __expf(bl[3])};
#pragma unroll
            for (int nv = 0; nv < 8; ++nv) st[nv] = st[nv] * dec + *(const f32x4*)(Lp + ((size_t)nv * 512 + w * 64 + lane) * 4);
        }
        __syncthreads();
#pragma unroll
        for (int nv = 0; nv < 8; ++nv) *(u32x2*)(lds + L_ST + (16 * nv + (lane & 15)) * PA + (16 * w + 4 * (lane >> 4)) * 2) = (u32x2){pk2(st[nv][0], st[nv][1]), pk2(st[nv][2], st[nv][3])};
        ChunkRegs R;
        const int c0g = grp_start(g), ncg = grp_count(g);
        load_chunk<true>(R, HQ, HK, HV, HLF, ((size_t)h * T_ + (size_t)c0g * CH) * HDIM, tid);
        f32x4 gn4[4];
#pragma unroll
        for (int q = 0; q < 4; ++q) gn4[q] = *(const f32x4*)(og + h * HDIM + 16 * (tid & 7) + 4 * q);
        for (int ci = 0; ci < ncg; ++ci) {
            const int t0 = (c0g + ci) * CH;
            const size_t base = ((size_t)h * T_ + t0) * HDIM;
            stage_chunk<true>(lds, R, tid);
            if (ci + 1 < ncg) load_chunk<true>(R, HQ, HK, HV, HLF, base + (size_t)CH * HDIM, tid);
            const u32x4 ga = *(const u32x4*)(HG + base + (size_t)(tid >> 3) * HDIM + 16 * (tid & 7)), gb = *(const u32x4*)(HG + base + (size_t)(tid >> 3) * HDIM + 16 * (tid & 7) + 8);
            __syncthreads();
#pragma unroll
            for (int ii = 0; ii < 2; ++ii) { const int i = 2 * w + ii, ms = i >> 2, nt = i & 3;
                f32x4 acc = {0.f, 0.f, 0.f, 0.f};
                if (ms <= nt) {
#pragma unroll
                    for (int kk = 0; kk < 4; ++kk) acc = __builtin_amdgcn_mfma_f32_16x16x32_bf16(frag(lds + L_BK, 16 * ms + (lane & 15), PA, kk, lane), frag(lds + L_AQ, 16 * nt + (lane & 15), PA, kk, lane), acc, 0, 0, 0);
                }
                const int t = 16 * nt + (lane & 15), s0 = 16 * ms + 4 * (lane >> 4);
#pragma unroll
                for (int r = 0; r < 4; ++r) if (s0 + r > t) acc[r] = 0.f;
                *(u32x2*)(lds + L_P + t * PB + s0 * 2) = (u32x2){pk2(acc[0], acc[1]), pk2(acc[2], acc[3])};
            }
            __syncthreads();
            f32x4 o[4];
            { const int mt = w >> 1;
              const bf16x8 p0 = frag(lds + L_P, 16 * mt + (lane & 15), PB, 0, lane), p1 = frag(lds + L_P, 16 * mt + (lane & 15), PB, 1, lane);
              bf16x8 aq[4];
#pragma unroll
              for (int kk = 0; kk < 4; ++kk) aq[kk] = frag(lds + L_AQ, 16 * mt + (lane & 15), PA, kk, lane);
#pragma unroll
              for (int j = 0; j < 4; ++j) { const int nv = 4 * (w & 1) + j; f32x4 acc = {0.f, 0.f, 0.f, 0.f};
                  acc = __builtin_amdgcn_mfma_f32_16x16x32_bf16(p0, frag(lds + L_VT, 16 * nv + (lane & 15), PB, 0, lane), acc, 0, 0, 0);
                  acc = __builtin_amdgcn_mfma_f32_16x16x32_bf16(p1, frag(lds + L_VT, 16 * nv + (lane & 15), PB, 1, lane), acc, 0, 0, 0);
#pragma unroll
                  for (int kk = 0; kk < 4; ++kk) acc = __builtin_amdgcn_mfma_f32_16x16x32_bf16(aq[kk], frag(lds + L_ST, 16 * nv + (lane & 15), PA, kk, lane), acc, 0, 0, 0);
                  o[j] = acc; } }
            state_update(lds, st, w, lane);
            __syncthreads();
            { const int mt = w >> 1;
#pragma unroll
              for (int j = 0; j < 4; ++j)
#pragma unroll
                  for (int r = 0; r < 4; ++r) *(float*)(lds + L_OB + (16 * mt + 4 * (lane >> 4) + r) * POB + (16 * (4 * (w & 1) + j) + (lane & 15)) * 4) = o[j][r]; }
#pragma unroll
            for (int nv = 0; nv < 8; ++nv) *(u32x2*)(lds + L_ST + (16 * nv + (lane & 15)) * PA + (16 * w + 4 * (lane >> 4)) * 2) = (u32x2){pk2(st[nv][0], st[nv][1]), pk2(st[nv][2], st[nv][3])};
            __syncthreads();
            { const int t = tid >> 3, v0 = 16 * (tid & 7);
              f32x4 x[4]; float ss = 0.f;
#pragma unroll
              for (int q = 0; q < 4; ++q) { x[q] = *(const f32x4*)(lds + L_OB + t * POB + (v0 + 4 * q) * 4); ss += (x[q][0] * x[q][0] + x[q][1] * x[q][1]) + (x[q][2] * x[q][2] + x[q][3] * x[q][3]); }
              ss += __shfl_xor(ss, 1); ss += __shfl_xor(ss, 2); ss += __shfl_xor(ss, 4);
              const float rs = rsqrtf(ss * (1.f / HDIM) + EPS_);
              const unsigned gw[8] = {ga[0], ga[1], ga[2], ga[3], gb[0], gb[1], gb[2], gb[3]};
              unsigned ow[8];
#pragma unroll
              for (int q = 0; q < 4; ++q) { const f32x4 gn = gn4[q];
                  ow[2 * q] = pk2(x[q][0] * rs * gn[0] * bf2f(gw[2 * q] & 0xffffu), x[q][1] * rs * gn[1] * bf2f(gw[2 * q] >> 16));
                  ow[2 * q + 1] = pk2(x[q][2] * rs * gn[2] * bf2f(gw[2 * q + 1] & 0xffffu), x[q][3] * rs * gn[3] * bf2f(gw[2 * q + 1] >> 16)); }
              bf16_t* dst = MERGED + (size_t)(t0 + t) * DM + FOXW + h * HDIM + v0;
              *(u32x4*)dst = (u32x4){ow[0], ow[1], ow[2], ow[3]}; *(u32x4*)(dst + 8) = (u32x4){ow[4], ow[5], ow[6], ow[7]}; }
            __syncthreads();
        }
    }
}
}
__device__ __forceinline__ void p_scores(unsigned char* lds, const float* QP, const float* keys, float* SC) {
    float* Ks = (float*)lds;
    float* Qs = Ks + 128 * 132;
    const int tid = opaque_tid(), n = tid & 127, tq = tid >> 7;
    for (int it = blockIdx.x; it < 16 * (T_ / 64); it += gridDim.x) {
        const int hp = it % 16, t0 = (it / 16) * 64;
        __syncthreads();
        for (int i = tid; i < 128 * 32; i += 512) { const int r = i >> 5, c4 = i & 31; *(f32x4*)(Ks + r * 132 + 4 * c4) = *(const f32x4*)(keys + ((size_t)hp * 128 + r) * 128 + 4 * c4); }
        for (int i = tid; i < 64 * 32; i += 512) { const int r = i >> 5, c4 = i & 31; *(f32x4*)(Qs + r * 128 + 4 * c4) = *(const f32x4*)(QP + (size_t)(t0 + r) * PEER_QW + hp * 128 + 4 * c4); }
        __syncthreads();
        float acc[16];
#pragma unroll
        for (int j = 0; j < 16; ++j) acc[j] = 0.f;
        for (int d = 0; d < 128; d += 4) {
            const f32x4 kv = *(const f32x4*)(Ks + n * 132 + d);
#pragma unroll
            for (int j = 0; j < 16; ++j) { const f32x4 q = *(const f32x4*)(Qs + (tq * 16 + j) * 128 + d); acc[j] += (q[0] * kv[0] + q[1] * kv[1]) + (q[2] * kv[2] + q[3] * kv[3]); }
        }
#pragma unroll
        for (int j = 0; j < 16; ++j) SC[((size_t)(t0 + tq * 16 + j) * 16 + hp) * 128 + n] = acc[j];
    }
}
__device__ __forceinline__ unsigned fkey(float f) { const unsigned u = __builtin_bit_cast(unsigned, f); return (u & 0x80000000u) ? ~u : (u | 0x80000000u); }
__device__ __forceinline__ float fkey_inv(unsigned k) { const unsigned u = (k & 0x80000000u) ? (k & 0x7fffffffu) : ~k; return __builtin_bit_cast(float, u); }
__device__ __forceinline__ unsigned long long wave_max_u64(unsigned long long v) {
#pragma unroll
    for (int o = 1; o < 64; o <<= 1) { const unsigned lo = __shfl_xor((unsigned)v, o), hi = __shfl_xor((unsigned)(v >> 32), o); const unsigned long long w = ((unsigned long long)hi << 32) | lo; v = w > v ? w : v; }
    return v;
}
__device__ __forceinline__ void p_topk(const float* SC, int* PIDX, float* PGATE) {
    const int tid = opaque_tid(), lane = tid & 63, wave = tid >> 6;
    for (int i = blockIdx.x * 8 + wave; i < T_ * PEER_H; i += gridDim.x * 8) {
        const int t = i / PEER_H, h = i % PEER_H;
        float ts[2]; int ti[2];
#pragma unroll
        for (int p = 0; p < 2; ++p) {
            const float* s = SC + ((size_t)t * 16 + h * 2 + p) * 128;
            unsigned long long a = ((unsigned long long)fkey(s[lane]) << 32) | (unsigned)(127 - lane), b = ((unsigned long long)fkey(s[lane + 64]) << 32) | (unsigned)(127 - (lane + 64));
            float ms = 0.f; int mi = 0;
            for (int j = 0; j < 16; ++j) {
                const unsigned long long m = wave_max_u64(a > b ? a : b);
                if (a == m) a = 0ull; if (b == m) b = 0ull;
                if (lane == j) { ms = fkey_inv((unsigned)(m >> 32)); mi = 127 - (int)(m & 0xffffffffu); }
            }
            ts[p] = ms; ti[p] = mi;
        }
        unsigned long long cd[4];
#pragma unroll
        for (int c = 0; c < 4; ++c) { const int id = lane * 4 + c, ia = id >> 4, ib = id & 15;
            const float sa = __shfl(ts[0], ia), sb = __shfl(ts[1], ib); const int ea = __shfl(ti[0], ia), eb = __shfl(ti[1], ib);
            cd[c] = ((unsigned long long)fkey(sa + sb) << 32) | (unsigned)(0xffff - (ea * 128 + eb)); }
        float bs = 0.f; int be = 0;
        for (int j = 0; j < 16; ++j) {
            unsigned long long m = cd[0] > cd[1] ? cd[0] : cd[1]; const unsigned long long m2 = cd[2] > cd[3] ? cd[2] : cd[3]; m = m > m2 ? m : m2;
            m = wave_max_u64(m);
#pragma unroll
            for (int c = 0; c < 4; ++c) if (cd[c] == m) cd[c] = 0ull;
            if (lane == j) { bs = fkey_inv((unsigned)(m >> 32)); be = 0xffff - (int)(m & 0xffffffffu); }
        }
        const float mx = __shfl(bs, 0); float e = lane < 16 ? expf(bs - mx) : 0.f; const float den = wave_sum(e);
        if (lane < 16) { PIDX[(size_t)t * 128 + h * 16 + lane] = be; PGATE[(size_t)t * 128 + h * 16 + lane] = e / den; }
    }
}
__device__ __forceinline__ void p_expert_u(unsigned char* lds, const unsigned char* H8, const unsigned char* U4, const unsigned* PIDX, int* PD) {
    const int tid = opaque_tid(), lane = tid & 63, wave = tid >> 6, g = lane >> 4, n = lane & 15;
    const int xs = blockIdx.x & 7, tw = (blockIdx.x >> 3) * 8 + wave;
    int* eL = (int*)(lds + wave * 2048);
    const unsigned char* ub = U4 + (size_t)xs * PEER_NE * SLB + 16 * n;
    const unsigned char* hb = H8 + 512 * xs + 16 * n;
    unsigned ne = PIDX[(size_t)tw * 64 + lane];
    *(u32x2*)(eL + 2 * lane) = (u32x2){ne & 0xffffu, ne >> 16};
    ne = PIDX[(size_t)(tw + 256) * 64 + lane];
    u32x4 hlo_n = *(const u32x4*)(hb + (size_t)tw * DM), hhi_n = *(const u32x4*)(hb + (size_t)tw * DM + 256);
    u32x4 W[16]; int E[16];
#pragma unroll
    for (int s = 0; s < 16; ++s) { W[s] = *(const u32x4*)(ub + (size_t)eL[4 * s + g] * SLB); E[s] = eL[4 * (16 + s) + g]; }
#pragma unroll 1
    for (int k = 0; k < T_ / 256; ++k) {
        const int t = tw + 256 * k, cur = (k & 1) * 128, nxt = 128 - cur;
        *(u32x2*)(eL + nxt + 2 * lane) = (u32x2){ne & 0xffffu, ne >> 16};
        { const int t2 = tw + 256 * (k + 2 < T_ / 256 ? k + 2 : T_ / 256 - 1); ne = PIDX[(size_t)t2 * 64 + lane]; }
        u32x4 HA, HB;
#pragma unroll
        for (int c = 0; c < 4; ++c) {
            const unsigned l = hlo_n[c], h = hhi_n[c];
            HB[c] = (l & 0x0F0F0F0Fu) | ((h & 0x0F0F0F0Fu) << 4);
            HA[c] = ((((l >> 4) & 0x0F0F0F0Fu) + ((l >> 3) & 0x01010101u)) & 0x0F0F0F0Fu) | (((((h >> 4) & 0x0F0F0F0Fu) + ((h >> 3) & 0x01010101u)) & 0x0F0F0F0Fu) << 4);
        }
        { const int t1 = tw + 256 * (k + 1 < T_ / 256 ? k + 1 : T_ / 256 - 1); hlo_n = *(const u32x4*)(hb + (size_t)t1 * DM); hhi_n = *(const u32x4*)(hb + (size_t)t1 * DM + 256); }
        int* pd = PD + ((size_t)xs * T_ + t) * 128 + 4 * n + g;
#pragma unroll 1
        for (int hf = 0; hf < 2; ++hf) {
            int p[16];
#pragma unroll
            for (int i = 0; i < 16; ++i) {
                const u32x4 w = W[i]; int da = 0, db = 0;
#pragma unroll
                for (int c = 0; c < 4; ++c) { da = __builtin_amdgcn_sdot8((int)HA[c], (int)w[c], da, false); db = __builtin_amdgcn_sdot8((int)HB[c], (int)w[c], db, false); }
                p[i] = 16 * da + db;
                W[i] = *(const u32x4*)(ub + (size_t)E[i] * SLB);
                E[i] = eL[nxt + 4 * (16 * hf + i) + g];
            }
            int q8[8], q4[4], q2[2];
            { const bool hi = n & 8;
#pragma unroll
              for (int j = 0; j < 8; ++j) q8[j] = (hi ? p[j + 8] : p[j]) + __shfl_xor(hi ? p[j] : p[j + 8], 8); }
            { const bool hi = n & 4;
#pragma unroll
              for (int j = 0; j < 4; ++j) q4[j] = (hi ? q8[j + 4] : q8[j]) + __shfl_xor(hi ? q8[j] : q8[j + 4], 4); }
            { const bool hi = n & 2;
#pragma unroll
              for (int j = 0; j < 2; ++j) q2[j] = (hi ? q4[j + 2] : q4[j]) + __shfl_xor(hi ? q4[j] : q4[j + 2], 2); }
            { const bool hi = n & 1; pd[64 * hf] = (hi ? q2[1] : q2[0]) + __shfl_xor(hi ? q2[0] : q2[1], 1); }
        }
    }
}
__device__ __forceinline__ void p_expert_a(const float* SH, const int* HS, const float* SU, const float* SV, const unsigned short* PIDX, const float* PGATE, const int* PD, signed char* AQ, float* AF, int* AS) {
    const int tid = opaque_tid(), lane = tid & 63, wave = tid >> 6;
    for (int t = blockIdx.x * 8 + wave; t < T_; t += gridDim.x * 8) {
        const int hsum = HS[t]; const float sht = SH[t] * 0.5f;
        float av[2];
#pragma unroll
        for (int hh = 0; hh < 2; ++hh) {
            const int slot = lane + 64 * hh, e = PIDX[(size_t)t * 128 + slot];
            int ds = 0;
#pragma unroll
            for (int x = 0; x < 8; ++x) ds += PD[((size_t)x * T_ + t) * 128 + slot];
            const float d = (float)(2 * ds + hsum) * (SU[e] * sht);
            av[hh] = PGATE[(size_t)t * 128 + slot] * SV[e] * 0.5f * d * (1.f + erff(d * 0.70710678118654752f));
        }
        float amax = fmaxf(fabsf(av[0]), fabsf(av[1]));
#pragma unroll
        for (int o = 1; o < 64; o <<= 1) amax = fmaxf(amax, __shfl_xor(amax, o));
        amax = fmaxf(amax, 1e-37f);
        const float qsc = 127.f / amax;
        const int q0 = (int)rintf(av[0] * qsc), q1 = (int)rintf(av[1] * qsc);
        int qs = q0 + q1;
#pragma unroll
        for (int o = 1; o < 64; o <<= 1) qs += __shfl_xor(qs, o);
        AQ[(size_t)t * 128 + lane] = (signed char)q0; AQ[(size_t)t * 128 + 64 + lane] = (signed char)q1;
        if (lane == 0) { AF[t] = amax * (0.5f / 127.f); AS[t] = qs; }
    }
}
__device__ __forceinline__ void p_expert_v(unsigned char* lds, const unsigned char* V4, const unsigned* PIDX, const unsigned* AQ, const float* AF, const int* AS, const bf16_t* X1B, const float* mod, const float* ada_b, float* OUT) {
    const int tid = opaque_tid(), lane = tid & 63, wave = tid >> 6, g = lane >> 4, n = lane & 15;
    const int xs = blockIdx.x & 7, tw = (blockIdx.x >> 3) * 8 + wave;
    int* eL = (int*)(lds + wave * 2048);
    signed char* qL = (signed char*)(lds + wave * 2048 + 1024);
    const unsigned char* vb = V4 + (size_t)xs * PEER_NE * SLB + 16 * n;
    const int colb = 512 * xs + 16 * n + 4 * g;
    const f32x4 g2lo = *(const f32x4*)(mod + 5 * DM + colb) + *(const f32x4*)(ada_b + 5 * DM + colb), g2hi = *(const f32x4*)(mod + 5 * DM + colb + 256) + *(const f32x4*)(ada_b + 5 * DM + colb + 256);
    const int m0 = (n >> 2) == 0 ? -1 : 0, m1 = (n >> 2) == 1 ? -1 : 0, m2 = (n >> 2) == 2 ? -1 : 0, m3 = (n >> 2) == 3 ? -1 : 0;
    unsigned ne = PIDX[(size_t)tw * 64 + lane];
    *(u32x2*)(eL + 2 * lane) = (u32x2){ne & 0xffffu, ne >> 16};
    ne = PIDX[(size_t)(tw + 256) * 64 + lane];
    unsigned nq = AQ[(size_t)tw * 32 + (lane & 31)]; float nfa = AF[tw]; int nqs = AS[tw];
    u32x4 W[16]; int E[16];
#pragma unroll
    for (int s = 0; s < 16; ++s) { W[s] = *(const u32x4*)(vb + (size_t)eL[4 * s + g] * SLB); E[s] = eL[4 * (16 + s) + g]; }
#pragma unroll 1
    for (int k = 0; k < T_ / 256; ++k) {
        const int t = tw + 256 * k, cur = (k & 1) * 128, nxt = 128 - cur;
        *(u32x2*)(eL + nxt + 2 * lane) = (u32x2){ne & 0xffffu, ne >> 16};
        { const int t2 = tw + 256 * (k + 2 < T_ / 256 ? k + 2 : T_ / 256 - 1); ne = PIDX[(size_t)t2 * 64 + lane]; }
        if (lane < 32) ((unsigned*)qL)[lane] = nq;
        const float fa = nfa; const int qs = nqs;
        { const int t1 = tw + 256 * (k + 1 < T_ / 256 ? k + 1 : T_ / 256 - 1); nq = AQ[(size_t)t1 * 32 + (lane & 31)]; nfa = AF[t1]; nqs = AS[t1]; }
        f32x4* olo = (f32x4*)(OUT + (size_t)t * DM + colb); f32x4* ohi = (f32x4*)(OUT + (size_t)t * DM + colb + 256);
        const u32x2 blo = __builtin_nontemporal_load((const u32x2*)(X1B + (size_t)t * DM + colb)), bhi = __builtin_nontemporal_load((const u32x2*)(X1B + (size_t)t * DM + colb + 256));
        pg8::i32x4 acc[4];
#pragma unroll
        for (int i = 0; i < 4; ++i) acc[i] = (pg8::i32x4){0, 0, 0, 0};
#pragma unroll 1
        for (int it = 0; it < 2; ++it) {
            unsigned qa[16];
#pragma unroll
            for (int s = 0; s < 16; ++s) qa[s] = ((unsigned)(int)qL[4 * (16 * it + s) + g] & 0xffu) << (8 * (n & 3));
#pragma unroll
            for (int s = 0; s < 16; ++s) {
                const int i = 16 * it + s; const u32x4 w = W[s];
                const pg8::i32x4 A_ = {(int)qa[s] & m0, (int)qa[s] & m1, (int)qa[s] & m2, (int)qa[s] & m3};
                const u32x4 hi_ = w & 0xF0F0F0F0u;
                acc[2 * (s & 1)] = __builtin_amdgcn_mfma_i32_16x16x64_i8(A_, __builtin_bit_cast(pg8::i32x4, w), acc[2 * (s & 1)], 0, 0, 0);
                acc[2 * (s & 1) + 1] = __builtin_amdgcn_mfma_i32_16x16x64_i8(A_, __builtin_bit_cast(pg8::i32x4, hi_), acc[2 * (s & 1) + 1], 0, 0, 0);
                W[s] = *(const u32x4*)(vb + (size_t)E[s] * SLB);
                E[s] = eL[nxt + 4 * i + g];
            }
        }
        const pg8::i32x4 sh16 = acc[1] + acc[3], slo = acc[0] + acc[2] - sh16;
        const f32x4 xlo = {bf2f(blo.x & 0xffffu), bf2f(blo.x >> 16), bf2f(blo.y & 0xffffu), bf2f(blo.y >> 16)}, xhi = {bf2f(bhi.x & 0xffffu), bf2f(bhi.x >> 16), bf2f(bhi.y & 0xffffu), bf2f(bhi.y >> 16)};
        __builtin_nontemporal_store(xlo + g2lo * (f32x4){fa * (float)(2 * slo[0] - 15 * qs), fa * (float)(2 * slo[1] - 15 * qs), fa * (float)(2 * slo[2] - 15 * qs), fa * (float)(2 * slo[3] - 15 * qs)}, olo);
        __builtin_nontemporal_store(xhi + g2hi * (f32x4){fa * (float)((sh16[0] >> 3) + qs), fa * (float)((sh16[1] >> 3) + qs), fa * (float)((sh16[2] >> 3) + qs), fa * (float)((sh16[3] >> 3) + qs)}, ohi);
    }
}
namespace route {
typedef short bf16x8 __attribute__((ext_vector_type(8)));
constexpr int PK_ = 272, PQ_ = 528, PS_ = 1056;
constexpr int L_KB = 0, L_QT = L_KB + 2 * 128 * PK_, L_SC = L_QT + 32 * PQ_, L_WL = L_SC + 32 * PS_, L_END = L_WL + 8 * 1024;
static_assert(L_END <= 131072, "route LDS map");
__device__ __forceinline__ unsigned fkey(float f) { const unsigned u = __builtin_bit_cast(unsigned, f); return (u & 0x80000000u) ? ~u : (u | 0x80000000u); }
__device__ __forceinline__ float fkey_inv(unsigned k) { const unsigned u = (k & 0x80000000u) ? (k & 0x7fffffffu) : ~k; return __builtin_bit_cast(float, u); }
#define ROW_DPP(x_, ctrl_, bc_) __builtin_amdgcn_update_dpp(0, (x_), (ctrl_), 0xf, 0xf, (bc_))
__device__ __forceinline__ int row_sum(int c) {
    c += ROW_DPP(c, 0x128, false); c += ROW_DPP(c, 0x124, false); c += ROW_DPP(c, 0x122, false); c += ROW_DPP(c, 0x121, false); return c; }
__device__ __forceinline__ float row_sumf(float c) {
    c += __builtin_bit_cast(float, ROW_DPP(__builtin_bit_cast(int, c), 0x128, false)); c += __builtin_bit_cast(float, ROW_DPP(__builtin_bit_cast(int, c), 0x124, false));
    c += __builtin_bit_cast(float, ROW_DPP(__builtin_bit_cast(int, c), 0x122, false)); c += __builtin_bit_cast(float, ROW_DPP(__builtin_bit_cast(int, c), 0x121, false));
    return c; }
__device__ __forceinline__ int row_scan(int c) {
    c += ROW_DPP(c, 0x111, true); c += ROW_DPP(c, 0x112, true); c += ROW_DPP(c, 0x114, true); c += ROW_DPP(c, 0x118, true); return c; }
__device__ __forceinline__ unsigned row_maxu(unsigned c) { unsigned o;
    o = (unsigned)ROW_DPP((int)c, 0x128, false); c = o > c ? o : c; o = (unsigned)ROW_DPP((int)c, 0x124, false); c = o > c ? o : c;
    o = (unsigned)ROW_DPP((int)c, 0x122, false); c = o > c ? o : c; o = (unsigned)ROW_DPP((int)c, 0x121, false); c = o > c ? o : c; return c; }
__device__ __forceinline__ unsigned row_minu(unsigned c) { unsigned o;
    o = (unsigned)ROW_DPP((int)c, 0x128, false); c = o < c ? o : c; o = (unsigned)ROW_DPP((int)c, 0x124, false); c = o < c ? o : c;
    o = (unsigned)ROW_DPP((int)c, 0x122, false); c = o < c ? o : c; o = (unsigned)ROW_DPP((int)c, 0x121, false); c = o < c ? o : c; return c; }
template <int NV> __device__ __forceinline__ unsigned select16_row(unsigned (&key)[NV], unsigned& base) {
    unsigned lm = key[0];
#pragma unroll
    for (int v = 1; v < NV; ++v) lm = key[v] > lm ? key[v] : lm;
    const unsigned hi = row_maxu(lm), lo = row_minu(lm), b1 = (lo ? lo : 1u) - 1u, range = hi - b1;
    base = b1;
#pragma unroll
    for (int v = 0; v < NV; ++v) key[v] = (key[v] > b1 ? key[v] : b1) - b1;
    const int hb = 31 - __builtin_clz(range);
    unsigned prefix = 0u; bool done = false;
    int start = __builtin_amdgcn_readlane(hb, 0);
    { const int s1 = __builtin_amdgcn_readlane(hb, 16), s2 = __builtin_amdgcn_readlane(hb, 32), s3 = __builtin_amdgcn_readlane(hb, 48);
      start = s1 > start ? s1 : start; start = s2 > start ? s2 : start; start = s3 > start ? s3 : start; }
    for (int bit = start; bit >= 0; --bit) {
        const unsigned cand = prefix | (1u << bit); int c = 0;
#pragma unroll
        for (int v = 0; v < NV; ++v) c += (key[v] >= cand) ? 1 : 0;
        c = row_sum(c);
        const bool take = !done && c >= 16;
        prefix = take ? cand : prefix;
        done = done || (take && c == 16);
        if ((bit & 1) == 0 && __ballot(!done) == 0ull) break;
    }
    return prefix;
}
__device__ __forceinline__ void route_phase(unsigned char* lds, const bf16_t* QPB, const float* keys, unsigned short* PIDX, float* PGATE) {
    const int tid = opaque_tid(), lane = tid & 63, w = __builtin_amdgcn_readfirstlane(tid >> 6);
    const int h = blockIdx.x & 7;
    __syncthreads();
    for (int i = tid; i < 2 * 128 * 32; i += 512) { const int r = i >> 5, c4 = i & 31;
        const f32x4 k4 = *(const f32x4*)(keys + ((size_t)h * 256 + r) * 128 + 4 * c4);
        *(u32x2*)(lds + L_KB + r * PK_ + c4 * 8) = (u32x2){pk2(k4[0], k4[1]), pk2(k4[2], k4[3])}; }
    for (int tile = (blockIdx.x >> 3); tile < T_ / 32; tile += (gridDim.x >> 3)) {
        const int t0 = tile * 32;
        __syncthreads();
        { const int r = tid >> 4, c = tid & 15;
          const u32x4* src = (const u32x4*)(QPB + (size_t)(t0 + r) * PEER_QW + h * 256 + 16 * c);
          const u32x4 a = src[0], b = src[1];
          *(u32x4*)(lds + L_QT + r * PQ_ + c * 32) = a; *(u32x4*)(lds + L_QT + r * PQ_ + c * 32 + 16) = b; }
        __syncthreads();
#pragma unroll
        for (int p = 0; p < 2; ++p) {
            bf16x8 kb[4];
#pragma unroll
            for (int kk = 0; kk < 4; ++kk) kb[kk] = *(const bf16x8*)(lds + L_KB + (p * 128 + 16 * w + (lane & 15)) * PK_ + (kk * 32 + 8 * (lane >> 4)) * 2);
#pragma unroll
            for (int mt = 0; mt < 2; ++mt) { f32x4 acc = {0.f, 0.f, 0.f, 0.f};
#pragma unroll
                for (int kk = 0; kk < 4; ++kk) acc = __builtin_amdgcn_mfma_f32_16x16x32_bf16(*(const bf16x8*)(lds + L_QT + (16 * mt + (lane & 15)) * PQ_ + (p * 128 + kk * 32 + 8 * (lane >> 4)) * 2), kb[kk], acc, 0, 0, 0);
#pragma unroll
                for (int r = 0; r < 4; ++r) *(float*)(lds + L_SC + (16 * mt + 4 * (lane >> 4) + r) * PS_ + (p * 132 + 16 * w + (lane & 15)) * 4) = acc[r]; }
        }
        __syncthreads();
        unsigned char* wl = lds + L_WL + w * 1024 + (lane >> 4) * 256;
        const int li = lane & 15, t = t0 + 4 * w + (lane >> 4);
#pragma unroll
        for (int p = 0; p < 2; ++p) {
            const float* s = (const float*)(lds + L_SC + (4 * w + (lane >> 4)) * PS_ + p * 132 * 4);
            float sv[8]; unsigned key[8];
#pragma unroll
            for (int v = 0; v < 8; ++v) { sv[v] = s[li + 16 * v]; key[v] = fkey(sv[v]); }
            unsigned base_; const unsigned thr = select16_row<8>(key, base_); (void)base_;
            int cl = 0;
#pragma unroll
            for (int v = 0; v < 8; ++v) cl += (key[v] >= thr) ? 1 : 0;
            int pos = row_scan(cl) - cl;
#pragma unroll
            for (int v = 0; v < 8; ++v) if (key[v] >= thr) { if (pos < 16) *(u32x2*)(wl + p * 128 + pos * 8) = (u32x2){__builtin_bit_cast(unsigned, sv[v]), (unsigned)(li + 16 * v)}; ++pos; }
        }
        asm volatile("s_waitcnt lgkmcnt(0)" ::: "memory");
        {
            const u32x2 wa = *(const u32x2*)(wl + li * 8);
            float cs[16]; unsigned ck[16]; int ce[16];
#pragma unroll
            for (int v = 0; v < 16; ++v) { const u32x2 wb = *(const u32x2*)(wl + 128 + v * 8);
                cs[v] = __builtin_bit_cast(float, wa.x) + __builtin_bit_cast(float, wb.x); ck[v] = fkey(cs[v]); ce[v] = (int)(wa.y * 128u + wb.y); }
            unsigned base_; const unsigned thr = select16_row<16>(ck, base_);
            const unsigned thr0 = thr + base_;
            const float tf = (thr0 >= 0x00800000u && thr0 <= 0xFF7FFFFFu) ? fkey_inv(thr0) : 0.f;
            int cl = 0;
#pragma unroll
            for (int v = 0; v < 16; ++v) cl += (ck[v] >= thr) ? 1 : 0;
            int pos = row_scan(cl) - cl;
            float e[16]; int ps[16]; float es = 0.f;
#pragma unroll
            for (int v = 0; v < 16; ++v) { const bool in = ck[v] >= thr && pos < 16; e[v] = in ? __expf(cs[v] - tf) : 0.f; ps[v] = in ? pos : -1; if (ck[v] >= thr) ++pos; es += e[v]; }
            es = row_sumf(es);
            const float inv = 1.f / es;
#pragma unroll
            for (int v = 0; v < 16; ++v) if (ps[v] >= 0) { PIDX[(size_t)t * 128 + h * 16 + ps[v]] = (unsigned short)ce[v]; PGATE[(size_t)t * 128 + h * 16 + ps[v]] = e[v] * inv; }
        }
        asm volatile("s_waitcnt lgkmcnt(0)" ::: "memory");
    }
}
}
constexpr int LDS_SCRATCH = 147456, LDS_BYTES = LDS_SCRATCH + 256 + 8192;
struct Params { const float* in[17]; float* out; unsigned char* ws; };
__global__ void __launch_bounds__(512, 2) mega_fwd(Params P) {
    extern __shared__ __attribute__((aligned(16))) unsigned char lds[];
    volatile LAS unsigned* MISC = (volatile LAS unsigned*)((LAS unsigned char*)lds + LDS_SCRATCH);
    if (threadIdx.x < 64) MISC[threadIdx.x] = 0u;
    __syncthreads();
    typedef const __attribute__((address_space(4))) Params* KArgs;
#define KA() ({ KArgs _p = (KArgs)__builtin_amdgcn_kernarg_segment_ptr(); asm volatile("" : "+s"(_p)); _p; })
#define WSP(off) (KA()->ws + (off))
    XcdBarrier bar = xcd_barrier_post((unsigned*)WSP(WS_CTL), MISC + 8);
    p_convert(lds, KA()->in[6], KA()->in[12], KA()->in[13], nullptr, (bf16_t*)WSP(WS_WOUTT), (bf16_t*)WSP(WS_WQT), (float*)WSP(WS_WFT));
    __syncthreads();
    p_adaln(lds, KA()->in[1], KA()->in[2], (float*)WSP(CTL_MOD));
    p_colmax<DM>(KA()->in[12], (float*)WSP(WS_WOUTT + 17 * MiB));
    p_colmax<NIN>(KA()->in[6], (float*)WSP(WS_WINT + 64 * MiB));
    xcd_barrier(bar);
    p_quant_w<NIN, NPROJ, true>(lds, KA()->in[6], (float*)WSP(WS_WINT + 64 * MiB), WSP(WS_WINT), (float*)WSP(WS_WINT + 60 * MiB));
    __syncthreads();
    p_quant_w<DM, DM, false>(lds, KA()->in[12], (float*)WSP(WS_WOUTT + 17 * MiB), WSP(WS_WOUTT), (float*)WSP(WS_WOUTT + 16 * MiB));
    __syncthreads();
    p_norm1(lds, KA()->in[0], (float*)WSP(CTL_MOD), KA()->in[3], KA()->in[4], (float*)WSP(WS_WFT), KA()->in[7], WSP(WS_H), (float*)WSP(WS_WFT + 512 * 1024), (float*)WSP(WS_FLOGF));
    xcd_barrier(bar);
    { pg8::Gemm g{(bf16_t*)WSP(WS_H), (bf16_t*)WSP(WS_WINT), T_, NPROJ, DM / 2}; pg8::StaticOrder S; S.init(T_, NPROJ, (int)gridDim.x, (int)blockIdx.x);
      pg8::EpiInProjT<true> E{(bf16_t*)WSP(WS_FQ), (bf16_t*)WSP(WS_FK), (bf16_t*)WSP(WS_FV), (bf16_t*)WSP(WS_HQ), (bf16_t*)WSP(WS_HK), (bf16_t*)WSP(WS_HV), (bf16_t*)WSP(WS_HG), (float*)WSP(WS_HLF), KA()->in[8], KA()->in[9], KA()->in[10],
                              (float*)WSP(WS_WFT + 512 * 1024), (float*)WSP(WS_WINT + 60 * MiB), (PG8_LAS float*)((LAS unsigned char*)lds + LDS_SCRATCH + 256)};
      pg8::gemm_phase<pg8::EpiInProjT<true>, pg8::StaticOrder, false>((PG8_LAS unsigned char*)lds, g, S, E, nullptr); }
    xcd_barrier(bar);
    fox::attn_phase((char*)lds, (const fox::bf16*)(bf16_t*)WSP(WS_FQ), (const fox::bf16*)(bf16_t*)WSP(WS_FK), (const fox::bf16*)(bf16_t*)WSP(WS_FV), (float*)WSP(WS_FLOGF), KA()->in[8], KA()->in[9], (fox::bf16*)(bf16_t*)WSP(WS_MERGED));
    __syncthreads();
    hg::pass_a(lds, (bf16_t*)WSP(WS_HK), (bf16_t*)WSP(WS_HV), (float*)WSP(WS_HLF), (float*)WSP(WS_HO), (float*)WSP(WS_HO + 32 * MiB));
    __syncthreads();
    p_convert_uv4(lds, (unsigned*)WSP(WS_CTL + 32768), KA()->in[15], KA()->in[16], WSP(WS_UBF), (float*)WSP(WS_UBF + 64 * MiB), WSP(WS_VBF), (float*)WSP(WS_VBF + 64 * MiB));
    xcd_barrier(bar);
    hg::pass_b(lds, (bf16_t*)WSP(WS_HQ), (bf16_t*)WSP(WS_HK), (bf16_t*)WSP(WS_HV), (bf16_t*)WSP(WS_HG), (float*)WSP(WS_HLF), (float*)WSP(WS_HO), (float*)WSP(WS_HO + 32 * MiB), KA()->in[11], (bf16_t*)WSP(WS_MERGED));
    xcd_barrier(bar);
    p_quant_merged((bf16_t*)WSP(WS_MERGED), WSP(WS_FQ), (float*)WSP(WS_FK));
    xcd_barrier(bar);
    { pg8::Gemm g{(bf16_t*)WSP(WS_FQ), (bf16_t*)WSP(WS_WOUTT), T_, DM, DM / 2}; pg8::StaticOrder S; S.init(T_, DM, (int)gridDim.x, (int)blockIdx.x);
      pg8::EpiMixBf16T<true> E{(bf16_t*)WSP(WS_PROJ), (float*)WSP(CTL_MOD), KA()->in[3], (float*)WSP(WS_FK), (float*)WSP(WS_WOUTT + 16 * MiB)};
      pg8::gemm_phase<pg8::EpiMixBf16T<true>, pg8::StaticOrder, false>((PG8_LAS unsigned char*)lds, g, S, E, nullptr); }
    xcd_barrier(bar);
    p_post2(lds, KA()->in[0], (bf16_t*)WSP(WS_PROJ), (float*)WSP(CTL_MOD), KA()->in[3], KA()->in[5], (bf16_t*)WSP(WS_MERGED), (bf16_t*)WSP(WS_H), WSP(WS_PROJ + 256 * MiB), (float*)WSP(WS_PROJ + 320 * MiB), (int*)WSP(WS_PROJ + 320 * MiB + 65536));
    xcd_barrier(bar);
    { pg8::Gemm g{(bf16_t*)WSP(WS_H), (bf16_t*)WSP(WS_WQT), T_, PEER_QW, DM}; pg8::StaticOrder S; S.init(T_, PEER_QW, (int)gridDim.x, (int)blockIdx.x); pg8::EpiBf16<0> E{(bf16_t*)WSP(WS_QP), PEER_QW, nullptr, 0, 0};
      pg8::gemm_phase<pg8::EpiBf16<0>, pg8::StaticOrder, false>((PG8_LAS unsigned char*)lds, g, S, E, nullptr); }
    xcd_barrier(bar);
    route::route_phase(lds, (bf16_t*)WSP(WS_QP), KA()->in[14], (unsigned short*)WSP(WS_PIDX), (float*)WSP(WS_PGATE));
    xcd_barrier(bar);
    p_expert_u(lds, WSP(WS_PROJ + 256 * MiB), WSP(WS_UBF), (unsigned*)WSP(WS_PIDX), (int*)WSP(WS_FQ));
    xcd_barrier(bar);
    p_expert_a((float*)WSP(WS_PROJ + 320 * MiB), (int*)WSP(WS_PROJ + 320 * MiB + 65536), (float*)WSP(WS_UBF + 64 * MiB), (float*)WSP(WS_VBF + 64 * MiB), (unsigned short*)WSP(WS_PIDX), (float*)WSP(WS_PGATE), (int*)WSP(WS_FQ),
               (signed char*)WSP(WS_FK), (float*)WSP(WS_FK + 2 * MiB), (int*)WSP(WS_FK + 3 * MiB));
    xcd_barrier(bar);
    p_expert_v(lds, WSP(WS_VBF), (unsigned*)WSP(WS_PIDX), (unsigned*)WSP(WS_FK), (float*)WSP(WS_FK + 2 * MiB), (int*)WSP(WS_FK + 3 * MiB), (bf16_t*)WSP(WS_MERGED), (float*)WSP(CTL_MOD), KA()->in[3], KA()->out);
}

extern "C" void kernel_launch(void* const* d_in, const int* in_sizes, int n_in, void* d_out, int out_size, void* d_ws, size_t ws_size, hipStream_t stream) {
    static int grid = 0;
    if (!grid) {
        if (n_in != 17 || in_sizes[0] != T_ * DM || out_size != T_ * DM || ws_size < WS_END) { fprintf(stderr, "kernel_launch: unexpected shapes (n_in %d, in0 %d, out %d, ws %zu < %zu)\n", n_in, n_in > 0 ? in_sizes[0] : -1, out_size, ws_size, (size_t)WS_END); grid = -1; return; }
        int dev = 0, cus = 0, per_cu = 0; (void)hipGetDevice(&dev); (void)hipDeviceGetAttribute(&cus, hipDeviceAttributeMultiprocessorCount, dev);
        if (hipFuncSetAttribute((const void*)mega_fwd, hipFuncAttributeMaxDynamicSharedMemorySize, LDS_BYTES) != hipSuccess) { fprintf(stderr, "kernel_launch: hipFuncSetAttribute failed\n"); grid = -1; return; }
        (void)hipOccupancyMaxActiveBlocksPerMultiprocessor(&per_cu, mega_fwd, 512, LDS_BYTES);
        if (cus != 256 || per_cu < 1) { fprintf(stderr, "kernel_launch: built for 256 CUs with one resident workgroup each (got %d CUs, %d per CU)\n", cus, per_cu); grid = -1; return; }
        grid = cus;
    }
    if (grid < 0) return;
    Params P{};
    for (int i = 0; i < 17; ++i) P.in[i] = (const float*)d_in[i];
    P.out = (float*)d_out; P.ws = (unsigned char*)d_ws;
    (void)hipMemsetAsync((unsigned char*)d_ws + WS_CTL, 0, CTL_ZERO_BYTES, stream);
    hipLaunchKernelGGL(mega_fwd, dim3(grid), dim3(512), LDS_BYTES, stream, P);
}
```

```cpp
#include <hip/hip_runtime.h>
#include <hip/hip_bf16.h>
#include <cstdio>
#include <cstdint>
#include <type_traits>

constexpr int T_ = 8192, DM = 4096, NIN = 14352, NPROJ = 14336, FOXW = 2048, HGW = 2048, NHEAD = 16, HDIM = 128;
constexpr int PEER_H = 8, PEER_K = 128, PEER_TOP = 16, PEER_QW = 2048, PEER_NE = 16384;
constexpr float EPS_ = 1e-6f;

constexpr size_t MiB = 1u << 20;
constexpr size_t WS_CTL = 0, CTL_ZERO_BYTES = 256 * 1024;
constexpr size_t CTL_CMAX = 163840;
constexpr size_t CTL_MOD = 65536;
constexpr size_t WS_WINT = 2 * MiB;
constexpr size_t WS_WOUTT = WS_WINT + 112 * MiB;
constexpr size_t WS_WQT = WS_WOUTT + 32 * MiB;
constexpr size_t WS_WFT = WS_WQT + 16 * MiB;
constexpr size_t WS_UBF = WS_WFT + 1 * MiB;
constexpr size_t WS_VBF = WS_UBF + 128 * MiB;
constexpr size_t WS_H = WS_VBF + 128 * MiB;
constexpr size_t WS_FLOGF = WS_H + 64 * MiB;
constexpr size_t WS_FCUM = WS_FLOGF + 512 * 1024;
constexpr size_t WS_FQ = WS_FLOGF + 1 * MiB;
constexpr size_t WS_FK = WS_FQ + 32 * MiB;
constexpr size_t WS_FV = WS_FK + 32 * MiB;
constexpr size_t WS_HQ = WS_FV + 32 * MiB;
constexpr size_t WS_HK = WS_HQ + 32 * MiB;
constexpr size_t WS_HV = WS_HK + 32 * MiB;
constexpr size_t WS_HG = WS_HV + 32 * MiB;
constexpr size_t WS_HLF = WS_HG + 32 * MiB;
constexpr size_t WS_HO = WS_HLF + 64 * MiB;
constexpr size_t WS_MERGED = WS_HO + 64 * MiB;
constexpr size_t WS_QP = WS_MERGED + 64 * MiB;
constexpr size_t WS_SC = WS_QP + 64 * MiB;
constexpr size_t WS_PIDX = WS_SC + 64 * MiB;
constexpr size_t WS_PGATE = WS_PIDX + 4 * MiB;
constexpr size_t WS_PROJ = WS_PGATE + 4 * MiB;
constexpr size_t WS_PMOD = WS_WINT + 72 * MiB;
constexpr size_t WS_END = WS_PROJ + 448 * MiB;

typedef unsigned short bf16_t;
typedef float f32x4 __attribute__((ext_vector_type(4)));
typedef float f32x2 __attribute__((ext_vector_type(2)));
typedef unsigned u32x4 __attribute__((ext_vector_type(4)));
typedef unsigned u32x2 __attribute__((ext_vector_type(2)));
#define LAS __attribute__((address_space(3)))

__device__ __forceinline__ unsigned f2bf(float f) { unsigned u = __builtin_bit_cast(unsigned, f); return (u + 0x7fffu + ((u >> 16) & 1u)) >> 16; }
__device__ __forceinline__ unsigned pk2(float lo, float hi) { return f2bf(lo) | (f2bf(hi) << 16); }
__device__ __forceinline__ float bf2f(unsigned b) { return __builtin_bit_cast(float, b << 16); }
__device__ __forceinline__ float wave_sum(float v) {
#pragma unroll
    for (int o = 1; o < 64; o <<= 1) v += __shfl_xor(v, o);
    return v;
}
__device__ __forceinline__ float silu_f(float x) { return x / (1.f + __expf(-x)); }
__device__ __forceinline__ float sigmoid_f(float x) { return 1.f / (1.f + __expf(-x)); }
__device__ __forceinline__ int opaque_tid() { int t = threadIdx.x; asm volatile("" : "+v"(t)); return t; }
#define XB_TMO      128
#define XB_XCNT(j)  (256  + 64 * (j))
#define XB_XSUB(j)  (1280 + 64 * (j))
#define XB_XGEN(j)  (2304 + 64 * (j))
#define XB_TOP      3328
#define XB_TOPGEN   3392
#define XCD_BAR_WORDS 3456
#define XB_SPIN_CAP (1u << 18)

__device__ __forceinline__ unsigned xb_ld(unsigned* p)              { return __hip_atomic_load(p, __ATOMIC_RELAXED, __HIP_MEMORY_SCOPE_AGENT); }
__device__ __forceinline__ unsigned xb_add(unsigned* p, unsigned v) { return __hip_atomic_fetch_add(p, v, __ATOMIC_RELAXED, __HIP_MEMORY_SCOPE_AGENT); }
__device__ __forceinline__ unsigned xb_xcc_id() { return (unsigned)__builtin_amdgcn_s_getreg((3 << 11) | 20) & 0xFu; }
#define XB_SPIN(cond, bar) do { unsigned _sp = 0; while (cond) { __builtin_amdgcn_s_sleep(1); \
    if ((++_sp & 255u) == 0u) { if (xb_ld(&(bar)[XB_TMO])) break; if (_sp > XB_SPIN_CAP) { atomicAdd(&(bar)[XB_TMO], 1u); break; } } } } while (0)

struct XcdBarrier {
    unsigned* bar; unsigned x;
    volatile LAS unsigned* st;
};

__device__ __forceinline__ XcdBarrier xcd_barrier_post(unsigned* bar, volatile LAS unsigned* st) {
    XcdBarrier b; b.bar = bar; b.x = xb_xcc_id(); b.st = st;
    if (threadIdx.x == 0) (void)xb_add(&bar[XB_XCNT(b.x)], 1u);
    return b;
}
__device__ __forceinline__ void xcd_barrier_complete(unsigned* bar, unsigned x, unsigned& nloc, unsigned& nx) {
    const unsigned G = gridDim.x * gridDim.y * gridDim.z;
    unsigned sum, cnt, mine, sp = 0u;
    for (;;) {
        sum = 0u; cnt = 0u; mine = 0u;
#pragma unroll
        for (unsigned j = 0; j < 16; ++j) { const unsigned c = xb_ld(&bar[XB_XCNT(j)]); sum += c; cnt += (c > 0u) ? 1u : 0u; mine = (j == x) ? c : mine; }
        if (sum == G) break;
        __builtin_amdgcn_s_sleep(1);
        if ((++sp & 255u) == 0u) { if (xb_ld(&bar[XB_TMO])) break; if (sp > XB_SPIN_CAP) { atomicAdd(&bar[XB_TMO], 1u); break; } }
    }
    nloc = mine > 0u ? mine : 1u; nx = cnt > 0u ? cnt : 1u;
}

__device__ __forceinline__ void xcd_barrier(const XcdBarrier& b) {
    asm volatile("s_waitcnt vmcnt(0)" ::: "memory");
    __syncthreads();
    if (threadIdx.x == 0) {
        unsigned* bar = b.bar;
        __builtin_amdgcn_s_waitcnt(0);
        unsigned nloc = b.st[0], nx = b.st[1];
        if (nloc == 0u) { xcd_barrier_complete(bar, b.x, nloc, nx); b.st[0] = nloc; b.st[1] = nx; }
        const unsigned old = xb_add(&bar[XB_XSUB(b.x)], 1u);
        const unsigned gen = old / nloc;
        if (old + 1u == (gen + 1u) * nloc) {
            __builtin_amdgcn_fence(__ATOMIC_RELEASE, "agent");
            asm volatile("s_waitcnt vmcnt(0)" ::: "memory");
            const unsigned og = xb_add(&bar[XB_TOP], 1u);
            const unsigned tg = og / nx;
            if (og + 1u == (tg + 1u) * nx) xb_add(&bar[XB_TOPGEN], 1u);
            else XB_SPIN(xb_ld(&bar[XB_TOPGEN]) == tg, bar);
            __builtin_amdgcn_fence(__ATOMIC_ACQUIRE, "agent");
            xb_add(&bar[XB_XGEN(b.x)], 1u);
            asm volatile("s_waitcnt vmcnt(0)" ::: "memory");
        } else {
            XB_SPIN(xb_ld(&bar[XB_XGEN(b.x)]) == gen, bar);
            __builtin_amdgcn_fence(__ATOMIC_ACQUIRE, "agent");
            asm volatile("s_waitcnt vmcnt(0)" ::: "memory");
        }
    }
    __syncthreads();
}
namespace pg8 {
#define PG8_LAS __attribute__((address_space(3)))
typedef unsigned short bf16_t;
typedef short bf16x8 __attribute__((ext_vector_type(8)));
typedef float f32x4 __attribute__((ext_vector_type(4)));
typedef unsigned u32x4 __attribute__((ext_vector_type(4)));
typedef int i32x4 __attribute__((ext_vector_type(4)));
constexpr int BM = 256, BK = 64, HALF = 128, HTB = HALF * BK * 2  , STAGE_BYTES = 8 * HTB, NXCD = 8, WGM = 8;

__host__ __device__ __forceinline__ int lds_byte(int r, int c) { const int st = (r >> 4) * 2 + (c >> 5), rr = r & 15, cc = c & 31, ob = rr * 64 + cc * 2; return st * 1024 + (ob ^ (((ob >> 9) & 1) << 5)); }
__host__ __device__ __forceinline__ void stage_rc(int b, int& R, int& C) { const int st = b / 1024, sb = b % 1024, swz = sb ^ (((sb >> 9) & 1) << 5); R = (st >> 1) * 16 + swz / 64; C = (st & 1) * 32 + (swz % 64) / 2; }
__host__ __device__ __forceinline__ int perm32(int rho) { const int n = rho >> 4, i = rho & 15; return 8 * (i >> 2) + 4 * n + (i & 3); }

struct Unit { int pm, pn; };
struct Gemm { const bf16_t* A; const bf16_t* Bt; int M, N, K; };

struct StaticOrder {
    int nM, nN, nwg, G, c;
    __host__ __device__ void init(int M, int N, int G_, int c_) { nM = M / BM; nN = N / BM; nwg = nM * nN; G = G_; c = c_; }
    __host__ __device__ bool next(int i, Unit& u) const {
        const long L = (long)i * G + c; if (L >= nwg) return false;
        int wgid = (int)L; { const int q = nwg / NXCD, r = nwg % NXCD, xcd = wgid % NXCD, off = wgid / NXCD; wgid = (xcd < r ? xcd * (q + 1) : r * (q + 1) + (xcd - r) * q) + off; }
        const int nig = WGM * nN, gid = wgid / nig, fm = gid * WGM, gsz = (nM - fm) < WGM ? (nM - fm) : WGM;
        u.pm = fm + ((wgid % nig) % gsz); u.pn = (wgid % nig) / gsz; return true;
    }
    __device__ __forceinline__ void a_ready(const Unit&) const {}
    __device__ __forceinline__ void done(const Unit&) const {}
};
__device__ __forceinline__ unsigned cvt_pk_bf16(float lo, float hi) { unsigned r; asm volatile("v_cvt_pk_bf16_f32 %0, %1, %2" : "=v"(r) : "v"(lo), "v"(hi)); return r; }
typedef float f32x2 __attribute__((ext_vector_type(2)));
__device__ __forceinline__ f32x2 gelu_pk(f32x2 v) {
    const f32x2 av = __builtin_elementwise_abs(v), d = av * 0.2316418882f + 1.0f;
    f32x2 t; t.x = __builtin_amdgcn_rcpf(d.x); t.y = __builtin_amdgcn_rcpf(d.y);
    f32x2 q = t * 0.5307027145f + (-0.7265760135f); q = q * t + 0.7107068705f; q = q * t + (-0.142248368f); q = q * t + 0.127414796f; q = q * t;
    const f32x2 s = (v * v) * (-0.72134752044f);
    f32x2 e; e.x = __builtin_amdgcn_exp2f(s.x); e.y = __builtin_amdgcn_exp2f(s.y);
    const f32x2 m = v * (q * e), r = v - m;
    f32x2 o; o.x = v.x < 0.f ? m.x : r.x; o.y = v.y < 0.f ? m.y : r.y; return o;
}

struct EpiF32 {
    static constexpr bool PERM = false, AFTER_DRAIN = false, I8 = false; typedef f32x4 acc_t;
    float* C; int ldc; const float* bias;
    __device__ __forceinline__ void operator()(const f32x4 (&acc)[2][2][4][2], const Unit& u, int wr, int wc, int fr, int fq) const {
        const int row0 = u.pm * BM + wr * 64 + fr, col0 = u.pn * BM + wc * 32 + 4 * fq;
        f32x4 bv[2][2];
#pragma unroll
        for (int bj = 0; bj < 2; ++bj)
#pragma unroll
            for (int n = 0; n < 2; ++n) bv[bj][n] = bias ? *(const f32x4*)(bias + col0 + bj * HALF + n * 16) : (f32x4){0.f, 0.f, 0.f, 0.f};
#pragma unroll
        for (int ai = 0; ai < 2; ++ai)
#pragma unroll
            for (int m = 0; m < 4; ++m) { float* rowp = C + (size_t)(row0 + ai * HALF + m * 16) * ldc + col0;
#pragma unroll
                for (int bj = 0; bj < 2; ++bj)
#pragma unroll
                    for (int n = 0; n < 2; ++n) *(f32x4*)(rowp + bj * HALF + n * 16) = acc[ai][bj][m][n] + bv[bj][n]; }
    }
};
template <int ACT  > struct EpiBf16 {
    static constexpr bool PERM = true, AFTER_DRAIN = false, I8 = false; typedef f32x4 acc_t;
    bf16_t* O; int ldc; const float* bias; int split_cols; size_t split_stride;
    __device__ __forceinline__ void operator()(const f32x4 (&acc)[2][2][4][2], const Unit& u, int wr, int wc, int fr, int fq) const {
        const int row0 = u.pm * BM + wr * 64 + fr; int colt = u.pn * BM; bf16_t* base = O;
        if (split_cols) { const int t = colt / split_cols; base += (size_t)t * split_stride; colt -= t * split_cols; }
        const int col0 = colt + wc * 32 + 8 * fq, bcol0 = u.pn * BM + wc * 32 + 8 * fq;
        f32x4 bv[2][2];
#pragma unroll
        for (int bj = 0; bj < 2; ++bj)
#pragma unroll
            for (int n = 0; n < 2; ++n) bv[bj][n] = bias ? *(const f32x4*)(bias + bcol0 + bj * HALF + 4 * n) : (f32x4){0.f, 0.f, 0.f, 0.f};
#pragma unroll
        for (int ai = 0; ai < 2; ++ai)
#pragma unroll
            for (int m = 0; m < 4; ++m) { bf16_t* rowp = base + (size_t)(row0 + ai * HALF + m * 16) * ldc + col0;
#pragma unroll
                for (int bj = 0; bj < 2; ++bj) { f32x4 v0 = acc[ai][bj][m][0] + bv[bj][0], v1 = acc[ai][bj][m][1] + bv[bj][1];
                    if (ACT == 1) { f32x2 a = gelu_pk((f32x2){v0[0], v0[1]}), b = gelu_pk((f32x2){v0[2], v0[3]}), c = gelu_pk((f32x2){v1[0], v1[1]}), d = gelu_pk((f32x2){v1[2], v1[3]});
                        v0 = (f32x4){a.x, a.y, b.x, b.y}; v1 = (f32x4){c.x, c.y, d.x, d.y}; }
                    if (ACT == 2) {
#pragma unroll
                        for (int j = 0; j < 4; ++j) { v0[j] = 0.5f * v0[j] * (1.0f + erff(v0[j] * 0.70710678f)); v1[j] = 0.5f * v1[j] * (1.0f + erff(v1[j] * 0.70710678f)); } }
                    u32x4 w; w.x = cvt_pk_bf16(v0[0], v0[1]); w.y = cvt_pk_bf16(v0[2], v0[3]); w.z = cvt_pk_bf16(v1[0], v1[1]); w.w = cvt_pk_bf16(v1[2], v1[3]);
                    *(u32x4*)(rowp + bj * HALF) = w; } }
    }
};

template <class Epi, class Sched, bool STAMP = false>
__device__ __forceinline__ void gemm_phase(PG8_LAS unsigned char* lds, const Gemm g, const Sched& S, const Epi& E, unsigned long long* stamps) {
    const int tid = opaque_tid(), wid = __builtin_amdgcn_readfirstlane(tid >> 6), lane = tid & 63, wr = wid >> 2, wc = wid & 3, fr = lane & 15, fq = lane >> 4;
    const int K = g.K, nt = K / BK;
    int ts_lo = 0, ts_hi = 0, nts = 0; const unsigned long long rt_entry = STAMP ? (unsigned long long)wall_clock64() : 0ull;
#define PG8_STAMP() do { if (STAMP && wid == 0 && nts < 64) { const unsigned long long _c = (unsigned long long)clock64(); \
        ts_lo = (lane == nts) ? (int)(unsigned)_c : ts_lo; ts_hi = (lane == nts) ? (int)(unsigned)(_c >> 32) : ts_hi; ++nts; } } while (0)
    PG8_STAMP();
    unsigned voffA[2], voffB[2];
#pragma unroll
    for (int i = 0; i < 2; ++i) { int R, C; stage_rc(tid * 16 + i * 8192, R, C); const int Rb = Epi::PERM ? ((R & ~31) + perm32(R & 31)) : R;
        voffA[i] = (unsigned)(R * K + C) * 2u; voffB[i] = (unsigned)(Rb * K + C) * 2u; }
    const size_t kstep = (size_t)(BK * 2);
    const size_t hstep = (size_t)HALF * K * 2;
    const size_t tstep = 2 * hstep;
    const unsigned ldsw = (unsigned)wid * 1024u;
    const int aoff = lds_byte(wr * 64 + fr, fq * 8), boff = lds_byte(wc * 32 + fr, fq * 8);
#define PG8_SA(b, h) (((b) * 2 + (h)) * HTB)
#define PG8_SB(b, h) ((4 + (b) * 2 + (h)) * HTB)
#define PG8_STAGE(bufoff, gbase, voff) do { _Pragma("unroll") for (int _i = 0; _i < 2; ++_i) \
        __builtin_amdgcn_global_load_lds((const unsigned*)((const char*)(gbase) + (voff)[_i]), (PG8_LAS unsigned*)(lds + (bufoff) + ldsw + _i * 8192), 16, 0, 0); } while (0)
#define PG8_LDA(dst, b, h) do { _Pragma("unroll") for (int m = 0; m < 4; ++m) _Pragma("unroll") for (int k = 0; k < 2; ++k) dst[m][k] = *(const PG8_LAS bf16x8*)(lds + PG8_SA(b, h) + aoff + m * 2048 + k * 1024); } while (0)
#define PG8_LDB(dst, b, h) do { _Pragma("unroll") for (int n = 0; n < 2; ++n) _Pragma("unroll") for (int k = 0; k < 2; ++k) dst[n][k] = *(const PG8_LAS bf16x8*)(lds + PG8_SB(b, h) + boff + n * 2048 + k * 1024); } while (0)
#define PG8_MMA(ai, bj, At, Bt) do { __builtin_amdgcn_s_setprio(1); _Pragma("unroll") for (int m = 0; m < 4; ++m) _Pragma("unroll") for (int n = 0; n < 2; ++n) _Pragma("unroll") for (int k = 0; k < 2; ++k) \
        { if constexpr (Epi::I8) acc[ai][bj][m][n] = __builtin_amdgcn_mfma_i32_16x16x64_i8(__builtin_bit_cast(i32x4, Bt[n][k]), __builtin_bit_cast(i32x4, At[m][k]), acc[ai][bj][m][n], 0, 0, 0); \
          else acc[ai][bj][m][n] = __builtin_amdgcn_mfma_f32_16x16x32_bf16(Bt[n][k], At[m][k], acc[ai][bj][m][n], 0, 0, 0); } __builtin_amdgcn_s_setprio(0); } while (0)
#define PG8_WAIT_V(n) asm volatile("s_waitcnt vmcnt(" #n ")" ::: "memory")
#define PG8_WAIT_L(n) asm volatile("s_waitcnt lgkmcnt(" #n ")" ::: "memory")
#define PG8_BAR __builtin_amdgcn_s_barrier()
#define PG8_SCHED __builtin_amdgcn_sched_barrier(0)
    Unit cur, nxt; int ui = 0;
    if (!S.next(0, cur)) return;
    typedef typename Epi::acc_t acc_t;
    acc_t acc[2][2][4][2];
#pragma unroll
    for (int a = 0; a < 2; ++a)
#pragma unroll
        for (int b = 0; b < 2; ++b)
#pragma unroll
            for (int m = 0; m < 4; ++m)
#pragma unroll
                for (int n = 0; n < 2; ++n) acc[a][b][m][n] = (acc_t){0, 0, 0, 0};
    bf16x8 At[4][2], B0[2][2], B1[2][2];
    const char* cA = (const char*)g.A + (size_t)cur.pm * tstep; const char* cB = (const char*)g.Bt + (size_t)cur.pn * tstep;
    S.a_ready(cur);
    PG8_STAGE(PG8_SB(0, 0), cB, voffB); PG8_STAGE(PG8_SA(0, 0), cA, voffA); PG8_STAGE(PG8_SB(0, 1), cB + hstep, voffB); PG8_STAGE(PG8_SA(0, 1), cA + hstep, voffA);
    if (wr == 1) PG8_BAR;
    PG8_WAIT_V(4); PG8_BAR;
    PG8_STAGE(PG8_SB(1, 0), cB + kstep, voffB); PG8_STAGE(PG8_SA(1, 0), cA + kstep, voffA); PG8_STAGE(PG8_SB(1, 1), cB + hstep + kstep, voffB);
    PG8_WAIT_V(6); PG8_BAR;
    PG8_STAMP();
    for (;;) {
        const bool has_next = S.next(ui + 1, nxt);
        const char* nA = has_next ? (const char*)g.A + (size_t)nxt.pm * tstep : cA; const char* nB = has_next ? (const char*)g.Bt + (size_t)nxt.pn * tstep : cB;
        for (int t = 0; t < nt; t += 2) {
            const bool last = (t == nt - 2);
            const char* a1 = cA + (size_t)(t + 1) * kstep;
            const char* a2 = last ? nA : cA + (size_t)(t + 2) * kstep; const char* b2 = last ? nB : cB + (size_t)(t + 2) * kstep;
            const char* a3 = a2 + kstep; const char* b3 = b2 + kstep;
            if (last && has_next) S.a_ready(nxt);
            PG8_LDB(B0, 0, 0); PG8_SCHED; PG8_LDA(At, 0, 0); PG8_STAGE(PG8_SA(1, 1), a1 + hstep, voffA);
            PG8_WAIT_L(8); PG8_BAR; PG8_WAIT_L(0); PG8_MMA(0, 0, At, B0); PG8_BAR; PG8_SCHED;
            PG8_LDB(B1, 0, 1); PG8_STAGE(PG8_SB(0, 0), b2, voffB);
            PG8_BAR; PG8_WAIT_L(0); PG8_MMA(0, 1, At, B1); PG8_BAR;
            PG8_LDA(At, 0, 1); PG8_STAGE(PG8_SA(0, 0), a2, voffA);
            PG8_BAR; PG8_WAIT_L(0); PG8_MMA(1, 0, At, B0); PG8_BAR; PG8_SCHED;
            PG8_STAGE(PG8_SB(0, 1), b2 + hstep, voffB);
            PG8_WAIT_V(6); PG8_BAR; PG8_MMA(1, 1, At, B1); PG8_BAR;
            PG8_LDB(B0, 1, 0); PG8_SCHED; PG8_LDA(At, 1, 0); PG8_STAGE(PG8_SA(0, 1), a2 + hstep, voffA);
            PG8_WAIT_L(8); PG8_BAR; PG8_WAIT_L(0); PG8_MMA(0, 0, At, B0); PG8_BAR; PG8_SCHED;
            PG8_LDB(B1, 1, 1); PG8_STAGE(PG8_SB(1, 0), b3, voffB);
            PG8_BAR; PG8_WAIT_L(0); PG8_MMA(0, 1, At, B1); PG8_BAR;
            PG8_LDA(At, 1, 1); PG8_STAGE(PG8_SA(1, 0), a3, voffA);
            PG8_BAR; PG8_WAIT_L(0); PG8_MMA(1, 0, At, B0); PG8_BAR; PG8_SCHED;
            PG8_STAGE(PG8_SB(1, 1), b3 + hstep, voffB);
            PG8_WAIT_V(6); PG8_BAR; PG8_MMA(1, 1, At, B1); PG8_BAR;
        }
        PG8_STAMP();
        if constexpr (!Epi::AFTER_DRAIN) { if (wr == 0) PG8_BAR; E(acc, cur, wr, wc, fr, fq); S.done(cur); }
        PG8_STAMP();
        if (!has_next) break;
        if constexpr (!Epi::AFTER_DRAIN) { if (wr == 1) PG8_BAR; }
#pragma unroll
        for (int a = 0; a < 2; ++a)
#pragma unroll
            for (int b = 0; b < 2; ++b)
#pragma unroll
                for (int m = 0; m < 4; ++m)
#pragma unroll
                    for (int n = 0; n < 2; ++n) acc[a][b][m][n] = (acc_t){0, 0, 0, 0};
        cur = nxt; cA = nA; cB = nB; ++ui;
    }
    PG8_WAIT_V(0);
    if constexpr (Epi::AFTER_DRAIN) { if (wr == 0) PG8_BAR; }
    PG8_BAR;
    if constexpr (Epi::AFTER_DRAIN) { E.fused(acc, cur, wr, wc, fr, fq, lds, wid, lane); S.done(cur); }
    PG8_STAMP();
    if (STAMP && wid == 0) { stamps[lane] = lane < nts ? (((unsigned long long)(unsigned)ts_hi << 32) | (unsigned)ts_lo) : 0ull;
        if (lane == 62) stamps[62] = rt_entry; if (lane == 63) stamps[63] = (unsigned long long)wall_clock64(); }
#undef PG8_STAMP
#undef PG8_SA
#undef PG8_SB
#undef PG8_STAGE
#undef PG8_LDA
#undef PG8_LDB
#undef PG8_MMA
#undef PG8_WAIT_V
#undef PG8_WAIT_L
#undef PG8_BAR
#undef PG8_SCHED
}
}
namespace pg8 {
template <bool I8_> struct EpiInProjT {
    static constexpr bool PERM = true, AFTER_DRAIN = false, I8 = I8_; typedef typename std::conditional<I8_, i32x4, f32x4>::type acc_t;
    bf16_t *FQ, *FK, *FV, *HQ, *HK, *HV, *HG; float* HLF;
    const float *qg, *kg, *lbw;
    const float *SA, *SB;
    PG8_LAS float* tab;
    __device__ __forceinline__ void operator()(const acc_t (&accq)[2][2][4][2], const Unit& u, int wr, int wc, int fr, int fq) const {
        float sa[2][4]; f32x4 sb[2][2];
        if constexpr (I8_) {
#pragma unroll
            for (int ai = 0; ai < 2; ++ai)
#pragma unroll
                for (int m = 0; m < 4; ++m) sa[ai][m] = SA[u.pm * BM + ai * HALF + m * 16 + wr * 64 + fr];
#pragma unroll
            for (int bj = 0; bj < 2; ++bj)
#pragma unroll
                for (int n = 0; n < 2; ++n) sb[bj][n] = *(const f32x4*)(SB + u.pn * BM + bj * HALF + wc * 32 + 8 * fq + 4 * n);
        }
#define ACCV(ai, bj, m, n) (I8_ ? __builtin_convertvector(accq[ai][bj][m][n], f32x4) * (sb[bj][n] * sa[ai][m]) : __builtin_bit_cast(f32x4, accq[ai][bj][m][n]))
        const int ty = u.pn >> 3, hp = (u.pn & 7) * 2, rl0 = wr * 64 + fr, cih = wc * 32 + 8 * fq;
        const size_t row0 = (size_t)u.pm * BM + rl0;
        if (ty < 2) {
#pragma unroll
            for (int ai = 0; ai < 2; ++ai)
#pragma unroll
                for (int m = 0; m < 4; ++m)
#pragma unroll
                    for (int bj = 0; bj < 2; ++bj) { const f32x4 a = ACCV(ai, bj, m, 0), b = ACCV(ai, bj, m, 1);
                        float s = ((a[0] * a[0] + a[1] * a[1]) + (a[2] * a[2] + a[3] * a[3])) + ((b[0] * b[0] + b[1] * b[1]) + (b[2] * b[2] + b[3] * b[3]));
                        s += __shfl_xor(s, 16); s += __shfl_xor(s, 32);
                        if (fq == 0) tab[((ai * HALF + m * 16 + rl0) * 2 + bj) * 4 + wc] = s; }
            asm volatile("s_waitcnt lgkmcnt(0)" ::: "memory"); __builtin_amdgcn_s_barrier(); asm volatile("" ::: "memory");
            const float* gn = (ty == 0 ? qg : kg) + hp * HDIM + cih; bf16_t* dst = (ty == 0 ? FQ : FK);
            f32x4 g[2][2];
#pragma unroll
            for (int bj = 0; bj < 2; ++bj) { g[bj][0] = *(const f32x4*)(gn + bj * HDIM); g[bj][1] = *(const f32x4*)(gn + bj * HDIM + 4); }
#pragma unroll
            for (int ai = 0; ai < 2; ++ai)
#pragma unroll
                for (int m = 0; m < 4; ++m)
#pragma unroll
                    for (int bj = 0; bj < 2; ++bj) { const f32x4 p = *(const PG8_LAS f32x4*)(tab + ((ai * HALF + m * 16 + rl0) * 2 + bj) * 4);
                        const float rs = __builtin_amdgcn_rsqf(((p[0] + p[1]) + (p[2] + p[3])) * (1.f / HDIM) + EPS_);
                        const f32x4 a = ACCV(ai, bj, m, 0) * rs * g[bj][0], b = ACCV(ai, bj, m, 1) * rs * g[bj][1];
                        u32x4 w = {cvt_pk_bf16(a[0], a[1]), cvt_pk_bf16(a[2], a[3]), cvt_pk_bf16(b[0], b[1]), cvt_pk_bf16(b[2], b[3])};
                        *(u32x4*)(dst + ((size_t)(hp + bj) * T_ + row0 + ai * HALF + m * 16) * HDIM + cih) = w; }
        } else if (ty == 4) {
            float lb[2][8];
#pragma unroll
            for (int bj = 0; bj < 2; ++bj) { const float* l = lbw + (hp + bj) * HDIM + cih;
#pragma unroll
                for (int i = 0; i < 8; ++i) lb[bj][i] = __builtin_amdgcn_rcpf(1.f + __expf(l[HGW + i] - l[i])); }
#pragma unroll
            for (int ai = 0; ai < 2; ++ai)
#pragma unroll
                for (int m = 0; m < 4; ++m)
#pragma unroll
                    for (int bj = 0; bj < 2; ++bj) { float f[8];
                        const f32x4 v0_ = ACCV(ai, bj, m, 0), v1_ = ACCV(ai, bj, m, 1);
#pragma unroll
                        for (int i = 0; i < 8; ++i) { const float xx = (i < 4 ? v0_ : v1_)[i & 3]; f[i] = lb[bj][i] + (1.f - lb[bj][i]) * __builtin_amdgcn_rcpf(1.f + __expf(-xx)); }
                        const size_t o = ((size_t)(hp + bj) * T_ + row0 + ai * HALF + m * 16) * HDIM + cih;
#define LN_(x_) (__builtin_amdgcn_logf(x_) * 0.69314718055994531f)
                        { typedef _Float16 h2_ __attribute__((ext_vector_type(2)));
#define PKH_(a_, b_) __builtin_bit_cast(unsigned, (h2_){(_Float16)(a_), (_Float16)(b_)})
                          *(u32x4*)((unsigned short*)HLF + o) = (u32x4){PKH_(LN_(f[0]), LN_(f[1])), PKH_(LN_(f[2]), LN_(f[3])), PKH_(LN_(f[4]), LN_(f[5])), PKH_(LN_(f[6]), LN_(f[7]))};
#undef PKH_
                        }
#undef LN_
                        }
        } else {
            bf16_t* dst = ty == 2 ? FV : ty == 3 ? HQ : ty == 5 ? HV : HG;
            const bool act = (ty == 3) || (ty == 6); const float sc = ty == 3 ? 0.08838834764831845f : 1.f;
#pragma unroll
            for (int ai = 0; ai < 2; ++ai)
#pragma unroll
                for (int m = 0; m < 4; ++m)
#pragma unroll
                    for (int bj = 0; bj < 2; ++bj) { float f[8];
                        const f32x4 v0_ = ACCV(ai, bj, m, 0), v1_ = ACCV(ai, bj, m, 1);
#pragma unroll
                        for (int i = 0; i < 8; ++i) { const float xx = (i < 4 ? v0_ : v1_)[i & 3]; f[i] = act ? xx * sc * __builtin_amdgcn_rcpf(1.f + __expf(-xx)) : xx; }
                        u32x4 w = {cvt_pk_bf16(f[0], f[1]), cvt_pk_bf16(f[2], f[3]), cvt_pk_bf16(f[4], f[5]), cvt_pk_bf16(f[6], f[7])};
                        *(u32x4*)(dst + ((size_t)(hp + bj) * T_ + row0 + ai * HALF + m * 16) * HDIM + cih) = w; }
        }
    }
#undef ACCV
};
typedef EpiInProjT<false> EpiInProj;
}
namespace pg8 {
template <bool I8_> struct EpiOutProjT {
    static constexpr bool PERM = false, AFTER_DRAIN = false, I8 = I8_; typedef typename std::conditional<I8_, i32x4, f32x4>::type acc_t;
    const float* x; const float* mod; const float* ada_b; float* OUT; float* PSSQ; const float *SA, *SB;
    __device__ __forceinline__ void operator()(const acc_t (&acc)[2][2][4][2], const Unit& u, int wr, int wc, int fr, int fq) const {
        const int row0 = u.pm * BM + wr * 64 + fr, col0 = u.pn * BM + wc * 32 + 4 * fq;
        f32x4 gt[2][2];
#pragma unroll
        for (int bj = 0; bj < 2; ++bj)
#pragma unroll
            for (int n = 0; n < 2; ++n) { gt[bj][n] = *(const f32x4*)(mod + 2 * DM + col0 + bj * HALF + n * 16) + *(const f32x4*)(ada_b + 2 * DM + col0 + bj * HALF + n * 16);
                if constexpr (I8_) gt[bj][n] = gt[bj][n] * *(const f32x4*)(SB + col0 + bj * HALF + n * 16); }
#pragma unroll
        for (int ai = 0; ai < 2; ++ai)
#pragma unroll
            for (int m = 0; m < 4; ++m) { const size_t ro = (size_t)(row0 + ai * HALF + m * 16) * DM + col0; float s = 0.f;
                float rsc = 1.f; if constexpr (I8_) rsc = SA[row0 + ai * HALF + m * 16];
#pragma unroll
                for (int bj = 0; bj < 2; ++bj)
#pragma unroll
                    for (int n = 0; n < 2; ++n) { f32x4 av; if constexpr (I8_) av = __builtin_convertvector(acc[ai][bj][m][n], f32x4) * rsc; else av = __builtin_bit_cast(f32x4, acc[ai][bj][m][n]);
                        const f32x4 v = *(const f32x4*)(x + ro + bj * HALF + n * 16) + gt[bj][n] * av;
                        *(f32x4*)(OUT + ro + bj * HALF + n * 16) = v; s += (v[0] * v[0] + v[1] * v[1]) + (v[2] * v[2] + v[3] * v[3]); }
                s += __shfl_xor(s, 16); s += __shfl_xor(s, 32);
                if (fq == 0) PSSQ[(size_t)(row0 + ai * HALF + m * 16) * 64 + u.pn * 4 + wc] = s; }
    }
};
}
namespace pg8 {
template <bool I8_> struct EpiMixBf16T {
    static constexpr bool PERM = true, AFTER_DRAIN = false, I8 = I8_; typedef typename std::conditional<I8_, i32x4, f32x4>::type acc_t;
    bf16_t* O; const float* mod; const float* ada_b;
    const float *SA, *SB;
    __device__ __forceinline__ void operator()(const acc_t (&accq)[2][2][4][2], const Unit& u, int wr, int wc, int fr, int fq) const {
        const int row0 = u.pm * BM + wr * 64 + fr, col0 = u.pn * BM + wc * 32 + 8 * fq;
        f32x4 gt[2][2];
#pragma unroll
        for (int bj = 0; bj < 2; ++bj)
#pragma unroll
            for (int n = 0; n < 2; ++n) { gt[bj][n] = *(const f32x4*)(mod + 2 * DM + col0 + bj * HALF + 4 * n) + *(const f32x4*)(ada_b + 2 * DM + col0 + bj * HALF + 4 * n);
                if constexpr (I8_) gt[bj][n] = gt[bj][n] * *(const f32x4*)(SB + col0 + bj * HALF + 4 * n); }
#pragma unroll
        for (int ai = 0; ai < 2; ++ai)
#pragma unroll
            for (int m = 0; m < 4; ++m) { bf16_t* rowp = O + (size_t)(row0 + ai * HALF + m * 16) * DM + col0;
                float sa = 1.f; if constexpr (I8_) sa = SA[row0 + ai * HALF + m * 16];
#pragma unroll
                for (int bj = 0; bj < 2; ++bj) {
                    f32x4 v0, v1;
                    if constexpr (I8_) { v0 = __builtin_convertvector(accq[ai][bj][m][0], f32x4) * (gt[bj][0] * sa); v1 = __builtin_convertvector(accq[ai][bj][m][1], f32x4) * (gt[bj][1] * sa); }
                    else { v0 = __builtin_bit_cast(f32x4, accq[ai][bj][m][0]) * gt[bj][0]; v1 = __builtin_bit_cast(f32x4, accq[ai][bj][m][1]) * gt[bj][1]; }
                    u32x4 w = {cvt_pk_bf16(v0[0], v0[1]), cvt_pk_bf16(v0[2], v0[3]), cvt_pk_bf16(v1[0], v1[1]), cvt_pk_bf16(v1[2], v1[3])};
                    *(u32x4*)(rowp + bj * HALF) = w; } }
    }
};
}
__device__ __forceinline__ void transpose_item(const float* W, int ld, int c0, bf16_t* WT, int K, int r0, int nblk, LAS float* scr, int item, int lane) {
    const int kb = item / nblk, nb = item % nblk, k0 = 64 * kb, n0 = 32 * nb;
#pragma unroll 8
    for (int i = 0; i < 32; ++i) { const int kk = 2 * i + (lane >> 5); scr[kk * 33 + (lane & 31)] = W[(size_t)(k0 + kk) * ld + c0 + n0 + (lane & 31)]; }
    asm volatile("s_waitcnt lgkmcnt(0)" ::: "memory");
    const int c = lane & 7;
#pragma unroll
    for (int j = 0; j < 4; ++j) { const int n = (lane >> 3) + 8 * j; const LAS float* s = scr + (8 * c) * 33 + n;
        u32x4 o; o.x = pk2(s[0 * 33], s[1 * 33]); o.y = pk2(s[2 * 33], s[3 * 33]); o.z = pk2(s[4 * 33], s[5 * 33]); o.w = pk2(s[6 * 33], s[7 * 33]);
        *(u32x4*)(WT + (size_t)(r0 + n0 + n) * K + k0 + 8 * c) = o; }
    asm volatile("s_waitcnt lgkmcnt(0)" ::: "memory");
}
__device__ __forceinline__ void p_convert(unsigned char* lds, const float* w_in, const float* w_out, const float* w_q,
                                                    bf16_t* WinT, bf16_t* WoutT, bf16_t* WqT, float* WFT) {
    const int tid = opaque_tid(), lane = tid & 63, wave = tid >> 6;
    constexpr int TP = 272, I_O = 0  , NIT = I_O + 8 * 32, PER = NIT / 256;
    static_assert(NIT % 256 == 0, "items must divide evenly over 256 workgroups");
    unsigned char* tile = lds;
    f32x4 x[16];
#define CV_ITEM(it_, src_, ld_, dst_, n0_, k0_) const bool isq_ = (it_) >= I_O; const int j_ = isq_ ? (it_) - I_O : (it_); const float* src_ = isq_ ? w_q : w_out; const int ld_ = isq_ ? PEER_QW : DM; \
        bf16_t* dst_ = isq_ ? WqT : WoutT; const int n0_ = 256 * (j_ >> 5), k0_ = 128 * (j_ & 31)
    { CV_ITEM(blockIdx.x * PER, src, ld, dst, n0, k0); (void)dst;
#pragma unroll
      for (int r = 0; r < 16; ++r) x[r] = *(const f32x4*)(src + (size_t)(k0 + 16 * wave + r) * ld + n0 + 4 * lane); }
#pragma unroll 1
    for (int i = 0; i < PER; ++i) {
        CV_ITEM(blockIdx.x * PER + i, src, ld, dst, n0, k0); (void)src; (void)ld;
        u32x4 P[4][2];
#pragma unroll
        for (int b4 = 0; b4 < 4; ++b4)
#pragma unroll
            for (int d = 0; d < 8; ++d) P[b4][d >> 2][d & 3] = pk2(x[2 * d][b4], x[2 * d + 1][b4]);
        if (i + 1 < PER) { CV_ITEM(blockIdx.x * PER + i + 1, src1, ld1, dst1, n1, k1); (void)dst1;
#pragma unroll
            for (int r = 0; r < 16; ++r) x[r] = *(const f32x4*)(src1 + (size_t)(k1 + 16 * wave + r) * ld1 + n1 + 4 * lane); }
#pragma unroll
        for (int b4 = 0; b4 < 4; ++b4) { *(u32x4*)(tile + (4 * lane + b4) * TP + 32 * wave) = P[b4][0]; *(u32x4*)(tile + (4 * lane + b4) * TP + 32 * wave + 16) = P[b4][1]; }
        __syncthreads();
#pragma unroll
        for (int ps = 0; ps < 8; ++ps) { const int n = 32 * ps + (tid >> 4), pc = tid & 15;
            *(u32x4*)((unsigned char*)(dst + (size_t)(n0 + n) * DM + k0) + 16 * pc) = *(const u32x4*)(tile + n * TP + 16 * pc); }
        __syncthreads();
    }
#undef CV_ITEM
    const size_t gt = (size_t)blockIdx.x * 512 + tid, NGT = (size_t)gridDim.x * 512;
    for (size_t i = gt; i < (size_t)16 * DM; i += NGT) { const int h = (int)(i / DM), k = (int)(i % DM); WFT[i] = w_in[(size_t)k * NIN + 6144 + h]; }
}
__device__ __forceinline__ void p_adaln(unsigned char* lds, const float* c, const float* ada_w, float* mod) {
    float* cact = (float*)lds;
    float* part = cact + DM;
    const int tid = opaque_tid();
    for (int i = tid; i < DM; i += 512) cact[i] = silu_f(c[i]);
    __syncthreads();
    const int g = tid / 24, q = tid % 24;
    for (int cb = blockIdx.x; cb < 6 * DM / 96; cb += gridDim.x) {
        f32x4 acc = {0.f, 0.f, 0.f, 0.f};
        if (g < 21) {
            const float* wp = ada_w + (size_t)cb * 96 + 4 * q;
#pragma unroll 8
            for (int k = g; k < DM; k += 21) { const f32x4 w = *(const f32x4*)(wp + (size_t)k * (6 * DM)); acc += w * cact[k]; }
            *(f32x4*)(part + g * 96 + 4 * q) = acc;
        }
        __syncthreads();
        if (tid < 96) { float s = 0.f;
#pragma unroll
            for (int j = 0; j < 21; ++j) s += part[j * 96 + tid];
            mod[cb * 96 + tid] = s; }
        __syncthreads();
    }
}
__device__ __forceinline__ float dot2_bf16(unsigned a, unsigned b, float c) { typedef __bf16 bf2_ __attribute__((ext_vector_type(2))); return __builtin_amdgcn_fdot2_f32_bf16(__builtin_bit_cast(bf2_, a), __builtin_bit_cast(bf2_, b), c, false); }
__device__ __forceinline__ void p_norm1(unsigned char* lds, const float* x, const float* mod, const float* ada_b, const float* g1, const float* WFT, const float* fbias, unsigned char* H1Q, float* SA, float* FLOGF) {
    unsigned short* A1h = (unsigned short*)lds; unsigned short* B1h = A1h + DM; unsigned short* WFh = B1h + DM;
    const int tid = opaque_tid(), lane = tid & 63, wave = tid >> 6;
    for (int i = tid; i < DM; i += 512) { A1h[i] = (unsigned short)f2bf(g1[i] * (1.f + mod[DM + i] + ada_b[DM + i])); B1h[i] = (unsigned short)f2bf(mod[i] + ada_b[i]); }
    for (int i = tid; i < 16 * DM / 4; i += 512) { const f32x4 w = *(const f32x4*)(WFT + 4 * i); *(u32x2*)(WFh + 4 * i) = (u32x2){pk2(w[0], w[1]), pk2(w[2], w[3])}; }
    __syncthreads();
#define UNPK4(p_) ((f32x4){bf2f((p_).x & 0xffffu), bf2f((p_).x >> 16), bf2f((p_).y & 0xffffu), bf2f((p_).y >> 16)})
    for (int t0 = (blockIdx.x * 8 + wave) * 2; t0 < T_; t0 += gridDim.x * 16) {
        u32x2 hp[2][16];
        f32x4 vv[2][16];
#pragma unroll
        for (int tk = 0; tk < 2; ++tk)
#pragma unroll
            for (int j = 0; j < 16; ++j) vv[tk][j] = ((const f32x4*)(x + (size_t)(t0 + tk) * DM) + lane)[64 * j];
#pragma unroll
        for (int tk = 0; tk < 2; ++tk) {
            f32x4 (&v)[16] = vv[tk]; float ss = 0.f;
#pragma unroll
            for (int j = 0; j < 16; ++j) ss += (v[j][0] * v[j][0] + v[j][1] * v[j][1]) + (v[j][2] * v[j][2] + v[j][3] * v[j][3]);
            const float rstd = rsqrtf(wave_sum(ss) * (1.f / DM) + EPS_);
            float mx = 0.f;
#pragma unroll
            for (int j = 0; j < 16; ++j) { const u32x2 ap = *(const u32x2*)(A1h + 4 * lane + 256 * j), bp = *(const u32x2*)(B1h + 4 * lane + 256 * j);
                const f32x4 hh = v[j] * rstd * UNPK4(ap) + UNPK4(bp); hp[tk][j] = (u32x2){pk2(hh[0], hh[1]), pk2(hh[2], hh[3])}; v[j] = hh;
                mx = fmaxf(fmaxf(mx, fmaxf(fabsf(hh[0]), fabsf(hh[1]))), fmaxf(fabsf(hh[2]), fabsf(hh[3]))); }
#pragma unroll
            for (int o = 1; o < 64; o <<= 1) mx = fmaxf(mx, __shfl_xor(mx, o));
            const float sc = fmaxf(mx, 1e-30f) * (1.f / 127.f), inv = 1.f / sc;
            unsigned* q8 = (unsigned*)(H1Q + (size_t)(t0 + tk) * DM) + lane;
#pragma unroll
            for (int j = 0; j < 16; ++j) { const int b0 = (int)rintf(v[j][0] * inv) & 0xff, b1 = (int)rintf(v[j][1] * inv) & 0xff, b2 = (int)rintf(v[j][2] * inv) & 0xff, b3 = (int)rintf(v[j][3] * inv) & 0xff;
                q8[64 * j] = (unsigned)b0 | ((unsigned)b1 << 8) | ((unsigned)b2 << 16) | ((unsigned)b3 << 24); }
            if (lane == 0) SA[t0 + tk] = sc;
            asm volatile("" ::: "memory");
        }
        float dd0[16], dd1[16];
#pragma unroll
        for (int h = 0; h < 16; ++h) { float d0 = 0.f, d1 = 0.f;
#pragma unroll
            for (int j = 0; j < 16; ++j) { const u32x2 wp = *(const u32x2*)(WFh + h * DM + 4 * lane + 256 * j);
                d0 = dot2_bf16(hp[0][j].x, wp.x, d0); d0 = dot2_bf16(hp[0][j].y, wp.y, d0); d1 = dot2_bf16(hp[1][j].x, wp.x, d1); d1 = dot2_bf16(hp[1][j].y, wp.y, d1); }
            dd0[h] = d0; dd1[h] = d1; }
        float r16[16], r8[8], r4[4], r2[2], r1;
        { const bool hi = lane & 32;
#pragma unroll
          for (int j = 0; j < 16; ++j) r16[j] = (hi ? dd1[j] : dd0[j]) + __shfl_xor(hi ? dd0[j] : dd1[j], 32); }
        { const bool hi = lane & 16;
#pragma unroll
          for (int j = 0; j < 8; ++j) r8[j] = (hi ? r16[j + 8] : r16[j]) + __shfl_xor(hi ? r16[j] : r16[j + 8], 16); }
        { const bool hi = lane & 8;
#pragma unroll
          for (int j = 0; j < 4; ++j) r4[j] = (hi ? r8[j + 4] : r8[j]) + __shfl_xor(hi ? r8[j] : r8[j + 4], 8); }
        { const bool hi = lane & 4;
#pragma unroll
          for (int j = 0; j < 2; ++j) r2[j] = (hi ? r4[j + 2] : r4[j]) + __shfl_xor(hi ? r4[j] : r4[j + 2], 4); }
        { const bool hi = lane & 2; r1 = (hi ? r2[1] : r2[0]) + __shfl_xor(hi ? r2[0] : r2[1], 2); }
        r1 += __shfl_xor(r1, 1);
        if ((lane & 1) == 0) { const int h = (lane >> 1) & 15; const float z = r1 + fbias[h]; FLOGF[(size_t)h * T_ + t0 + (lane >> 5)] = fminf(z, 0.f) - log1pf(__expf(-fabsf(z))); }
    }
#undef UNPK4
}
__device__ __forceinline__ void p_post1(unsigned char* lds, const float* PROJ, const float* qg, const float* kg, const float* lbw,
                                                  bf16_t* FQ, bf16_t* FK, bf16_t* FV, bf16_t* HQ, bf16_t* HK, bf16_t* HV, bf16_t* HG, float* HLF) {
    const int tid = opaque_tid(), lane = tid & 63, wave = tid >> 6;
    for (int t = blockIdx.x * 8 + wave; t < T_; t += gridDim.x * 8) {
        const float* row = PROJ + (size_t)t * NPROJ;
        for (int s = 0; s < 112; ++s) {
            const int ty = s >> 4, h = s & 15, c = 2 * lane;
            const f32x2 p = *(const f32x2*)(row + s * 128 + c);
            const size_t o = ((size_t)h * T_ + t) * HDIM + c;
            if (ty < 2) {
                const float rs = rsqrtf(wave_sum(p[0] * p[0] + p[1] * p[1]) * (1.f / HDIM) + EPS_);
                const float* g = (ty == 0 ? qg : kg) + h * HDIM + c;
                *(unsigned*)((ty == 0 ? FQ : FK) + o) = pk2(p[0] * rs * g[0], p[1] * rs * g[1]);
            } else if (ty == 2) { *(unsigned*)(FV + o) = pk2(p[0], p[1]); }
            else if (ty == 3) { *(unsigned*)(HQ + o) = pk2(silu_f(p[0]) * 0.08838834764831845f, silu_f(p[1]) * 0.08838834764831845f); }
            else if (ty == 4) {
                const int j = h * HDIM + c;
                const float lb0 = 1.f / (1.f + __expf(lbw[HGW + j] - lbw[j])), lb1 = 1.f / (1.f + __expf(lbw[HGW + j + 1] - lbw[j + 1]));
                const float f0 = lb0 + (1.f - lb0) * sigmoid_f(p[0]), f1 = lb1 + (1.f - lb1) * sigmoid_f(p[1]);
                *(f32x2*)(HLF + o) = (f32x2){__logf(f0), __logf(f1)};
                *(unsigned*)(HK + o) = pk2(1.f - f0, 1.f - f1);
            } else if (ty == 5) { *(unsigned*)(HV + o) = pk2(p[0], p[1]); }
            else { *(unsigned*)(HG + o) = pk2(silu_f(p[0]), silu_f(p[1])); }
        }
    }
}
__device__ __forceinline__ void p_scan(unsigned char* lds, const float* FLOGF, float* FCUM) {
    float* part = (float*)lds;
    const int tid = opaque_tid();
    for (int h = blockIdx.x; h < NHEAD; h += gridDim.x) {
        const float* src = FLOGF + (size_t)h * T_ + tid * 16; float v[16]; float s = 0.f;
#pragma unroll
        for (int i = 0; i < 16; ++i) { s += src[i]; v[i] = s; }
        part[tid] = s; __syncthreads();
        if (tid == 0) { float run = 0.f; for (int i = 0; i < 512; ++i) { const float p = part[i]; part[i] = run; run += p; } }
        __syncthreads();
        const float off = part[tid]; float* dst = FCUM + (size_t)h * T_ + tid * 16;
#pragma unroll
        for (int i = 0; i < 16; ++i) dst[i] = v[i] + off;
        __syncthreads();
    }
}
constexpr int SLB = 256;
__device__ __forceinline__ void p_convert_uv4(unsigned char* lds, unsigned* qhead, const float* u, const float* v, unsigned char* U4, float* SU, unsigned char* V4, float* SV) {
    const int tid = opaque_tid(), lane = tid & 63, wave = tid >> 6;
    volatile unsigned* slot = (volatile unsigned*)lds;
    for (;;) {
        __syncthreads();
        if (tid == 0) *slot = __hip_atomic_fetch_add(qhead, 1u, __ATOMIC_RELAXED, __HIP_MEMORY_SCOPE_AGENT);
        __syncthreads();
        const unsigned chunk = *slot;
        if (chunk >= 2u * PEER_NE / 8u) break;
        { const int r = (int)chunk * 8 + wave;
        const bool isv = r >= PEER_NE; const int e = isv ? r - PEER_NE : r;
        const float* src = (isv ? v : u) + (size_t)e * DM;
        f32x4 x[16]; float mx = 0.f, ss = 0.f;
#pragma unroll
        for (int i = 0; i < 16; ++i) {
            x[i] = *(const f32x4*)(src + 4 * lane + 256 * i);
            ss += (x[i][0] * x[i][0] + x[i][1] * x[i][1]) + (x[i][2] * x[i][2] + x[i][3] * x[i][3]);
            mx = fmaxf(fmaxf(mx, fmaxf(fabsf(x[i][0]), fabsf(x[i][1]))), fmaxf(fabsf(x[i][2]), fabsf(x[i][3]))); }
#pragma unroll
        for (int o = 1; o < 64; o <<= 1) { mx = fmaxf(mx, __shfl_xor(mx, o)); ss += __shfl_xor(ss, o); }
        const float sc = fmaxf(fminf(0.3352f * sqrtf(ss * (1.f / DM)), mx * (1.f / 7.5f)), 1e-30f), inv = 1.f / sc;
        unsigned qd[16];
#pragma unroll
        for (int i = 0; i < 16; ++i) { qd[i] = 0u;
#pragma unroll
            for (int b4 = 0; b4 < 4; ++b4) qd[i] |= (unsigned)(int)fminf(fmaxf(floorf(x[i][b4] * inv) + 8.f, 0.f), 15.f) << (8 * b4);
            if (!isv || (i & 1)) qd[i] ^= 0x08080808u; }
        unsigned* dst = (unsigned*)((isv ? V4 : U4) + (size_t)e * SLB) + lane;
#pragma unroll
        for (int xs = 0; xs < 8; ++xs) dst[(size_t)xs * PEER_NE * (SLB / 4)] = qd[2 * xs] | (qd[2 * xs + 1] << 4);
        if (lane == 0) (isv ? SV : SU)[e] = sc; }
    }
}
template <int LD> __device__ __forceinline__ void p_colmax(const float* W, float* PM) {
    const int tid = opaque_tid();
    constexpr int NCH = (LD + 2047) / 2048;
    for (int it = blockIdx.x; it < 64 * NCH; it += gridDim.x) {
        const int ch = it % NCH, ks = it / NCH, col = ch * 2048 + tid * 4;
        if (col < LD) {
            f32x4 mx = {0.f, 0.f, 0.f, 0.f};
#pragma unroll 16
            for (int k = 0; k < 64; ++k) { const f32x4 w = *(const f32x4*)(W + (size_t)(ks * 64 + k) * LD + col); mx = (f32x4){fmaxf(mx[0], fabsf(w[0])), fmaxf(mx[1], fabsf(w[1])), fmaxf(mx[2], fabsf(w[2])), fmaxf(mx[3], fabsf(w[3]))}; }
            *(f32x4*)(PM + (size_t)ks * LD + col) = mx;
        }
    }
}
template <int LD, int NOUT, bool GAP16> __device__ __forceinline__ void p_quant_w(unsigned char* lds, const float* W, const float* PM, unsigned char* WT8, float* SB) {
    const int tid = opaque_tid(), lane = tid & 63, wave = tid >> 6;
    constexpr int TP = 144, NIT = (NOUT / 256) * (DM / 128), PER = NIT / 256;
    static_assert(NIT % 256 == 0, "items must divide evenly over 256 workgroups");
    unsigned char* tile = lds;
    float* redm = (float*)(lds + 256 * TP);
    float* scl = redm + 512;
    int gcur = -1; f32x4 inv = {0.f, 0.f, 0.f, 0.f};
    f32x4 x[16];
    { const int it = blockIdx.x * PER, g = it / (DM / 128), kt = it % (DM / 128), n0 = 256 * g, c0 = (GAP16 && n0 >= 6144) ? n0 + 16 : n0;
#pragma unroll
      for (int r = 0; r < 16; ++r) x[r] = *(const f32x4*)(W + (size_t)(128 * kt + 16 * wave + r) * LD + c0 + 4 * lane); }
#pragma unroll 1
    for (int i = 0; i < PER; ++i) {
        const int it = blockIdx.x * PER + i, g = it / (DM / 128), kt = it % (DM / 128), n0 = 256 * g, c0 = (GAP16 && n0 >= 6144) ? n0 + 16 : n0, k0 = 128 * kt;
        if (g != gcur) {
            gcur = g;
            { const int c = tid & 255, hf = tid >> 8; float m = 0.f;
#pragma unroll 8
              for (int p = 0; p < 32; ++p) m = fmaxf(m, PM[(size_t)(32 * hf + p) * LD + c0 + c]);
              redm[hf * 256 + c] = m; }
            __syncthreads();
            if (tid < 256) { const float sc = fmaxf(fmaxf(redm[tid], redm[256 + tid]), 1e-30f) * (1.f / 127.f); scl[tid] = 1.f / sc; if (kt == 0) SB[n0 + tid] = sc; }
            __syncthreads();
            inv = *(const f32x4*)(scl + 4 * lane);
        }
        u32x4 P[4];
#pragma unroll
        for (int b4 = 0; b4 < 4; ++b4)
#pragma unroll
            for (int d = 0; d < 4; ++d) { unsigned v = 0u;
#pragma unroll
                for (int e2 = 0; e2 < 4; ++e2) v |= ((unsigned)((int)fminf(fmaxf(rintf(x[4 * d + e2][b4] * inv[b4]), -127.f), 127.f) & 0xff)) << (8 * e2);
                P[b4][d] = v; }
        if (i + 1 < PER) { const int it1 = it + 1, g1 = it1 / (DM / 128), kt1 = it1 % (DM / 128), n1 = 256 * g1, c1 = (GAP16 && n1 >= 6144) ? n1 + 16 : n1;
#pragma unroll
            for (int r = 0; r < 16; ++r) x[r] = *(const f32x4*)(W + (size_t)(128 * kt1 + 16 * wave + r) * LD + c1 + 4 * lane); }
#pragma unroll
        for (int b4 = 0; b4 < 4; ++b4) *(u32x4*)(tile + (4 * lane + b4) * TP + 16 * wave) = P[b4];
        __syncthreads();
#pragma unroll
        for (int ps = 0; ps < 4; ++ps) { const int n = 64 * ps + (tid >> 3), pc = tid & 7;
            *(u32x4*)(WT8 + (size_t)(n0 + n) * DM + k0 + 16 * pc) = *(const u32x4*)(tile + n * TP + 16 * pc); }
        __syncthreads();
    }
}
__device__ __forceinline__ void p_quant_merged(const bf16_t* MERGED, unsigned char* M8, float* SM) {
    const int tid = opaque_tid(), lane = tid & 63, wave = tid >> 6;
    for (int t = blockIdx.x * 8 + wave; t < T_; t += gridDim.x * 8) {
        const u32x4* src = (const u32x4*)(MERGED + (size_t)t * DM) + lane;
        u32x4 w[8]; float mx = 0.f;
#pragma unroll
        for (int j = 0; j < 8; ++j) { w[j] = src[64 * j];
#pragma unroll
            for (int c = 0; c < 4; ++c) mx = fmaxf(mx, fmaxf(fabsf(bf2f(w[j][c] & 0xffffu)), fabsf(bf2f(w[j][c] >> 16)))); }
#pragma unroll
        for (int o = 1; o < 64; o <<= 1) mx = fmaxf(mx, __shfl_xor(mx, o));
        const float sc = fmaxf(mx, 1e-30f) * (1.f / 127.f), inv = 1.f / sc;
#pragma unroll
        for (int j = 0; j < 8; ++j) { u32x2 o;
#pragma unroll
            for (int q = 0; q < 2; ++q) { const unsigned a = w[j][2 * q], b = w[j][2 * q + 1];
                o[q] = ((unsigned)((int)rintf(bf2f(a & 0xffffu) * inv) & 0xff)) | (((unsigned)((int)rintf(bf2f(a >> 16) * inv) & 0xff)) << 8) |
                       (((unsigned)((int)rintf(bf2f(b & 0xffffu) * inv) & 0xff)) << 16) | (((unsigned)((int)rintf(bf2f(b >> 16) * inv) & 0xff)) << 24); }
            *(u32x2*)(M8 + (size_t)t * DM + 8 * lane + 512 * j) = o; }
        if (lane == 0) SM[t] = sc;
    }
}
namespace fox {
constexpr int B = 1, H = NHEAD, HKV = NHEAD, SQ = T_, SKV = T_, D = HDIM, QOFF = 0, WINDOW = SKV;
constexpr float THR = 8.f;
constexpr bool WSKIP = false;
constexpr float SCALE = 0.08838834764831845f;
constexpr float INV_SCALE = 11.313708498984761f;
constexpr int NW = 8, QBLK = 32, KVBLK = 64, QB = NW * QBLK;
constexpr int SHM_V = KVBLK * D * 2, SHM_K = KVBLK * D * 2;
constexpr int LDS_BYTES = 2 * SHM_V + 2 * SHM_K + NW * 64 * 4;
constexpr int CUM_OFF = LDS_BYTES;
constexpr int OST = 4096;
static_assert(D == 128 && SQ % QB == 0 && SKV % KVBLK == 0 && H % HKV == 0 && QOFF >= 0 && QOFF + SQ <= SKV && WINDOW >= 1, "geometry");

using bf16 = __hip_bfloat16;
typedef short bf16x8 __attribute__((ext_vector_type(8)));
typedef short s16x4 __attribute__((ext_vector_type(4)));
typedef float f32x16 __attribute__((ext_vector_type(16)));
typedef float f32x4 __attribute__((ext_vector_type(4)));
typedef unsigned u32x4 __attribute__((ext_vector_type(4)));
template <class A, class Bt> struct same_t { static constexpr bool v = false; };
template <class A> struct same_t<A, A> { static constexpr bool v = true; };

#define KSWZ(row, colB) ((row) * 256 + ((colB) ^ (((row) & 7) << 4)))
#define SBAR() __builtin_amdgcn_sched_barrier(0)
__device__ __forceinline__ int v_st(int k, int c) { const int kk = (k & ~0xC) | ((k & 4) << 1) | ((k & 8) >> 1); return ((kk >> 3) * 4 + (c >> 5)) * 512 + ((kk & 7) * 32 + (c & 31)) * 2; }
__device__ __forceinline__ int v_rd_base(int lane) { return ((lane & 3) << 3) | (((lane >> 2) & 3) << 6) | (((lane >> 4) & 1) << 5) | (((lane >> 5) & 1) << 8); }
constexpr int v_rd_off(int d0, int ks, int half) { return d0 * 512 + ks * 4096 + half * 2048; }
__device__ __forceinline__ int crow(int r, int hi) { return (r & 3) + 8 * (r >> 2) + 4 * hi; }
__device__ __forceinline__ unsigned cvtpk(float lo, float hi) {
    unsigned r; asm volatile("v_cvt_pk_bf16_f32 %0, %1, %2" : "=v"(r) : "v"(lo), "v"(hi)); return r;
}
__device__ __forceinline__ bf16x8 pack8(f32x4 a, f32x4 b) {
    u32x4 w = {cvtpk(a[0], a[1]), cvtpk(a[2], a[3]), cvtpk(b[0], b[1]), cvtpk(b[2], b[3])};
    return *reinterpret_cast<bf16x8*>(&w);
}
template <class T> __device__ __forceinline__ bf16x8 load8(const T* p) {
    if constexpr (same_t<T, float>::v) { return pack8(*(const f32x4*)p, *(const f32x4*)(p + 4)); }
    else { return *reinterpret_cast<const bf16x8*>(p); }
}
__device__ __forceinline__ void mask_tile(f32x16& p0, f32x16& p1, int dq, unsigned W) {
    const float NEG = -__builtin_inff();
#pragma unroll
    for (int r = 0; r < 16; ++r) {
        const int c = (r & 3) + 8 * (r >> 2);
        if ((unsigned)(dq - c) >= W) p0[r] = NEG;
        if ((unsigned)(dq - c - 32) >= W) p1[r] = NEG;
    }
}
__device__ __forceinline__ void partialSM(f32x16& p0, f32x16& p1, float& m_reg, float& mn, float& alpha) {
    float pmax = p0[0]; for (int r = 1; r < 16; ++r) pmax = fmaxf(pmax, p0[r]); for (int r = 0; r < 16; ++r) pmax = fmaxf(pmax, p1[r]);
    { auto rr = __builtin_amdgcn_permlane32_swap(__float_as_uint(pmax), __float_as_uint(pmax), false, false);
      pmax = fmaxf(__uint_as_float(rr[0]), __uint_as_float(rr[1])); }
    constexpr float C2 = 1.4426950408889634f * SCALE;
    if (__builtin_expect(__all((pmax - m_reg) * SCALE <= THR), 1)) { mn = m_reg; alpha = 1.f; }
    else { mn = fmaxf(m_reg, pmax); alpha = __builtin_amdgcn_exp2f((m_reg - mn) * C2); m_reg = mn; }
    const float mnL = -mn * C2;
    for (int r = 0; r < 16; ++r) p0[r] = fmaf(p0[r], C2, mnL); for (int r = 0; r < 16; ++r) p1[r] = fmaf(p1[r], C2, mnL);
    for (int r = 0; r < 16; ++r) p0[r] = __builtin_amdgcn_exp2f(p0[r]);
}
__device__ __forceinline__ void finishSM(f32x16& p0, f32x16& p1, float alpha, float& l_reg, bf16x8& pa0, bf16x8& pa1, bf16x8& pa2, bf16x8& pa3) {
    for (int r = 0; r < 16; ++r) p1[r] = __builtin_amdgcn_exp2f(p1[r]);
    float ps = 0; for (int r = 0; r < 16; ++r) ps += p0[r]; for (int r = 0; r < 16; ++r) ps += p1[r];
    { auto rr = __builtin_amdgcn_permlane32_swap(__float_as_uint(ps), __float_as_uint(ps), false, false);
      ps = __uint_as_float(rr[0]) + __uint_as_float(rr[1]); }
    l_reg = l_reg * alpha + ps;
#define PK4(P, B_, OUT) do { unsigned a0 = cvtpk(P[B_+0], P[B_+1]), a1 = cvtpk(P[B_+2], P[B_+3]);                          \
        unsigned b0 = cvtpk(P[B_+4], P[B_+5]), b1 = cvtpk(P[B_+6], P[B_+7]);                                             \
        auto r0 = __builtin_amdgcn_permlane32_swap(a0, b0, false, false); auto r1 = __builtin_amdgcn_permlane32_swap(a1, b1, false, false); \
        u32x4 w = {r0[0], r1[0], r0[1], r1[1]}; OUT = *reinterpret_cast<bf16x8*>(&w); } while (0)
    PK4(p0, 0, pa0); PK4(p0, 8, pa1); PK4(p1, 0, pa2); PK4(p1, 8, pa3);
#undef PK4
}
template <int KB, bool SK>
__device__ __forceinline__ void qkt(f32x16& p0, f32x16& p1, const char* K_lds, int r32, int hi, const bf16x8* qr, bool act, const float* cb) {
    if (SK && !act) { const float NEG = -__builtin_inff();
#pragma unroll
        for (int r = 0; r < 16; ++r) { p0[r] = NEG; p1[r] = NEG; } return; }
#pragma unroll
    for (int g = 0; g < 4; ++g) { const f32x4 c0 = *(const f32x4*)(cb + 8 * g), c1 = *(const f32x4*)(cb + 32 + 8 * g);
#pragma unroll
        for (int e = 0; e < 4; ++e) { p0[4 * g + e] = c0[e]; p1[4 * g + e] = c1[e]; } }
    const char* kb[4];
#pragma unroll
    for (int dd = 0; dd < 4; ++dd) kb[dd] = K_lds + KB * SHM_K + KSWZ(r32, (dd * 16 + hi * 8) * 2);
#pragma unroll
    for (int d0 = 0; d0 < 8; ++d0) { const char* a = kb[d0 & 3] + (d0 >> 2) * 128;
        bf16x8 b0 = *reinterpret_cast<const bf16x8*>(a);
        bf16x8 b1 = *reinterpret_cast<const bf16x8*>(a + 32 * 256);
        p0 = __builtin_amdgcn_mfma_f32_32x32x16_bf16(b0, qr[d0], p0, 0, 0, 0);
        p1 = __builtin_amdgcn_mfma_f32_32x32x16_bf16(b1, qr[d0], p1, 0, 0, 0); }
}
template <int VB, bool SK>
__device__ __forceinline__ void pv_tile(f32x16* o, int vb0, bf16x8 pa0, bf16x8 pa1, bf16x8 pa2, bf16x8 pa3, bool act) {
    if (SK && !act) return;
#define TRRD(dst, off) asm volatile("ds_read_b64_tr_b16 %0, %1 offset:%2" : "=&v"(dst) : "v"(vb0), "i"(off) : "memory")
#define PV_D0(d0) do { s16x4 l0, l1, l2, l3, h0, h1, h2, h3; constexpr int b_ = VB * SHM_V + v_rd_off(d0, 0, 0);     \
        TRRD(l0, b_); TRRD(h0, b_ + 2048); TRRD(l1, b_ + 4096); TRRD(h1, b_ + 6144); TRRD(l2, b_ + 8192); TRRD(h2, b_ + 10240); TRRD(l3, b_ + 12288); TRRD(h3, b_ + 14336); \
        asm volatile("s_waitcnt lgkmcnt(0)" ::: "memory"); SBAR();                 \
        o[d0] = __builtin_amdgcn_mfma_f32_32x32x16_bf16(pa0, (bf16x8){l0[0], l0[1], l0[2], l0[3], h0[0], h0[1], h0[2], h0[3]}, o[d0], 0, 0, 0);   \
        o[d0] = __builtin_amdgcn_mfma_f32_32x32x16_bf16(pa1, (bf16x8){l1[0], l1[1], l1[2], l1[3], h1[0], h1[1], h1[2], h1[3]}, o[d0], 0, 0, 0);   \
        o[d0] = __builtin_amdgcn_mfma_f32_32x32x16_bf16(pa2, (bf16x8){l2[0], l2[1], l2[2], l2[3], h2[0], h2[1], h2[2], h2[3]}, o[d0], 0, 0, 0);   \
        o[d0] = __builtin_amdgcn_mfma_f32_32x32x16_bf16(pa3, (bf16x8){l3[0], l3[1], l3[2], l3[3], h3[0], h3[1], h3[2], h3[3]}, o[d0], 0, 0, 0); } while (0)
    PV_D0(0); PV_D0(1); PV_D0(2); PV_D0(3);
#undef PV_D0
#undef TRRD
}

template <class TIn, class TOut> struct BlockRef { const TIn* Q; const TIn* K; const TIn* V; TOut* O; int P0; };
template <class TIn> struct Seam {
    bf16x8 qr[8];
    bf16x8 st_v0, st_v1, st_k0, st_k1; f32x4 sf0, sf1, sf2, sf3;
    f32x4 tq[16];
};
__device__ __forceinline__ int swa_jlo(int P0, int W) { const int lowk = P0 - W + 1; return lowk > 0 ? lowk / KVBLK : 0; }
#define ROW(p, k0, rr) ((p) + (size_t)((k0) + (rr)) * D + sc)
#define VMW() asm volatile("s_waitcnt vmcnt(0)" ::: "memory")
#define VMWN(n) asm volatile("s_waitcnt vmcnt(%0)" :: "i"(n) : "memory")
#define SLOAD_H(Kp, Vp, k0) do { S.st_v0 = load8<TIn>(ROW(Vp, k0, sr)); S.st_v1 = load8<TIn>(ROW(Vp, k0, 32 + sr));              \
                         S.st_k0 = load8<TIn>(ROW(Kp, k0, sr)); S.st_k1 = load8<TIn>(ROW(Kp, k0, 32 + sr)); } while (0)
#define SWRITE_HK(bf) do { *(bf16x8*)(K_lds + (bf) * SHM_K + kws) = S.st_k0; *(bf16x8*)(K_lds + (bf) * SHM_K + kws + 32 * 256) = S.st_k1; } while (0)
#define SWRITE_HV(bf) do { *(bf16x8*)(V_lds + (bf) * SHM_V + vst0) = S.st_v0; *(bf16x8*)(V_lds + (bf) * SHM_V + vst1) = S.st_v1; } while (0)
#define SWRITE_H(bf) do { SWRITE_HV(bf); SWRITE_HK(bf); } while (0)
#define SLOAD_F(p, k0) do { S.sf0 = *(const f32x4*)ROW(p, k0, sr); S.sf1 = *(const f32x4*)(ROW(p, k0, sr) + 4);                \
                            S.sf2 = *(const f32x4*)ROW(p, k0, 32 + sr); S.sf3 = *(const f32x4*)(ROW(p, k0, 32 + sr) + 4); } while (0)
#define SWRITE_KF(bf) do { *(bf16x8*)(K_lds + (bf) * SHM_K + kws) = pack8(S.sf0, S.sf1); *(bf16x8*)(K_lds + (bf) * SHM_K + kws + 32 * 256) = pack8(S.sf2, S.sf3); } while (0)
#define SWRITE_VF(bf) do { *(bf16x8*)(V_lds + (bf) * SHM_V + vst0) = pack8(S.sf0, S.sf1); *(bf16x8*)(V_lds + (bf) * SHM_V + vst1) = pack8(S.sf2, S.sf3); } while (0)
template <class TIn, class TOut>
__device__ __forceinline__ void causal_swa_prime(const BlockRef<TIn, TOut>& cur, int W, char* lds, Seam<TIn>& S) {
    constexpr bool F32 = same_t<TIn, float>::v;
    const int tid = opaque_tid(), wid = __builtin_amdgcn_readfirstlane(tid >> 6), lane = tid & 63, r32 = lane & 31, hi = lane >> 5;
    const int sr = tid >> 4, sc = (tid & 15) * 8, kws = KSWZ(sr, sc * 2); char* K_lds = lds + 2 * SHM_V;
    const int kb0 = swa_jlo(cur.P0, W) * KVBLK;
    for (int d0 = 0; d0 < 8; ++d0) S.qr[d0] = load8<TIn>(cur.Q + (size_t)(wid * QBLK + r32) * D + d0 * 16 + hi * 8);
    if constexpr (F32) { SLOAD_F((const float*)cur.K, kb0); VMW(); SWRITE_KF(0); SBAR(); SLOAD_F((const float*)cur.V, kb0); }
    else { SLOAD_H(cur.K, cur.V, kb0); VMW(); SWRITE_HK(0); }
    __syncthreads();
}
template <class TIn, class TOut>
__device__ __forceinline__ void causal_swa_block(const BlockRef<TIn, TOut>& cur, const BlockRef<TIn, TOut>& nxt, int skv, int W, char* lds, Seam<TIn>& S) {
    constexpr bool F32 = same_t<TIn, float>::v;
    const int tid = opaque_tid(), wid = __builtin_amdgcn_readfirstlane(tid >> 6), lane = tid & 63, r32 = lane & 31, hi = lane >> 5;
    const int j_lo = swa_jlo(cur.P0, W);
    int j_hi = (cur.P0 + QB - 1) / KVBLK + 1; if (j_hi > skv / KVBLK) j_hi = skv / KVBLK;
    const int NT = j_hi - j_lo;
    const int kbn = swa_jlo(nxt.P0, W) * KVBLK;
    const int qlo = cur.P0 + wid * QBLK, qm = qlo + r32 - 4 * hi;
    char* V_lds = lds; char* K_lds = lds + 2 * SHM_V;
    float* ws = (float*)(lds + 2 * SHM_V + 2 * SHM_K) + wid * 64; float* li_l = ws, * al_l = ws + 32;
    const float* cum = (const float*)(lds + CUM_OFF);
    float m_reg = -1e30f, l_reg = 0; f32x16 o[4] = {};
    const int sr = tid >> 4, sc = (tid & 15) * 8, vst0 = v_st(sr, sc), vst1 = v_st(32 + sr, sc), kws = KSWZ(sr, sc * 2);
    const int vb0 = (int)(uintptr_t)V_lds + v_rd_base(lane);
    const TIn* Kh = cur.K; const TIn* Vh = cur.V;
#define RESC(a) do { if (__any((a) < 1.f)) { if (hi == 0) al_l[r32] = (a); asm volatile("s_waitcnt lgkmcnt(0)" ::: "memory");              \
                     for (int d_ = 0; d_ < 4; ++d_) for (int r = 0; r < 16; ++r) o[d_][r] *= al_l[crow(r, hi)]; } } while (0)
#define KBASE(t) ((j_lo + (t)) * KVBLK)
#define CUMT(t) (cum + KBASE(t) + 4 * hi)
#define ACT(t) (KBASE(t) <= qlo + QBLK - 1 && KBASE(t) + KVBLK - 1 >= qlo - W + 1)
#define MASKT(P0_, P1_, t) do { const int kb_ = KBASE(t); if ((!SK || ACT(t)) && (kb_ + KVBLK - 1 > qlo || kb_ <= qlo + QBLK - 1 - W)) mask_tile(P0_, P1_, qm - kb_, (unsigned)W); } while (0)
    constexpr int NQL = F32 ? 16 : 8;
    constexpr bool SK = WSKIP && !F32;
#define SEAM_K0() do { VMWN(NQL); if constexpr (F32) { SWRITE_KF(0); SBAR(); SLOAD_F((const float*)nxt.V, kbn); } else { SWRITE_HK(0); } SBAR(); } while (0)
    f32x16 pA0, pA1, pB0, pB1; float mnA, mnB, alA, alB; bf16x8 pa0, pa1, pa2, pa3;
    if constexpr (F32) { VMW(); SWRITE_VF(0); SBAR(); } else { SWRITE_HV(0); SBAR(); }
    if (NT > 1) { if constexpr (F32) SLOAD_F((const float*)Kh, KBASE(1)); else SLOAD_H(Kh, Vh, KBASE(1)); }
    SBAR(); qkt<0, SK>(pA0, pA1, K_lds, r32, hi, S.qr, ACT(0), CUMT(0));
    if constexpr (F32) { if (NT > 1) { VMW(); SWRITE_KF(1); SBAR(); SLOAD_F((const float*)Vh, KBASE(1)); } }
    MASKT(pA0, pA1, 0); partialSM(pA0, pA1, m_reg, mnA, alA);
    if (NT > 1) { VMW(); if constexpr (F32) { SWRITE_VF(1); SBAR(); if (NT > 2) SLOAD_F((const float*)Kh, KBASE(2)); } else SWRITE_H(1); }
    __syncthreads();
#define HALF_STEP(PX0, PX1, mnX, alX, PY0, PY1, alY, t, KB, VB, SB) do {                                                      \
        SBAR(); qkt<KB, SK>(PX0, PX1, K_lds, r32, hi, S.qr, ACT(t), CUMT(t));                                             \
        finishSM(PY0, PY1, alY, l_reg, pa0, pa1, pa2, pa3); SBAR();                                                           \
        if ((t) + 1 < NT) { if constexpr (F32) { VMW(); SWRITE_KF(SB); SBAR(); SLOAD_F((const float*)Vh, KBASE((t) + 1)); }  \
                            else { SLOAD_H(Kh, Vh, KBASE((t) + 1)); } SBAR(); }                                               \
        pv_tile<VB, SK>(o, vb0, pa0, pa1, pa2, pa3, ACT((t) - 1)); MASKT(PX0, PX1, (t)); partialSM(PX0, PX1, m_reg, mnX, alX);                                        \
        __syncthreads();                                                                                                      \
        if ((t) + 1 < NT) { VMW(); if constexpr (F32) { SWRITE_VF(SB); SBAR(); if ((t) + 2 < NT) SLOAD_F((const float*)Kh, KBASE((t) + 2)); } \
                            else { SWRITE_H(SB); } }                                                                          \
        RESC(alX); __syncthreads(); } while (0)
    for (int t = 1; t + 1 < NT; t += 2) {
        HALF_STEP(pB0, pB1, mnB, alB, pA0, pA1, alA, t, 1, 0, 0);
        HALF_STEP(pA0, pA1, mnA, alA, pB0, pB1, alB, t + 1, 0, 1, 1);
    }
    const bool even = (NT & 1) == 0;
    if (even) { SBAR(); qkt<1, SK>(pB0, pB1, K_lds, r32, hi, S.qr, ACT(NT - 1), CUMT(NT - 1)); SBAR(); }
#define QROW(e) (nxt.Q + (size_t)(wid * QBLK + r32) * D + ((e) >> 1) * 16 + hi * 8 + ((e) & 1) * 4)
    if constexpr (F32) { SLOAD_F((const float*)nxt.K, kbn); SBAR();
#pragma unroll
        for (int e = 0; e < 8; ++e) S.tq[e] = *(const f32x4*)QROW(e); }
    else { SLOAD_H(nxt.K, nxt.V, kbn); SBAR();
#pragma unroll
        for (int d0 = 0; d0 < 8; ++d0) S.qr[d0] = load8<TIn>(nxt.Q + (size_t)(wid * QBLK + r32) * D + d0 * 16 + hi * 8); }
    SBAR();
    finishSM(pA0, pA1, alA, l_reg, pa0, pa1, pa2, pa3); SBAR();
    if constexpr (F32) {
#pragma unroll
        for (int e = 8; e < 16; ++e) S.tq[e] = *(const f32x4*)QROW(e); SBAR(); }
#undef QROW
    pv_tile<0, SK>(o, vb0, pa0, pa1, pa2, pa3, ACT(even ? NT - 2 : NT - 1));
    if (even) { MASKT(pB0, pB1, NT - 1); partialSM(pB0, pB1, m_reg, mnB, alB); __syncthreads(); RESC(alB);
        finishSM(pB0, pB1, alB, l_reg, pa0, pa1, pa2, pa3); SBAR(); pv_tile<1, SK>(o, vb0, pa0, pa1, pa2, pa3, ACT(NT - 1)); }
    SBAR(); SEAM_K0();
    if (hi == 0) li_l[r32] = l_reg; asm volatile("s_waitcnt lgkmcnt(0)" ::: "memory");
    float rli[16];
#pragma unroll
    for (int r = 0; r < 16; ++r) rli[r] = __builtin_amdgcn_rcpf(li_l[crow(r, hi)]);
    TOut* Ow = cur.O + (size_t)(wid * QBLK) * OST;
#pragma unroll
    for (int r = 0; r < 16; ++r) { const int orow = crow(r, hi);
#pragma unroll
        for (int d0 = 0; d0 < 4; ++d0) { const float v = o[d0][r] * rli[r];
            if constexpr (same_t<TOut, float>::v) { Ow[(size_t)orow * OST + d0 * 32 + r32] = v; }
            else { const float vn = __shfl_xor(v, 1);
                   if ((r32 & 1) == 0) *(unsigned*)(Ow + (size_t)orow * OST + d0 * 32 + r32) = cvtpk(v, vn); } } }
    if constexpr (F32) {
#pragma unroll
        for (int d0 = 0; d0 < 8; ++d0) S.qr[d0] = pack8(S.tq[2 * d0], S.tq[2 * d0 + 1]); }
    __syncthreads();
#undef RESC
#undef KBASE
#undef CUMT
#undef ACT
#undef MASKT
#undef SEAM_K0
#undef HALF_STEP
}
#undef ROW
#undef VMW
#undef VMWN
#undef SLOAD_H
#undef SWRITE_HK
#undef SWRITE_HV
#undef SWRITE_H
#undef SLOAD_F
#undef SWRITE_KF
#undef SWRITE_VF

constexpr int ATT_LDS = CUM_OFF + SKV * 4;
__device__ __forceinline__ int row_window(const float* a, int t, float bound) {
    const float thr = a[t] - bound * INV_SCALE;
    int lo = 0, hi = t + 1;
    while (lo < hi) { const int mid = (lo + hi) >> 1; if (a[mid] < thr) lo = mid + 1; else hi = mid; }
    return t - lo + 1;
}
__device__ __forceinline__ void attn_phase(char* lds, const bf16* FQ, const bf16* FK, const bf16* FV, const float* FLOGF, const float* qg, const float* kg, bf16* MERGED) {
    constexpr int NQB = SQ / QB, NX = NQB / 2, TOTAL = NX * H;
    if (blockIdx.x < TOTAL) { const int L = blockIdx.x;
        const int h = L / NX, x = L % NX, y = NQB - 1 - x;
        __syncthreads();
        float* cum = (float*)(lds + CUM_OFF);
        int W;
        { const int tid = opaque_tid(), lane = tid & 63;
          { const float* src = FLOGF + (size_t)h * SKV + tid * 16; float p[16]; float run = 0.f;
#pragma unroll
            for (int q = 0; q < 4; ++q) { const f32x4 v = *(const f32x4*)(src + 4 * q);
#pragma unroll
                for (int e = 0; e < 4; ++e) { run += v[e]; p[4 * q + e] = run; } }
            float inc = run;
#pragma unroll
            for (int o = 1; o < 64; o <<= 1) { const float u = __shfl_up(inc, o); if (lane >= o) inc += u; }
            float* wt = (float*)(lds + 2 * SHM_V + 2 * SHM_K);
            if (lane == 63) wt[tid >> 6] = inc;
            __syncthreads();
            float off = inc - run;
            for (int w8 = 0; w8 < (tid >> 6); ++w8) off += wt[w8];
#pragma unroll
            for (int q = 0; q < 4; ++q) *(f32x4*)(cum + tid * 16 + 4 * q) = (f32x4){(p[4 * q] + off) * (-INV_SCALE), (p[4 * q + 1] + off) * (-INV_SCALE), (p[4 * q + 2] + off) * (-INV_SCALE), (p[4 * q + 3] + off) * (-INV_SCALE)};
            __syncthreads(); }
          float gq = fmaxf(fabsf(qg[h * D + lane]), fabsf(qg[h * D + 64 + lane])), gk = fmaxf(fabsf(kg[h * D + lane]), fabsf(kg[h * D + 64 + lane]));
#pragma unroll
          for (int o = 1; o < 64; o <<= 1) { gq = fmaxf(gq, __shfl_xor(gq, o)); gk = fmaxf(gk, __shfl_xor(gk, o)); }
          const float bound = 2.f * INV_SCALE * gq * gk + 48.f;
          __syncthreads();
          int w = row_window(cum, ((tid >> 8) ? y : x) * QB + (tid & 255), bound);
#pragma unroll
          for (int o = 1; o < 64; o <<= 1) { const int w2 = __shfl_xor(w, o); w = w2 > w ? w2 : w; }
          int* wm = (int*)(lds + 2 * SHM_V + 2 * SHM_K);
          if (lane == 0) wm[tid >> 6] = w;
          __syncthreads();
          w = wm[0];
#pragma unroll
          for (int i = 1; i < 8; ++i) w = wm[i] > w ? wm[i] : w;
          w = (w + KVBLK - 1) & ~(KVBLK - 1); if (w > SKV) w = SKV;
          W = __builtin_amdgcn_readfirstlane(w);
          __syncthreads(); }
        BlockRef<bf16, bf16> b0, b1;
        const size_t hb = (size_t)h * SKV * D;
        b0.Q = FQ + hb + (size_t)x * QB * D; b0.K = FK + hb; b0.V = FV + hb; b0.O = MERGED + (size_t)x * QB * OST + h * D; b0.P0 = x * QB;
        b1.Q = FQ + hb + (size_t)y * QB * D; b1.K = FK + hb; b1.V = FV + hb; b1.O = MERGED + (size_t)y * QB * OST + h * D; b1.P0 = y * QB;
        Seam<bf16> S;
        causal_swa_prime<bf16, bf16>(b0, W, lds, S);
        BlockRef<bf16, bf16> cur = b0; int pass = 0;
        for (;;) { const bool last = pass == 1; const BlockRef<bf16, bf16> nxt = last ? cur : b1;
            causal_swa_block<bf16, bf16>(cur, nxt, SKV, W, lds, S);
            if (last) break; cur = nxt; pass = 1; }
    }
}
}
__device__ __forceinline__ void p_hgrn_seq(const bf16_t* HQ, const bf16_t* HK, const bf16_t* HV, const float* HLF, float* HO) {
    const int tid = opaque_tid(), lane = tid & 63, wave = tid >> 6;
    for (int it = blockIdx.x; it < NHEAD * 16; it += gridDim.x) {
        const int h = it >> 4, vc = (it & 15) * 8 + wave;
        const size_t hb = (size_t)h * T_ * HDIM;
        float Sa = 0.f, Sb = 0.f;
        for (int t0 = 0; t0 < T_; t0 += 8) {
            float fa[8], fb[8], ka[8], kb[8], qa[8], qb[8], vv[8];
#pragma unroll
            for (int i = 0; i < 8; ++i) { const size_t r = hb + (size_t)(t0 + i) * HDIM;
                fa[i] = HLF[r + lane]; fb[i] = HLF[r + lane + 64];
                ka[i] = bf2f(HK[r + lane]); kb[i] = bf2f(HK[r + lane + 64]);
                qa[i] = bf2f(HQ[r + lane]); qb[i] = bf2f(HQ[r + lane + 64]);
                vv[i] = bf2f(HV[r + vc]); }
            float p[8];
#pragma unroll
            for (int i = 0; i < 8; ++i) { Sa = expf(fa[i]) * Sa + ka[i] * vv[i]; Sb = expf(fb[i]) * Sb + kb[i] * vv[i]; p[i] = qa[i] * Sa + qb[i] * Sb; }
#pragma unroll
            for (int i = 0; i < 8; ++i) p[i] = wave_sum(p[i]);
            if (lane < 8) { float o = p[0];
#pragma unroll
                for (int i = 1; i < 8; ++i) o = (lane == i) ? p[i] : o;
                HO[hb + (size_t)(t0 + lane) * HDIM + vc] = o; }
        }
    }
}
__device__ __forceinline__ void p_hgrn_post(const float* HO, const bf16_t* HG, const float* og, bf16_t* MERGED) {
    const int tid = opaque_tid(), lane = tid & 63, wave = tid >> 6;
    for (int i = blockIdx.x * 8 + wave; i < T_ * NHEAD; i += gridDim.x * 8) {
        const int h = i / T_, t = i % T_, c = 2 * lane;
        const size_t r = ((size_t)h * T_ + t) * HDIM + c;
        const f32x2 o = *(const f32x2*)(HO + r);
        const float rs = rsqrtf(wave_sum(o[0] * o[0] + o[1] * o[1]) * (1.f / HDIM) + EPS_);
        const unsigned g = *(const unsigned*)(HG + r);
        const float g0 = bf2f(g & 0xffffu), g1 = bf2f(g >> 16);
        *(unsigned*)(MERGED + (size_t)t * DM + FOXW + h * HDIM + c) = pk2(o[0] * rs * og[h * HDIM + c] * g0, o[1] * rs * og[h * HDIM + c + 1] * g1);
    }
}
__device__ __forceinline__ void p_post2(unsigned char* lds, const float* x, const bf16_t* MIXG, const float* mod, const float* ada_b, const float* g2, bf16_t* X1B, bf16_t* H, unsigned char* H8, float* SH, int* HS) {
    float* A2 = (float*)lds; float* B2 = A2 + DM;
    const int tid = opaque_tid(), lane = tid & 63, wave = tid >> 6;
    for (int i = tid; i < DM; i += 512) { A2[i] = g2[i] * (1.f + mod[4 * DM + i] + ada_b[4 * DM + i]); B2[i] = mod[3 * DM + i] + ada_b[3 * DM + i]; }
    __syncthreads();
    for (int t = blockIdx.x * 8 + wave; t < T_; t += gridDim.x * 8) {
        const f32x4* xr = (const f32x4*)(x + (size_t)t * DM) + lane; const u32x2* mr = (const u32x2*)(MIXG + (size_t)t * DM) + lane;
        u32x2* orow = (u32x2*)(X1B + (size_t)t * DM) + lane;
        f32x4 v[16]; float ss = 0.f;
#pragma unroll
        for (int j = 0; j < 16; ++j) { const u32x2 m = mr[64 * j]; v[j] = xr[64 * j] + (f32x4){bf2f(m.x & 0xffffu), bf2f(m.x >> 16), bf2f(m.y & 0xffffu), bf2f(m.y >> 16)}; orow[64 * j] = (u32x2){pk2(v[j][0], v[j][1]), pk2(v[j][2], v[j][3])};
            ss += (v[j][0] * v[j][0] + v[j][1] * v[j][1]) + (v[j][2] * v[j][2] + v[j][3] * v[j][3]);
            if ((j & 3) == 3) asm volatile("" ::: "memory"); }
        const float rstd = rsqrtf(wave_sum(ss) * (1.f / DM) + EPS_);
        u32x2* o8 = (u32x2*)(H + (size_t)t * DM) + lane;
#pragma unroll
        for (int j = 0; j < 16; ++j) { const f32x4 a = *(const f32x4*)(A2 + 4 * lane + 256 * j), b = *(const f32x4*)(B2 + 4 * lane + 256 * j);
            const f32x4 hh = v[j] * rstd * a + b; u32x2 o = {pk2(hh[0], hh[1]), pk2(hh[2], hh[3])}; o8[64 * j] = o; v[j] = hh;
            if ((j & 3) == 3) asm volatile("" ::: "memory"); }
        float mx = 0.f;
#pragma unroll
        for (int j = 0; j < 16; ++j) mx = fmaxf(fmaxf(mx, fmaxf(fabsf(v[j][0]), fabsf(v[j][1]))), fmaxf(fabsf(v[j][2]), fabsf(v[j][3])));
#pragma unroll
        for (int o = 1; o < 64; o <<= 1) mx = fmaxf(mx, __shfl_xor(mx, o));
        const float sc = fmaxf(mx, 1e-30f) * (1.f / 119.f), inv = 1.f / sc;
        unsigned* h8 = (unsigned*)(H8 + (size_t)t * DM) + lane;
        int hs = 0;
#pragma unroll
        for (int j = 0; j < 16; ++j) { const int c0 = (int)rintf(v[j][0] * inv), c1 = (int)rintf(v[j][1] * inv), c2 = (int)rintf(v[j][2] * inv), c3 = (int)rintf(v[j][3] * inv);
            hs += (c0 + c1) + (c2 + c3);
            h8[64 * j] = (unsigned)(c0 & 0xff) | ((unsigned)(c1 & 0xff) << 8) | ((unsigned)(c2 & 0xff) << 16) | ((unsigned)(c3 & 0xff) << 24); }
#pragma unroll
        for (int o = 1; o < 64; o <<= 1) hs += __shfl_xor(hs, o);
        if (lane == 0) { SH[t] = sc; HS[t] = hs; }
    }
}
namespace hg {
typedef short bf16x8 __attribute__((ext_vector_type(8)));
constexpr int CH = 64, NG = 16;
__device__ __forceinline__ int grp_start(int g) { return g < 5 ? 9 * g : g < 11 ? 45 + 8 * (g - 5) : 93 + 7 * (g - 11); }
__device__ __forceinline__ int grp_count(int g) { return g < 5 ? 9 : g < 11 ? 8 : 7; }
constexpr int PA = 272, PB = 144;
constexpr int L_AQ = 0, L_BK = L_AQ + 64 * PA, L_KDT = L_BK + 64 * PA, L_VT = L_KDT + 128 * PB, L_P = L_VT + 128 * PB, L_ST = L_P + 64 * PB,
              L_SEG = L_ST + 128 * PA, L_BL = L_SEG + 8 * 128 * 4, L_END = L_BL + 512, L_OB = 0, POB = 528;
static_assert(64 * POB <= L_KDT && L_END <= 131072, "hgrn LDS map");
__device__ __forceinline__ bf16x8 frag(const unsigned char* base, int row, int pitch, int kk, int lane) { return *(const bf16x8*)(base + row * pitch + (kk * 32 + 8 * (lane >> 4)) * 2); }

struct ChunkRegs { unsigned lf[8], kq[8], kk[8], kv[8]; };
template <bool FULL>
__device__ __forceinline__ void load_chunk(ChunkRegs& R, const bf16_t* HQ, const bf16_t* HK, const bf16_t* HV, const float* HLF, size_t base, int tid) {
    const int c0 = 2 * (tid & 63), g8 = tid >> 6;
    const size_t e0 = base + (size_t)(8 * g8) * HDIM + c0;
#pragma unroll
    for (int i = 0; i < 8; ++i) { R.lf[i] = *(const unsigned*)((const unsigned short*)HLF + e0 + i * HDIM);
        R.kv[i] = *(const unsigned*)(HV + e0 + i * HDIM); if (FULL) R.kq[i] = *(const unsigned*)(HQ + e0 + i * HDIM); }
}
template <bool FULL>
__device__ __forceinline__ f32x2 stage_chunk(unsigned char* lds, ChunkRegs& R, int tid) {
    const int c0 = 2 * (tid & 63), g8 = tid >> 6;
    float b0[8], b1[8]; unsigned (&kq)[8] = R.kq; unsigned (&kk)[8] = R.kk; unsigned (&kv)[8] = R.kv;
#pragma unroll
    for (int i = 0; i < 8; ++i) { b0[i] = (float)__builtin_bit_cast(_Float16, (unsigned short)(R.lf[i] & 0xffffu)); b1[i] = (float)__builtin_bit_cast(_Float16, (unsigned short)(R.lf[i] >> 16)); }
#pragma unroll
    for (int i = 0; i < 8; ++i) kk[i] = pk2(1.f - __expf(b0[i]), 1.f - __expf(b1[i]));
#pragma unroll
    for (int i = 1; i < 8; ++i) { b0[i] += b0[i - 1]; b1[i] += b1[i - 1]; }
    float* seg = (float*)(lds + L_SEG);
    *(f32x2*)(seg + g8 * 128 + c0) = (f32x2){b0[7], b1[7]};
    __syncthreads();
    float off0 = 0.f, off1 = 0.f, tot0 = 0.f, tot1 = 0.f;
#pragma unroll
    for (int g = 0; g < 8; ++g) { const f32x2 s = *(const f32x2*)(seg + g * 128 + c0); if (g < g8) { off0 += s[0]; off1 += s[1]; } tot0 += s[0]; tot1 += s[1]; }
    if (g8 == 0) *(f32x2*)((float*)(lds + L_BL) + c0) = (f32x2){tot0, tot1};
    u32x4 kd0, kd1, vt0, vt1;
#pragma unroll
    for (int i = 0; i < 8; ++i) {
        const float ba = b0[i] + off0, bb = b1[i] + off1;
        const float k0 = bf2f(kk[i] & 0xffffu), k1 = bf2f(kk[i] >> 16);
        if (FULL) {
            const float ea = __expf(ba), eb = __expf(bb), ia = __expf(fminf(-ba, 80.f)), ib = __expf(fminf(-bb, 80.f));
            const int t = 8 * g8 + i;
            *(unsigned*)(lds + L_AQ + t * PA + c0 * 2) = pk2(bf2f(kq[i] & 0xffffu) * ea, bf2f(kq[i] >> 16) * eb);
            *(unsigned*)(lds + L_BK + t * PA + c0 * 2) = pk2(k0 * ia, k1 * ib);
        }
        const unsigned da = f2bf(k0 * __expf(tot0 - ba)), db = f2bf(k1 * __expf(tot1 - bb));
        const unsigned va = kv[i] & 0xffffu, vb = kv[i] >> 16;
        if (i & 1) { kd0[i >> 1] |= da << 16; kd1[i >> 1] |= db << 16; vt0[i >> 1] |= va << 16; vt1[i >> 1] |= vb << 16; }
        else { kd0[i >> 1] = da; kd1[i >> 1] = db; vt0[i >> 1] = va; vt1[i >> 1] = vb; }
    }
    *(u32x4*)(lds + L_KDT + c0 * PB + 16 * g8) = kd0; *(u32x4*)(lds + L_KDT + (c0 + 1) * PB + 16 * g8) = kd1;
    *(u32x4*)(lds + L_VT + c0 * PB + 16 * g8) = vt0; *(u32x4*)(lds + L_VT + (c0 + 1) * PB + 16 * g8) = vt1;
    return (f32x2){tot0, tot1};
}
__device__ __forceinline__ void state_update(const unsigned char* lds, f32x4 (&st)[8], int w, int lane) {
    const f32x4 bl = *(const f32x4*)((const float*)(lds + L_BL) + 16 * w + 4 * (lane >> 4));
    const f32x4 dec = {__expf(bl[0]), __expf(bl[1]), __expf(bl[2]), __expf(bl[3])};
    const bf16x8 a0 = frag(lds + L_KDT, 16 * w + (lane & 15), PB, 0, lane), a1 = frag(lds + L_KDT, 16 * w + (lane & 15), PB, 1, lane);
#pragma unroll
    for (int nv = 0; nv < 8; ++nv) {
        st[nv] = st[nv] * dec;
        st[nv] = __builtin_amdgcn_mfma_f32_16x16x32_bf16(a0, frag(lds + L_VT, 16 * nv + (lane & 15), PB, 0, lane), st[nv], 0, 0, 0);
        st[nv] = __builtin_amdgcn_mfma_f32_16x16x32_bf16(a1, frag(lds + L_VT, 16 * nv + (lane & 15), PB, 1, lane), st[nv], 0, 0, 0);
    }
}
__device__ __forceinline__ void pass_a(unsigned char* lds, const bf16_t* HK, const bf16_t* HV, const float* HLF, float* LST, float* BSUM) {
    const int tid = opaque_tid(), lane = tid & 63, w = __builtin_amdgcn_readfirstlane(tid >> 6);
    for (int it = blockIdx.x; it < NHEAD * (NG - 1); it += gridDim.x) {
        const int h = it / (NG - 1), g = it % (NG - 1);
        f32x4 st[8];
#pragma unroll
        for (int nv = 0; nv < 8; ++nv) st[nv] = (f32x4){0.f, 0.f, 0.f, 0.f};
        f32x2 bs = {0.f, 0.f};
        ChunkRegs R;
        const int c0g = grp_start(g), ncg = grp_count(g);
        load_chunk<false>(R, nullptr, HK, HV, HLF, ((size_t)h * T_ + (size_t)c0g * CH) * HDIM, tid);
        __syncthreads();
        for (int ci = 0; ci < ncg; ++ci) {
            bs += stage_chunk<false>(lds, R, tid);
            if (ci + 1 < ncg) load_chunk<false>(R, nullptr, HK, HV, HLF, ((size_t)h * T_ + (size_t)(c0g + ci + 1) * CH) * HDIM, tid);
            __syncthreads();
            state_update(lds, st, w, lane);
        }
        float* Lp = LST + ((size_t)(h * NG + g) * 128) * 128;
#pragma unroll
        for (int nv = 0; nv < 8; ++nv) *(f32x4*)(Lp + ((size_t)nv * 512 + w * 64 + lane) * 4) = st[nv];
        if (tid < 64) *(f32x2*)(BSUM + (size_t)(h * NG + g) * 128 + 2 * tid) = bs;
    }
}
__device__ __forceinline__ void pass_b(unsigned char* lds, const bf16_t* HQ, const bf16_t* HK, const bf16_t* HV, const bf16_t* HG, const float* HLF, const float* LST, const float* BSUM, const float* og, bf16_t* MERGED) {
    const int tid = opaque_tid(), lane = tid & 63, w = __builtin_amdgcn_readfirstlane(tid >> 6);
    for (int it = blockIdx.x; it < NHEAD * NG; it += gridDim.x) {
        const int h = it / NG, g = it % NG;
        f32x4 st[8];
#pragma unroll
        for (int nv = 0; nv < 8; ++nv) st[nv] = (f32x4){0.f, 0.f, 0.f, 0.f};
        for (int j = 0; j < g; ++j) {
            const float* Lp = LST + ((size_t)(h * NG + j) * 128) * 128;
            const f32x4 bl = *(const f32x4*)(BSUM + (size_t)(h * NG + j) * 128 + 16 * w + 4 * (lane >> 4));
            const f32x4 dec = {__expf(bl[0]), __expf(bl[1]), __expf(bl[2]), __expf(bl[3])};
#pragma unroll
            for (int nv = 0; nv < 8; ++nv) st[nv] = st[nv] * dec + *(const f32x4*)(Lp + ((size_t)nv * 512 + w * 64 + lane) * 4);
        }
        __syncthreads();
#pragma unroll
        for (int nv = 0; nv < 8; ++nv) *(u32x2*)(lds + L_ST + (16 * nv + (lane & 15)) * PA + (16 * w + 4 * (lane >> 4)) * 2) = (u32x2){pk2(st[nv][0], st[nv][1]), pk2(st[nv][2], st[nv][3])};
        ChunkRegs R;
        const int c0g = grp_start(g), ncg = grp_count(g);
        load_chunk<true>(R, HQ, HK, HV, HLF, ((size_t)h * T_ + (size_t)c0g * CH) * HDIM, tid);
        f32x4 gn4[4];
#pragma unroll
        for (int q = 0; q < 4; ++q) gn4[q] = *(const f32x4*)(og + h * HDIM + 16 * (tid & 7) + 4 * q);
        for (int ci = 0; ci < ncg; ++ci) {
            const int t0 = (c0g + ci) * CH;
            const size_t base = ((size_t)h * T_ + t0) * HDIM;
            stage_chunk<true>(lds, R, tid);
            if (ci + 1 < ncg) load_chunk<true>(R, HQ, HK, HV, HLF, base + (size_t)CH * HDIM, tid);
            const u32x4 ga = *(const u32x4*)(HG + base + (size_t)(tid >> 3) * HDIM + 16 * (tid & 7)), gb = *(const u32x4*)(HG + base + (size_t)(tid >> 3) * HDIM + 16 * (tid & 7) + 8);
            __syncthreads();
#pragma unroll
            for (int ii = 0; ii < 2; ++ii) { const int i = 2 * w + ii, ms = i >> 2, nt = i & 3;
                f32x4 acc = {0.f, 0.f, 0.f, 0.f};
                if (ms <= nt) {
#pragma unroll
                    for (int kk = 0; kk < 4; ++kk) acc = __builtin_amdgcn_mfma_f32_16x16x32_bf16(frag(lds + L_BK, 16 * ms + (lane & 15), PA, kk, lane), frag(lds + L_AQ, 16 * nt + (lane & 15), PA, kk, lane), acc, 0, 0, 0);
                }
                const int t = 16 * nt + (lane & 15), s0 = 16 * ms + 4 * (lane >> 4);
#pragma unroll
                for (int r = 0; r < 4; ++r) if (s0 + r > t) acc[r] = 0.f;
                *(u32x2*)(lds + L_P + t * PB + s0 * 2) = (u32x2){pk2(acc[0], acc[1]), pk2(acc[2], acc[3])};
            }
            __syncthreads();
            f32x4 o[4];
            { const int mt = w >> 1;
              const bf16x8 p0 = frag(lds + L_P, 16 * mt + (lane & 15), PB, 0, lane), p1 = frag(lds + L_P, 16 * mt + (lane & 15), PB, 1, lane);
              bf16x8 aq[4];
#pragma unroll
              for (int kk = 0; kk < 4; ++kk) aq[kk] = frag(lds + L_AQ, 16 * mt + (lane & 15), PA, kk, lane);
#pragma unroll
              for (int j = 0; j < 4; ++j) { const int nv = 4 * (w & 1) + j; f32x4 acc = {0.f, 0.f, 0.f, 0.f};
                  acc = __builtin_amdgcn_mfma_f32_16x16x32_bf16(p0, frag(lds + L_VT, 16 * nv + (lane & 15), PB, 0, lane), acc, 0, 0, 0);
                  acc = __builtin_amdgcn_mfma_f32_16x16x32_bf16(p1, frag(lds + L_VT, 16 * nv + (lane & 15), PB, 1, lane), acc, 0, 0, 0);
#pragma unroll
                  for (int kk = 0; kk < 4; ++kk) acc = __builtin_amdgcn_mfma_f32_16x16x32_bf16(aq[kk], frag(lds + L_ST, 16 * nv + (lane & 15), PA, kk, lane), acc, 0, 0, 0);
                  o[j] = acc; } }
            state_update(lds, st, w, lane);
            __syncthreads();
            { const int mt = w >> 1;
#pragma unroll
              for (int j = 0; j < 4; ++j)
#pragma unroll
                  for (int r = 0; r < 4; ++r) *(float*)(lds + L_OB + (16 * mt + 4 * (lane >> 4) + r) * POB + (16 * (4 * (w & 1) + j) + (lane & 15)) * 4) = o[j][r]; }
#pragma unroll
            for (int nv = 0; nv < 8; ++nv) *(u32x2*)(lds + L_ST + (16 * nv + (lane & 15)) * PA + (16 * w + 4 * (lane >> 4)) * 2) = (u32x2){pk2(st[nv][0], st[nv][1]), pk2(st[nv][2], st[nv][3])};
            __syncthreads();
            { const int t = tid >> 3, v0 = 16 * (tid & 7);
              f32x4 x[4]; float ss = 0.f;
#pragma unroll
              for (int q = 0; q < 4; ++q) { x[q] = *(const f32x4*)(lds + L_OB + t * POB + (v0 + 4 * q) * 4); ss += (x[q][0] * x[q][0] + x[q][1] * x[q][1]) + (x[q][2] * x[q][2] + x[q][3] * x[q][3]); }
              ss += __shfl_xor(ss, 1); ss += __shfl_xor(ss, 2); ss += __shfl_xor(ss, 4);
              const float rs = rsqrtf(ss * (1.f / HDIM) + EPS_);
              const unsigned gw[8] = {ga[0], ga[1], ga[2], ga[3], gb[0], gb[1], gb[2], gb[3]};
              unsigned ow[8];
#pragma unroll
              for (int q = 0; q < 4; ++q) { const f32x4 gn = gn4[q];
                  ow[2 * q] = pk2(x[q][0] * rs * gn[0] * bf2f(gw[2 * q] & 0xffffu), x[q][1] * rs * gn[1] * bf2f(gw[2 * q] >> 16));
                  ow[2 * q + 1] = pk2(x[q][2] * rs * gn[2] * bf2f(gw[2 * q + 1] & 0xffffu), x[q][3] * rs * gn[3] * bf2f(gw[2 * q + 1] >> 16)); }
              bf16_t* dst = MERGED + (size_t)(t0 + t) * DM + FOXW + h * HDIM + v0;
              *(u32x4*)dst = (u32x4){ow[0], ow[1], ow[2], ow[3]}; *(u32x4*)(dst + 8) = (u32x4){ow[4], ow[5], ow[6], ow[7]}; }
        }
    }
}
}
__device__ __forceinline__ void p_scores(unsigned char* lds, const float* QP, const float* keys, float* SC) {
    float* Ks = (float*)lds;
    float* Qs = Ks + 128 * 132;
    const int tid = opaque_tid(), n = tid & 127, tq = tid >> 7;
    for (int it = blockIdx.x; it < 16 * (T_ / 64); it += gridDim.x) {
        const int hp = it % 16, t0 = (it / 16) * 64;
        __syncthreads();
        for (int i = tid; i < 128 * 32; i += 512) { const int r = i >> 5, c4 = i & 31; *(f32x4*)(Ks + r * 132 + 4 * c4) = *(const f32x4*)(keys + ((size_t)hp * 128 + r) * 128 + 4 * c4); }
        for (int i = tid; i < 64 * 32; i += 512) { const int r = i >> 5, c4 = i & 31; *(f32x4*)(Qs + r * 128 + 4 * c4) = *(const f32x4*)(QP + (size_t)(t0 + r) * PEER_QW + hp * 128 + 4 * c4); }
        __syncthreads();
        float acc[16];
#pragma unroll
        for (int j = 0; j < 16; ++j) acc[j] = 0.f;
        for (int d = 0; d < 128; d += 4) {
            const f32x4 kv = *(const f32x4*)(Ks + n * 132 + d);
#pragma unroll
            for (int j = 0; j < 16; ++j) { const f32x4 q = *(const f32x4*)(Qs + (tq * 16 + j) * 128 + d); acc[j] += (q[0] * kv[0] + q[1] * kv[1]) + (q[2] * kv[2] + q[3] * kv[3]); }
        }
#pragma unroll
        for (int j = 0; j < 16; ++j) SC[((size_t)(t0 + tq * 16 + j) * 16 + hp) * 128 + n] = acc[j];
    }
}
__device__ __forceinline__ unsigned fkey(float f) { const unsigned u = __builtin_bit_cast(unsigned, f); return (u & 0x80000000u) ? ~u : (u | 0x80000000u); }
__device__ __forceinline__ float fkey_inv(unsigned k) { const unsigned u = (k & 0x80000000u) ? (k & 0x7fffffffu) : ~k; return __builtin_bit_cast(float, u); }
__device__ __forceinline__ unsigned long long wave_max_u64(unsigned long long v) {
#pragma unroll
    for (int o = 1; o < 64; o <<= 1) { const unsigned lo = __shfl_xor((unsigned)v, o), hi = __shfl_xor((unsigned)(v >> 32), o); const unsigned long long w = ((unsigned long long)hi << 32) | lo; v = w > v ? w : v; }
    return v;
}
__device__ __forceinline__ void p_topk(const float* SC, int* PIDX, float* PGATE) {
    const int tid = opaque_tid(), lane = tid & 63, wave = tid >> 6;
    for (int i = blockIdx.x * 8 + wave; i < T_ * PEER_H; i += gridDim.x * 8) {
        const int t = i / PEER_H, h = i % PEER_H;
        float ts[2]; int ti[2];
#pragma unroll
        for (int p = 0; p < 2; ++p) {
            const float* s = SC + ((size_t)t * 16 + h * 2 + p) * 128;
            unsigned long long a = ((unsigned long long)fkey(s[lane]) << 32) | (unsigned)(127 - lane), b = ((unsigned long long)fkey(s[lane + 64]) << 32) | (unsigned)(127 - (lane + 64));
            float ms = 0.f; int mi = 0;
            for (int j = 0; j < 16; ++j) {
                const unsigned long long m = wave_max_u64(a > b ? a : b);
                if (a == m) a = 0ull; if (b == m) b = 0ull;
                if (lane == j) { ms = fkey_inv((unsigned)(m >> 32)); mi = 127 - (int)(m & 0xffffffffu); }
            }
            ts[p] = ms; ti[p] = mi;
        }
        unsigned long long cd[4];
#pragma unroll
        for (int c = 0; c < 4; ++c) { const int id = lane * 4 + c, ia = id >> 4, ib = id & 15;
            const float sa = __shfl(ts[0], ia), sb = __shfl(ts[1], ib); const int ea = __shfl(ti[0], ia), eb = __shfl(ti[1], ib);
            cd[c] = ((unsigned long long)fkey(sa + sb) << 32) | (unsigned)(0xffff - (ea * 128 + eb)); }
        float bs = 0.f; int be = 0;
        for (int j = 0; j < 16; ++j) {
            unsigned long long m = cd[0] > cd[1] ? cd[0] : cd[1]; const unsigned long long m2 = cd[2] > cd[3] ? cd[2] : cd[3]; m = m > m2 ? m : m2;
            m = wave_max_u64(m);
#pragma unroll
            for (int c = 0; c < 4; ++c) if (cd[c] == m) cd[c] = 0ull;
            if (lane == j) { bs = fkey_inv((unsigned)(m >> 32)); be = 0xffff - (int)(m & 0xffffffffu); }
        }
        const float mx = __shfl(bs, 0); float e = lane < 16 ? expf(bs - mx) : 0.f; const float den = wave_sum(e);
        if (lane < 16) { PIDX[(size_t)t * 128 + h * 16 + lane] = be; PGATE[(size_t)t * 128 + h * 16 + lane] = e / den; }
    }
}
__device__ __forceinline__ void p_expert_u(unsigned char* lds, const unsigned char* H8, const unsigned char* U4, const unsigned* PIDX, int* PD) {
    const int tid = opaque_tid(), lane = tid & 63, wave = tid >> 6, g = lane >> 4, n = lane & 15;
    const int xs = blockIdx.x & 7, tw = (blockIdx.x >> 3) * 8 + wave;
    int* eL = (int*)(lds + wave * 2048);
    const unsigned char* ub = U4 + (size_t)xs * PEER_NE * SLB + 16 * n;
    const unsigned char* hb = H8 + 512 * xs + 16 * n;
    unsigned ne = PIDX[(size_t)tw * 64 + lane];
    *(u32x2*)(eL + 2 * lane) = (u32x2){ne & 0xffffu, ne >> 16};
    ne = PIDX[(size_t)(tw + 256) * 64 + lane];
    u32x4 hlo_n = *(const u32x4*)(hb + (size_t)tw * DM), hhi_n = *(const u32x4*)(hb + (size_t)tw * DM + 256);
    u32x4 W[16]; int E[16];
#pragma unroll
    for (int s = 0; s < 16; ++s) { W[s] = *(const u32x4*)(ub + (size_t)eL[4 * s + g] * SLB); E[s] = eL[4 * (16 + s) + g]; }
#pragma unroll 1
    for (int k = 0; k < T_ / 256; ++k) {
        const int t = tw + 256 * k, cur = (k & 1) * 128, nxt = 128 - cur;
        *(u32x2*)(eL + nxt + 2 * lane) = (u32x2){ne & 0xffffu, ne >> 16};
        { const int t2 = tw + 256 * (k + 2 < T_ / 256 ? k + 2 : T_ / 256 - 1); ne = PIDX[(size_t)t2 * 64 + lane]; }
        u32x4 HA, HB;
#pragma unroll
        for (int c = 0; c < 4; ++c) {
            const unsigned l = hlo_n[c], h = hhi_n[c];
            HB[c] = (l & 0x0F0F0F0Fu) | ((h & 0x0F0F0F0Fu) << 4);
            HA[c] = ((((l >> 4) & 0x0F0F0F0Fu) + ((l >> 3) & 0x01010101u)) & 0x0F0F0F0Fu) | (((((h >> 4) & 0x0F0F0F0Fu) + ((h >> 3) & 0x01010101u)) & 0x0F0F0F0Fu) << 4);
        }
        { const int t1 = tw + 256 * (k + 1 < T_ / 256 ? k + 1 : T_ / 256 - 1); hlo_n = *(const u32x4*)(hb + (size_t)t1 * DM); hhi_n = *(const u32x4*)(hb + (size_t)t1 * DM + 256); }
        int* pd = PD + ((size_t)xs * T_ + t) * 128 + 4 * n + g;
#pragma unroll 1
        for (int hf = 0; hf < 2; ++hf) {
            int p[16];
#pragma unroll
            for (int i = 0; i < 16; ++i) {
                const u32x4 w = W[i]; int da = 0, db = 0;
#pragma unroll
                for (int c = 0; c < 4; ++c) { da = __builtin_amdgcn_sdot8((int)HA[c], (int)w[c], da, false); db = __builtin_amdgcn_sdot8((int)HB[c], (int)w[c], db, false); }
                p[i] = 16 * da + db;
                W[i] = *(const u32x4*)(ub + (size_t)E[i] * SLB);
                E[i] = eL[nxt + 4 * (16 * hf + i) + g];
            }
            int q8[8], q4[4], q2[2];
            { const bool hi = n & 8;
#pragma unroll
              for (int j = 0; j < 8; ++j) q8[j] = (hi ? p[j + 8] : p[j]) + __shfl_xor(hi ? p[j] : p[j + 8], 8); }
            { const bool hi = n & 4;
#pragma unroll
              for (int j = 0; j < 4; ++j) q4[j] = (hi ? q8[j + 4] : q8[j]) + __shfl_xor(hi ? q8[j] : q8[j + 4], 4); }
            { const bool hi = n & 2;
#pragma unroll
              for (int j = 0; j < 2; ++j) q2[j] = (hi ? q4[j + 2] : q4[j]) + __shfl_xor(hi ? q4[j] : q4[j + 2], 2); }
            { const bool hi = n & 1; pd[64 * hf] = (hi ? q2[1] : q2[0]) + __shfl_xor(hi ? q2[0] : q2[1], 1); }
        }
    }
}
__device__ __forceinline__ void p_expert_a(const float* SH, const int* HS, const float* SU, const float* SV, const unsigned short* PIDX, const float* PGATE, const int* PD, signed char* AQ, float* AF, int* AS) {
    const int tid = opaque_tid(), lane = tid & 63, wave = tid >> 6;
    static_assert(T_ == 4 * 256 * 8, "four tokens per wave");
    const int tb = blockIdx.x * 8 + wave;
    int hsum[4], ds[4][2]; float sht[4], su[4][2], sv[4][2], pg[4][2];
#pragma unroll
    for (int k = 0; k < 4; ++k) { const int t = tb + 2048 * k; hsum[k] = HS[t]; sht[k] = SH[t] * 0.5f;
#pragma unroll
        for (int hh = 0; hh < 2; ++hh) { const int slot = lane + 64 * hh, e = PIDX[(size_t)t * 128 + slot];
            su[k][hh] = SU[e]; sv[k][hh] = SV[e]; pg[k][hh] = PGATE[(size_t)t * 128 + slot];
            int d_ = 0;
#pragma unroll
            for (int x = 0; x < 8; ++x) d_ += PD[((size_t)x * T_ + t) * 128 + slot];
            ds[k][hh] = d_; } }
#pragma unroll
    for (int k = 0; k < 4; ++k) { const int t = tb + 2048 * k;
        float av[2];
#pragma unroll
        for (int hh = 0; hh < 2; ++hh) {
            const float d = (float)(2 * ds[k][hh] + hsum[k]) * (su[k][hh] * sht[k]);
            av[hh] = pg[k][hh] * sv[k][hh] * 0.5f * d * (1.f + erff(d * 0.70710678118654752f));
        }
        float amax = fmaxf(fabsf(av[0]), fabsf(av[1]));
#pragma unroll
        for (int o = 1; o < 64; o <<= 1) amax = fmaxf(amax, __shfl_xor(amax, o));
        amax = fmaxf(amax, 1e-37f);
        const float qsc = 127.f / amax;
        const int q0 = (int)rintf(av[0] * qsc), q1 = (int)rintf(av[1] * qsc);
        int qs = q0 + q1;
#pragma unroll
        for (int o = 1; o < 64; o <<= 1) qs += __shfl_xor(qs, o);
        AQ[(size_t)t * 128 + lane] = (signed char)q0; AQ[(size_t)t * 128 + 64 + lane] = (signed char)q1;
        if (lane == 0) { AF[t] = amax * (0.5f / 127.f); AS[t] = qs; }
    }
}
__device__ __forceinline__ void p_expert_v(unsigned char* lds, const unsigned char* V4, const unsigned* PIDX, const unsigned* AQ, const float* AF, const int* AS, const bf16_t* X1B, const float* mod, const float* ada_b, float* OUT) {
    const int tid = opaque_tid(), lane = tid & 63, wave = tid >> 6, g = lane >> 4, n = lane & 15;
    const int xs = blockIdx.x & 7, tw = (blockIdx.x >> 3) * 8 + wave;
    int* eL = (int*)(lds + wave * 2048);
    signed char* qL = (signed char*)(lds + wave * 2048 + 1024);
    const unsigned char* vb = V4 + (size_t)xs * PEER_NE * SLB + 16 * n;
    const int colb = 512 * xs + 16 * n + 4 * g;
    const f32x4 g2lo = *(const f32x4*)(mod + 5 * DM + colb) + *(const f32x4*)(ada_b + 5 * DM + colb), g2hi = *(const f32x4*)(mod + 5 * DM + colb + 256) + *(const f32x4*)(ada_b + 5 * DM + colb + 256);
    const int m0 = (n >> 2) == 0 ? -1 : 0, m1 = (n >> 2) == 1 ? -1 : 0, m2 = (n >> 2) == 2 ? -1 : 0, m3 = (n >> 2) == 3 ? -1 : 0;
    unsigned ne = PIDX[(size_t)tw * 64 + lane];
    *(u32x2*)(eL + 2 * lane) = (u32x2){ne & 0xffffu, ne >> 16};
    ne = PIDX[(size_t)(tw + 256) * 64 + lane];
    unsigned nq = AQ[(size_t)tw * 32 + (lane & 31)]; float nfa = AF[tw]; int nqs = AS[tw];
    u32x4 W[16]; int E[16];
#pragma unroll
    for (int s = 0; s < 16; ++s) { W[s] = *(const u32x4*)(vb + (size_t)eL[4 * s + g] * SLB); E[s] = eL[4 * (16 + s) + g]; }
#pragma unroll 1
    for (int k = 0; k < T_ / 256; ++k) {
        const int t = tw + 256 * k, cur = (k & 1) * 128, nxt = 128 - cur;
        *(u32x2*)(eL + nxt + 2 * lane) = (u32x2){ne & 0xffffu, ne >> 16};
        { const int t2 = tw + 256 * (k + 2 < T_ / 256 ? k + 2 : T_ / 256 - 1); ne = PIDX[(size_t)t2 * 64 + lane]; }
        if (lane < 32) ((unsigned*)qL)[lane] = nq;
        const float fa = nfa; const int qs = nqs;
        { const int t1 = tw + 256 * (k + 1 < T_ / 256 ? k + 1 : T_ / 256 - 1); nq = AQ[(size_t)t1 * 32 + (lane & 31)]; nfa = AF[t1]; nqs = AS[t1]; }
        f32x4* olo = (f32x4*)(OUT + (size_t)t * DM + colb); f32x4* ohi = (f32x4*)(OUT + (size_t)t * DM + colb + 256);
        const u32x2 blo = __builtin_nontemporal_load((const u32x2*)(X1B + (size_t)t * DM + colb)), bhi = __builtin_nontemporal_load((const u32x2*)(X1B + (size_t)t * DM + colb + 256));
        pg8::i32x4 acc[4];
#pragma unroll
        for (int i = 0; i < 4; ++i) acc[i] = (pg8::i32x4){0, 0, 0, 0};
#pragma unroll 1
        for (int it = 0; it < 2; ++it) {
            unsigned qa[16];
#pragma unroll
            for (int s = 0; s < 16; ++s) qa[s] = ((unsigned)(int)qL[4 * (16 * it + s) + g] & 0xffu) << (8 * (n & 3));
#pragma unroll
            for (int s = 0; s < 16; ++s) {
                const int i = 16 * it + s; const u32x4 w = W[s];
                const pg8::i32x4 A_ = {(int)qa[s] & m0, (int)qa[s] & m1, (int)qa[s] & m2, (int)qa[s] & m3};
                const u32x4 hi_ = w & 0xF0F0F0F0u;
                acc[2 * (s & 1)] = __builtin_amdgcn_mfma_i32_16x16x64_i8(A_, __builtin_bit_cast(pg8::i32x4, w), acc[2 * (s & 1)], 0, 0, 0);
                acc[2 * (s & 1) + 1] = __builtin_amdgcn_mfma_i32_16x16x64_i8(A_, __builtin_bit_cast(pg8::i32x4, hi_), acc[2 * (s & 1) + 1], 0, 0, 0);
                W[s] = *(const u32x4*)(vb + (size_t)E[s] * SLB);
                E[s] = eL[nxt + 4 * i + g];
            }
        }
        const pg8::i32x4 sh16 = acc[1] + acc[3], slo = acc[0] + acc[2] - sh16;
        const f32x4 xlo = {bf2f(blo.x & 0xffffu), bf2f(blo.x >> 16), bf2f(blo.y & 0xffffu), bf2f(blo.y >> 16)}, xhi = {bf2f(bhi.x & 0xffffu), bf2f(bhi.x >> 16), bf2f(bhi.y & 0xffffu), bf2f(bhi.y >> 16)};
        __builtin_nontemporal_store(xlo + g2lo * (f32x4){fa * (float)(2 * slo[0] - 15 * qs), fa * (float)(2 * slo[1] - 15 * qs), fa * (float)(2 * slo[2] - 15 * qs), fa * (float)(2 * slo[3] - 15 * qs)}, olo);
        __builtin_nontemporal_store(xhi + g2hi * (f32x4){fa * (float)((sh16[0] >> 3) + qs), fa * (float)((sh16[1] >> 3) + qs), fa * (float)((sh16[2] >> 3) + qs), fa * (float)((sh16[3] >> 3) + qs)}, ohi);
    }
}
namespace route {
typedef short bf16x8 __attribute__((ext_vector_type(8)));
constexpr int PK_ = 272, PQ_ = 528, PS_ = 1056;
constexpr int L_KB = 0, L_QT = L_KB + 2 * 128 * PK_, L_SC = L_QT + 32 * PQ_, L_WL = L_SC + 32 * PS_, L_END = L_WL + 8 * 1024;
static_assert(L_END <= 131072, "route LDS map");
__device__ __forceinline__ unsigned fkey(float f) { const unsigned u = __builtin_bit_cast(unsigned, f); return (u & 0x80000000u) ? ~u : (u | 0x80000000u); }
__device__ __forceinline__ float fkey_inv(unsigned k) { const unsigned u = (k & 0x80000000u) ? (k & 0x7fffffffu) : ~k; return __builtin_bit_cast(float, u); }
#define ROW_DPP(x_, ctrl_, bc_) __builtin_amdgcn_update_dpp(0, (x_), (ctrl_), 0xf, 0xf, (bc_))
__device__ __forceinline__ int row_sum(int c) {
    c += ROW_DPP(c, 0x128, false); c += ROW_DPP(c, 0x124, false); c += ROW_DPP(c, 0x122, false); c += ROW_DPP(c, 0x121, false); return c; }
__device__ __forceinline__ float row_sumf(float c) {
    c += __builtin_bit_cast(float, ROW_DPP(__builtin_bit_cast(int, c), 0x128, false)); c += __builtin_bit_cast(float, ROW_DPP(__builtin_bit_cast(int, c), 0x124, false));
    c += __builtin_bit_cast(float, ROW_DPP(__builtin_bit_cast(int, c), 0x122, false)); c += __builtin_bit_cast(float, ROW_DPP(__builtin_bit_cast(int, c), 0x121, false));
    return c; }
__device__ __forceinline__ int row_scan(int c) {
    c += ROW_DPP(c, 0x111, true); c += ROW_DPP(c, 0x112, true); c += ROW_DPP(c, 0x114, true); c += ROW_DPP(c, 0x118, true); return c; }
__device__ __forceinline__ unsigned row_maxu(unsigned c) { unsigned o;
    o = (unsigned)ROW_DPP((int)c, 0x128, false); c = o > c ? o : c; o = (unsigned)ROW_DPP((int)c, 0x124, false); c = o > c ? o : c;
    o = (unsigned)ROW_DPP((int)c, 0x122, false); c = o > c ? o : c; o = (unsigned)ROW_DPP((int)c, 0x121, false); c = o > c ? o : c; return c; }
__device__ __forceinline__ unsigned row_minu(unsigned c) { unsigned o;
    o = (unsigned)ROW_DPP((int)c, 0x128, false); c = o < c ? o : c; o = (unsigned)ROW_DPP((int)c, 0x124, false); c = o < c ? o : c;
    o = (unsigned)ROW_DPP((int)c, 0x122, false); c = o < c ? o : c; o = (unsigned)ROW_DPP((int)c, 0x121, false); c = o < c ? o : c; return c; }
template <int NV> __device__ __forceinline__ unsigned select16_row(unsigned (&key)[NV], unsigned& base) {
    unsigned lm = key[0];
#pragma unroll
    for (int v = 1; v < NV; ++v) lm = key[v] > lm ? key[v] : lm;
    const unsigned hi = row_maxu(lm), lo = row_minu(lm), b1 = (lo ? lo : 1u) - 1u, range = hi - b1;
    base = b1;
#pragma unroll
    for (int v = 0; v < NV; ++v) key[v] = (key[v] > b1 ? key[v] : b1) - b1;
    const int hb = 31 - __builtin_clz(range);
    unsigned prefix = 0u; bool done = false;
    int start = __builtin_amdgcn_readlane(hb, 0);
    { const int s1 = __builtin_amdgcn_readlane(hb, 16), s2 = __builtin_amdgcn_readlane(hb, 32), s3 = __builtin_amdgcn_readlane(hb, 48);
      start = s1 > start ? s1 : start; start = s2 > start ? s2 : start; start = s3 > start ? s3 : start; }
    for (int bit = start; bit >= 0; --bit) {
        const unsigned cand = prefix | (1u << bit); int c = 0;
#pragma unroll
        for (int v = 0; v < NV; ++v) c += (key[v] >= cand) ? 1 : 0;
        c = row_sum(c);
        const bool take = !done && c >= 16;
        prefix = take ? cand : prefix;
        done = done || (take && c == 16);
        if ((bit & 1) == 0 && __ballot(!done) == 0ull) break;
    }
    return prefix;
}
__device__ __forceinline__ void route_phase(unsigned char* lds, const bf16_t* QPB, const float* keys, unsigned short* PIDX, float* PGATE) {
    const int tid = opaque_tid(), lane = tid & 63, w = __builtin_amdgcn_readfirstlane(tid >> 6);
    const int h = blockIdx.x & 7;
    __syncthreads();
    for (int i = tid; i < 2 * 128 * 32; i += 512) { const int r = i >> 5, c4 = i & 31;
        const f32x4 k4 = *(const f32x4*)(keys + ((size_t)h * 256 + r) * 128 + 4 * c4);
        *(u32x2*)(lds + L_KB + r * PK_ + c4 * 8) = (u32x2){pk2(k4[0], k4[1]), pk2(k4[2], k4[3])}; }
    for (int tile = (blockIdx.x >> 3); tile < T_ / 32; tile += (gridDim.x >> 3)) {
        const int t0 = tile * 32;
        __syncthreads();
        { const int r = tid >> 4, c = tid & 15;
          const u32x4* src = (const u32x4*)(QPB + (size_t)(t0 + r) * PEER_QW + h * 256 + 16 * c);
          const u32x4 a = src[0], b = src[1];
          *(u32x4*)(lds + L_QT + r * PQ_ + c * 32) = a; *(u32x4*)(lds + L_QT + r * PQ_ + c * 32 + 16) = b; }
        __syncthreads();
#pragma unroll
        for (int p = 0; p < 2; ++p) {
            bf16x8 kb[4];
#pragma unroll
            for (int kk = 0; kk < 4; ++kk) kb[kk] = *(const bf16x8*)(lds + L_KB + (p * 128 + 16 * w + (lane & 15)) * PK_ + (kk * 32 + 8 * (lane >> 4)) * 2);
#pragma unroll
            for (int mt = 0; mt < 2; ++mt) { f32x4 acc = {0.f, 0.f, 0.f, 0.f};
#pragma unroll
                for (int kk = 0; kk < 4; ++kk) acc = __builtin_amdgcn_mfma_f32_16x16x32_bf16(*(const bf16x8*)(lds + L_QT + (16 * mt + (lane & 15)) * PQ_ + (p * 128 + kk * 32 + 8 * (lane >> 4)) * 2), kb[kk], acc, 0, 0, 0);
#pragma unroll
                for (int r = 0; r < 4; ++r) *(float*)(lds + L_SC + (16 * mt + 4 * (lane >> 4) + r) * PS_ + (p * 132 + 16 * w + (lane & 15)) * 4) = acc[r]; }
        }
        __syncthreads();
        unsigned char* wl = lds + L_WL + w * 1024 + (lane >> 4) * 256;
        const int li = lane & 15, t = t0 + 4 * w + (lane >> 4);
#pragma unroll
        for (int p = 0; p < 2; ++p) {
            const float* s = (const float*)(lds + L_SC + (4 * w + (lane >> 4)) * PS_ + p * 132 * 4);
            float sv[8]; unsigned key[8];
#pragma unroll
            for (int v = 0; v < 8; ++v) { sv[v] = s[li + 16 * v]; key[v] = fkey(sv[v]); }
            unsigned base_; const unsigned thr = select16_row<8>(key, base_); (void)base_;
            int cl = 0;
#pragma unroll
            for (int v = 0; v < 8; ++v) cl += (key[v] >= thr) ? 1 : 0;
            int pos = row_scan(cl) - cl;
#pragma unroll
            for (int v = 0; v < 8; ++v) if (key[v] >= thr) { if (pos < 16) *(u32x2*)(wl + p * 128 + pos * 8) = (u32x2){__builtin_bit_cast(unsigned, sv[v]), (unsigned)(li + 16 * v)}; ++pos; }
        }
        asm volatile("s_waitcnt lgkmcnt(0)" ::: "memory");
        {
            const u32x2 wa = *(const u32x2*)(wl + li * 8);
            float cs[16]; unsigned ck[16]; int ce[16];
#pragma unroll
            for (int v = 0; v < 16; ++v) { const u32x2 wb = *(const u32x2*)(wl + 128 + v * 8);
                cs[v] = __builtin_bit_cast(float, wa.x) + __builtin_bit_cast(float, wb.x); ck[v] = fkey(cs[v]); ce[v] = (int)(wa.y * 128u + wb.y); }
            unsigned base_; const unsigned thr = select16_row<16>(ck, base_);
            const unsigned thr0 = thr + base_;
            const float tf = (thr0 >= 0x00800000u && thr0 <= 0xFF7FFFFFu) ? fkey_inv(thr0) : 0.f;
            int cl = 0;
#pragma unroll
            for (int v = 0; v < 16; ++v) cl += (ck[v] >= thr) ? 1 : 0;
            int pos = row_scan(cl) - cl;
            float e[16]; int ps[16]; float es = 0.f;
#pragma unroll
            for (int v = 0; v < 16; ++v) { const bool in = ck[v] >= thr && pos < 16; e[v] = in ? __expf(cs[v] - tf) : 0.f; ps[v] = in ? pos : -1; if (ck[v] >= thr) ++pos; es += e[v]; }
            es = row_sumf(es);
            const float inv = 1.f / es;
#pragma unroll
            for (int v = 0; v < 16; ++v) if (ps[v] >= 0) { PIDX[(size_t)t * 128 + h * 16 + ps[v]] = (unsigned short)ce[v]; PGATE[(size_t)t * 128 + h * 16 + ps[v]] = e[v] * inv; }
        }
        asm volatile("s_waitcnt lgkmcnt(0)" ::: "memory");
    }
}
}
constexpr int LDS_SCRATCH = 147456, LDS_BYTES = LDS_SCRATCH + 256 + 8192;
struct Params { const float* in[17]; float* out; unsigned char* ws; };
__global__ void __launch_bounds__(512, 2) mega_fwd(Params P) {
    extern __shared__ __attribute__((aligned(16))) unsigned char lds[];
    volatile LAS unsigned* MISC = (volatile LAS unsigned*)((LAS unsigned char*)lds + LDS_SCRATCH);
    if (threadIdx.x < 64) MISC[threadIdx.x] = 0u;
    __syncthreads();
    typedef const __attribute__((address_space(4))) Params* KArgs;
#define KA() ({ KArgs _p = (KArgs)__builtin_amdgcn_kernarg_segment_ptr(); asm volatile("" : "+s"(_p)); _p; })
#define WSP(off) (KA()->ws + (off))
    XcdBarrier bar = xcd_barrier_post((unsigned*)WSP(WS_CTL), MISC + 8);
    p_convert(lds, KA()->in[6], KA()->in[12], KA()->in[13], nullptr, (bf16_t*)WSP(WS_WOUTT), (bf16_t*)WSP(WS_WQT), (float*)WSP(WS_WFT));
    __syncthreads();
    p_adaln(lds, KA()->in[1], KA()->in[2], (float*)WSP(CTL_MOD));
    p_colmax<DM>(KA()->in[12], (float*)WSP(WS_WOUTT + 17 * MiB));
    p_colmax<NIN>(KA()->in[6], (float*)WSP(WS_WINT + 64 * MiB));
    xcd_barrier(bar);
    p_quant_w<NIN, NPROJ, true>(lds, KA()->in[6], (float*)WSP(WS_WINT + 64 * MiB), WSP(WS_WINT), (float*)WSP(WS_WINT + 60 * MiB));
    __syncthreads();
    p_quant_w<DM, DM, false>(lds, KA()->in[12], (float*)WSP(WS_WOUTT + 17 * MiB), WSP(WS_WOUTT), (float*)WSP(WS_WOUTT + 16 * MiB));
    __syncthreads();
    p_norm1(lds, KA()->in[0], (float*)WSP(CTL_MOD), KA()->in[3], KA()->in[4], (float*)WSP(WS_WFT), KA()->in[7], WSP(WS_H), (float*)WSP(WS_WFT + 512 * 1024), (float*)WSP(WS_FLOGF));
    xcd_barrier(bar);
    { pg8::Gemm g{(bf16_t*)WSP(WS_H), (bf16_t*)WSP(WS_WINT), T_, NPROJ, DM / 2}; pg8::StaticOrder S; S.init(T_, NPROJ, (int)gridDim.x, (int)blockIdx.x);
      pg8::EpiInProjT<true> E{(bf16_t*)WSP(WS_FQ), (bf16_t*)WSP(WS_FK), (bf16_t*)WSP(WS_FV), (bf16_t*)WSP(WS_HQ), (bf16_t*)WSP(WS_HK), (bf16_t*)WSP(WS_HV), (bf16_t*)WSP(WS_HG), (float*)WSP(WS_HLF), KA()->in[8], KA()->in[9], KA()->in[10],
                              (float*)WSP(WS_WFT + 512 * 1024), (float*)WSP(WS_WINT + 60 * MiB), (PG8_LAS float*)((LAS unsigned char*)lds + LDS_SCRATCH + 256)};
      pg8::gemm_phase<pg8::EpiInProjT<true>, pg8::StaticOrder, false>((PG8_LAS unsigned char*)lds, g, S, E, nullptr); }
    xcd_barrier(bar);
    fox::attn_phase((char*)lds, (const fox::bf16*)(bf16_t*)WSP(WS_FQ), (const fox::bf16*)(bf16_t*)WSP(WS_FK), (const fox::bf16*)(bf16_t*)WSP(WS_FV), (float*)WSP(WS_FLOGF), KA()->in[8], KA()->in[9], (fox::bf16*)(bf16_t*)WSP(WS_MERGED));
    __syncthreads();
    hg::pass_a(lds, (bf16_t*)WSP(WS_HK), (bf16_t*)WSP(WS_HV), (float*)WSP(WS_HLF), (float*)WSP(WS_HO), (float*)WSP(WS_HO + 32 * MiB));
    __syncthreads();
    p_convert_uv4(lds, (unsigned*)WSP(WS_CTL + 32768), KA()->in[15], KA()->in[16], WSP(WS_UBF), (float*)WSP(WS_UBF + 64 * MiB), WSP(WS_VBF), (float*)WSP(WS_VBF + 64 * MiB));
    xcd_barrier(bar);
    hg::pass_b(lds, (bf16_t*)WSP(WS_HQ), (bf16_t*)WSP(WS_HK), (bf16_t*)WSP(WS_HV), (bf16_t*)WSP(WS_HG), (float*)WSP(WS_HLF), (float*)WSP(WS_HO), (float*)WSP(WS_HO + 32 * MiB), KA()->in[11], (bf16_t*)WSP(WS_MERGED));
    xcd_barrier(bar);
    p_quant_merged((bf16_t*)WSP(WS_MERGED), WSP(WS_FQ), (float*)WSP(WS_FK));
    xcd_barrier(bar);
    { pg8::Gemm g{(bf16_t*)WSP(WS_FQ), (bf16_t*)WSP(WS_WOUTT), T_, DM, DM / 2}; pg8::StaticOrder S; S.init(T_, DM, (int)gridDim.x, (int)blockIdx.x);
      pg8::EpiMixBf16T<true> E{(bf16_t*)WSP(WS_PROJ), (float*)WSP(CTL_MOD), KA()->in[3], (float*)WSP(WS_FK), (float*)WSP(WS_WOUTT + 16 * MiB)};
      pg8::gemm_phase<pg8::EpiMixBf16T<true>, pg8::StaticOrder, false>((PG8_LAS unsigned char*)lds, g, S, E, nullptr); }
    xcd_barrier(bar);
    p_post2(lds, KA()->in[0], (bf16_t*)WSP(WS_PROJ), (float*)WSP(CTL_MOD), KA()->in[3], KA()->in[5], (bf16_t*)WSP(WS_MERGED), (bf16_t*)WSP(WS_H), WSP(WS_PROJ + 256 * MiB), (float*)WSP(WS_PROJ + 320 * MiB), (int*)WSP(WS_PROJ + 320 * MiB + 65536));
    xcd_barrier(bar);
    { pg8::Gemm g{(bf16_t*)WSP(WS_H), (bf16_t*)WSP(WS_WQT), T_, PEER_QW, DM}; pg8::StaticOrder S; S.init(T_, PEER_QW, (int)gridDim.x, (int)blockIdx.x); pg8::EpiBf16<0> E{(bf16_t*)WSP(WS_QP), PEER_QW, nullptr, 0, 0};
      pg8::gemm_phase<pg8::EpiBf16<0>, pg8::StaticOrder, false>((PG8_LAS unsigned char*)lds, g, S, E, nullptr); }
    xcd_barrier(bar);
    route::route_phase(lds, (bf16_t*)WSP(WS_QP), KA()->in[14], (unsigned short*)WSP(WS_PIDX), (float*)WSP(WS_PGATE));
    xcd_barrier(bar);
    p_expert_u(lds, WSP(WS_PROJ + 256 * MiB), WSP(WS_UBF), (unsigned*)WSP(WS_PIDX), (int*)WSP(WS_FQ));
    xcd_barrier(bar);
    p_expert_a((float*)WSP(WS_PROJ + 320 * MiB), (int*)WSP(WS_PROJ + 320 * MiB + 65536), (float*)WSP(WS_UBF + 64 * MiB), (float*)WSP(WS_VBF + 64 * MiB), (unsigned short*)WSP(WS_PIDX), (float*)WSP(WS_PGATE), (int*)WSP(WS_FQ),
               (signed char*)WSP(WS_FK), (float*)WSP(WS_FK + 2 * MiB), (int*)WSP(WS_FK + 3 * MiB));
    xcd_barrier(bar);
    p_expert_v(lds, WSP(WS_VBF), (unsigned*)WSP(WS_PIDX), (unsigned*)WSP(WS_FK), (float*)WSP(WS_FK + 2 * MiB), (int*)WSP(WS_FK + 3 * MiB), (bf16_t*)WSP(WS_MERGED), (float*)WSP(CTL_MOD), KA()->in[3], KA()->out);
}

extern "C" void kernel_launch(void* const* d_in, const int* in_sizes, int n_in, void* d_out, int out_size, void* d_ws, size_t ws_size, hipStream_t stream) {
    static int grid = 0;
    if (!grid) {
        if (n_in != 17 || in_sizes[0] != T_ * DM || out_size != T_ * DM || ws_size < WS_END) { fprintf(stderr, "kernel_launch: unexpected shapes (n_in %d, in0 %d, out %d, ws %zu < %zu)\n", n_in, n_in > 0 ? in_sizes[0] : -1, out_size, ws_size, (size_t)WS_END); grid = -1; return; }
        int dev = 0, cus = 0, per_cu = 0; (void)hipGetDevice(&dev); (void)hipDeviceGetAttribute(&cus, hipDeviceAttributeMultiprocessorCount, dev);
        if (hipFuncSetAttribute((const void*)mega_fwd, hipFuncAttributeMaxDynamicSharedMemorySize, LDS_BYTES) != hipSuccess) { fprintf(stderr, "kernel_launch: hipFuncSetAttribute failed\n"); grid = -1; return; }
        (void)hipOccupancyMaxActiveBlocksPerMultiprocessor(&per_cu, mega_fwd, 512, LDS_BYTES);
        if (cus != 256 || per_cu < 1) { fprintf(stderr, "kernel_launch: built for 256 CUs with one resident workgroup each (got %d CUs, %d per CU)\n", cus, per_cu); grid = -1; return; }
        grid = cus;
    }
    if (grid < 0) return;
    Params P{};
    for (int i = 0; i < 17; ++i) P.in[i] = (const float*)d_in[i];
    P.out = (float*)d_out; P.ws = (unsigned char*)d_ws;
    (void)hipMemsetAsync((unsigned char*)d_ws + WS_CTL, 0, CTL_ZERO_BYTES, stream);
    hipLaunchKernelGGL(mega_fwd, dim3(grid), dim3(512), LDS_BYTES, stream, P);
}
```
